# Optimizing an MI355X kernel written in HIP

```python
import jax, jax.numpy as jnp
from jax import lax
import numpy as np

D_MODEL = 1024
BATCH = 4
SEQ = 8192
DEPTH = 2

CHUNK = 64
N_META = 16
Q_BLOCK = 128
EPS = 1e-6

D_MIX = D_MODEL
N_GROUPS = 4
GROUP_WIDTH = D_MIX // N_GROUPS

LRU_WIDTH = GROUP_WIDTH
LRU_BLOCKS = 4
LRU_BLOCK = LRU_WIDTH // LRU_BLOCKS
CONV_WIDTH = 4
LRU_C = 8.0
HG_HEADS = 4
HG_DV = GROUP_WIDTH // HG_HEADS
HG_DK = 64
HG_CHUNK = 16
MLA_HEADS = 4
MLA_NOPE = 64
MLA_ROPE = 32
MLA_V = GROUP_WIDTH // MLA_HEADS
MLA_Q_RANK = 192
MLA_KV_RANK = 128
ROPE_THETA = 10000.0
FOX_HEADS = 4
FOX_HD = GROUP_WIDTH // FOX_HEADS
D_FF = 2816
N_EXPERTS = 8
TOP_K = 2
D_FF_EXPERT = 3584
N_DENSE = (DEPTH + 1) // 2
N_MOE = DEPTH // 2

IN_SIZES = (LRU_WIDTH, LRU_WIDTH,
            HG_HEADS * HG_DK, HG_HEADS * HG_DK, HG_HEADS * HG_DV, HG_HEADS * HG_DV,
            MLA_Q_RANK, MLA_KV_RANK, MLA_ROPE,
            FOX_HEADS * FOX_HD, FOX_HEADS * FOX_HD, FOX_HEADS * FOX_HD, FOX_HEADS)
IN_COLS = sum(IN_SIZES)

kernel_name = "hymba_hybrid_rglru_hgrn2_mla_fox_moe"

F32 = jnp.float32


def rmsnorm(x, g):
    xf = x.astype(F32)
    y = xf * lax.rsqrt(jnp.mean(xf * xf, axis=-1, keepdims=True) + EPS)
    return (y * g.astype(F32)).astype(x.dtype)


def group_rmsnorm(y, g):
    B, Lp, _ = y.shape
    yg = y.reshape(B, Lp, N_GROUPS, GROUP_WIDTH)
    return rmsnorm(yg, g.reshape(N_GROUPS, GROUP_WIDTH)).reshape(B, Lp, D_MIX)


def chunk_ids(pos):
    return jnp.where(pos < N_META, 0, 1 + (pos - N_META) // CHUNK)


def rope(t, pos):
    half = t.shape[-1] // 2
    inv = ROPE_THETA ** (-jnp.arange(half, dtype=F32) / half)
    ang = pos.astype(F32)[:, None] * inv[None, :]
    cos = jnp.cos(ang)[:, None, :]
    sin = jnp.sin(ang)[:, None, :]
    t1 = t[..., :half].astype(F32)
    t2 = t[..., half:].astype(F32)
    return jnp.concatenate([t1 * cos - t2 * sin, t1 * sin + t2 * cos], axis=-1).astype(t.dtype)


def blocked_attention(q, k, v, score_mod):
    B, H, Lp, dk = q.shape
    nb = Lp // Q_BLOCK
    scale = dk ** -0.5
    qb = q.reshape(B, H, nb, Q_BLOCK, dk).transpose(2, 0, 1, 3, 4)

    def one_block(args):
        q_blk, blk = args
        s = jnp.einsum('bhqd,bhkd->bhqk', q_blk, k).astype(F32) * scale
        p = jax.nn.softmax(score_mod(s, blk * Q_BLOCK), axis=-1)
        return jnp.einsum('bhqk,bhkd->bhqd', p.astype(v.dtype), v)

    o = lax.map(one_block, (qb, jnp.arange(nb)))
    return o.transpose(1, 2, 0, 3, 4).reshape(B, H, Lp, v.shape[-1])


def _linear_combine(e1, e2):
    a1, b1 = e1
    a2, b2 = e2
    return a1 * a2, a2 * b1 + b2


def rglru_mixer(xb, gb, conv_w, conv_b, wa, ba, wx, bx, lam):
    B, Lp, W = xb.shape
    xp = jnp.pad(xb, ((0, 0), (CONV_WIDTH - 1, 0), (0, 0)))
    u = conv_b + xp[:, 0:Lp] * conv_w[0]
    for j in range(1, CONV_WIDTH):
        u = u + xp[:, j:j + Lp] * conv_w[j]
    ub = u.reshape(B, Lp, LRU_BLOCKS, LRU_BLOCK)
    r = jax.nn.sigmoid(jnp.einsum('blnc,ncd->blnd', ub, wa) + ba).reshape(B, Lp, W)
    i = jax.nn.sigmoid(jnp.einsum('blnc,ncd->blnd', ub, wx) + bx).reshape(B, Lp, W)
    log_a = -LRU_C * r.astype(F32) * jax.nn.softplus(-lam.astype(F32))
    a = jnp.exp(log_a)
    b = jnp.sqrt(-jnp.expm1(2.0 * log_a)) * (i * u).astype(F32)
    _, h = lax.associative_scan(_linear_combine, (a, b), axis=1)
    return h.astype(xb.dtype) * jax.nn.gelu(gb)


def hgrn2_mixer(q, fz, v, g, lb):
    B, Lp, _ = q.shape
    nc = Lp // HG_CHUNK
    logf = jnp.logaddexp(jnp.log(lb), jnp.log1p(-lb) + jax.nn.log_sigmoid(fz.astype(F32)))
    k = -jnp.expm1(logf)

    def heads(t, d):
        return t.reshape(B, nc, HG_CHUNK, HG_HEADS, d).transpose(0, 3, 1, 2, 4)

    qh = heads(q.astype(F32), HG_DK)
    kh = heads(k, HG_DK)
    lfh = heads(logf, HG_DK)
    vh = heads(v.astype(F32), HG_DV)
    b = jnp.cumsum(lfh, axis=3)
    b_end = b[:, :, :, -1:, :]
    q_dec = qh * jnp.exp(b)
    k_dec = kh * jnp.exp(-b)
    tri = jnp.tril(jnp.ones((HG_CHUNK, HG_CHUNK), dtype=bool))
    att = jnp.where(tri, jnp.einsum('bhntd,bhnsd->bhnts', q_dec, k_dec), 0.0)
    o_intra = jnp.einsum('bhnts,bhnsv->bhntv', att, vh)
    u_chunk = jnp.einsum('bhnsd,bhnsv->bhndv', kh * jnp.exp(b_end - b), vh)
    dec_chunk = jnp.exp(b_end[:, :, :, 0, :])

    def step(S, inp):
        dec, uc = inp
        return dec[..., None] * S + uc, S

    S0 = jnp.zeros((B, HG_HEADS, HG_DK, HG_DV), F32)
    _, S_prev = lax.scan(step, S0, (jnp.moveaxis(dec_chunk, 2, 0), jnp.moveaxis(u_chunk, 2, 0)))
    o_inter = jnp.einsum('bhntd,nbhdv->bhntv', q_dec, S_prev)
    o = (o_intra + o_inter).transpose(0, 2, 3, 1, 4).reshape(B, Lp, HG_HEADS * HG_DV)
    return o.astype(g.dtype) * jax.nn.silu(g)


def mla_mixer(cq, ckv, kr, pos, cid, gq, w_uq, gkv, w_ukv, gqn, gkn):
    B, Lp, _ = cq.shape
    q = (rmsnorm(cq, gq) @ w_uq).reshape(B, Lp, MLA_HEADS, MLA_NOPE + MLA_ROPE)
    kv = (rmsnorm(ckv, gkv) @ w_ukv).reshape(B, Lp, MLA_HEADS, MLA_NOPE + MLA_V)
    k_nope, v = kv[..., :MLA_NOPE], kv[..., MLA_NOPE:]
    k = jnp.concatenate([k_nope, jnp.broadcast_to(kr[:, :, None, :], (B, Lp, MLA_HEADS, MLA_ROPE))], axis=-1)
    q = rmsnorm(q, gqn)
    k = rmsnorm(k, gkn)
    q = jnp.concatenate([q[..., :MLA_NOPE], rope(q[..., MLA_NOPE:], pos)], axis=-1)
    k = jnp.concatenate([k[..., :MLA_NOPE], rope(k[..., MLA_NOPE:], pos)], axis=-1)

    def chunk_mask(s, q0):
        qc = lax.dynamic_slice_in_dim(cid, q0, Q_BLOCK)
        return jnp.where(cid[None, :] <= qc[:, None], s, -jnp.inf)

    o = blocked_attention(q.transpose(0, 2, 1, 3), k.transpose(0, 2, 1, 3),
                          v.transpose(0, 2, 1, 3), chunk_mask)
    return o.transpose(0, 2, 1, 3).reshape(B, Lp, MLA_HEADS * MLA_V)


def fox_mixer(q, k, v, fz, pos, bf, gqn, gkn):
    B, Lp, _ = q.shape

    def heads(t):
        return t.reshape(B, Lp, FOX_HEADS, FOX_HD)

    qh = rmsnorm(heads(q), gqn).transpose(0, 2, 1, 3)
    kh = rmsnorm(heads(k), gkn).transpose(0, 2, 1, 3)
    vh = heads(v).transpose(0, 2, 1, 3)
    logf = jax.nn.log_sigmoid((fz + bf).astype(F32))
    c = jnp.cumsum(logf, axis=1).transpose(0, 2, 1)

    def decay_mask(s, q0):
        cq = lax.dynamic_slice_in_dim(c, q0, Q_BLOCK, axis=2)
        qp = q0 + jnp.arange(Q_BLOCK)
        bias = cq[..., :, None] - c[..., None, :]
        return jnp.where(pos[None, :] <= qp[:, None], s + bias, -jnp.inf)

    o = blocked_attention(qh, kh, vh, decay_mask)
    return o.transpose(0, 2, 1, 3).reshape(B, Lp, FOX_HEADS * FOX_HD)


def swiglu(u, wg, wu, wd):
    return (jax.nn.silu(u @ wg) * (u @ wu)) @ wd


def moe_swiglu(u, w_router, w_gate, w_up, w_down):
    logits = jnp.einsum('bld,de->ble', u, w_router).astype(F32)
    top_v, top_i = lax.top_k(logits, TOP_K)
    gates = jax.nn.softmax(top_v, axis=-1)
    dense_gate = jnp.sum(jax.nn.one_hot(top_i, N_EXPERTS, dtype=F32) * gates[..., None], axis=-2)
    out = jnp.zeros_like(u)
    for e in range(N_EXPERTS):
        ye = swiglu(u, w_gate[e], w_up[e], w_down[e])
        out = out + dense_gate[..., e:e + 1].astype(u.dtype) * ye
    return out


def setup_inputs(seed: int = 0) -> dict:
    key = jax.random.key(seed)
    it = iter(jax.random.split(key, 40))

    def nrm(shape, scale):
        return jax.random.normal(next(it), shape, F32) * scale

    def gain(shape):
        return 1.0 + nrm(shape, 0.05)

    u = jax.random.uniform(next(it), (DEPTH, LRU_WIDTH), F32, minval=0.9, maxval=0.999)
    a0 = u ** (1.0 / LRU_C)
    lru_lambda = jnp.log(a0) - jnp.log1p(-a0)
    return {
        "x": nrm((BATCH, SEQ, D_MODEL), 1.0),
        "meta": nrm((N_META, D_MODEL), 1.0),
        "norm1_g": gain((DEPTH, D_MODEL)),
        "norm2_g": gain((DEPTH, D_MODEL)),
        "w_in": nrm((DEPTH, D_MODEL, IN_COLS), D_MODEL ** -0.5),
        "w_out": nrm((DEPTH, D_MIX, D_MODEL), D_MIX ** -0.5),
        "out_norm_g": gain((DEPTH, D_MIX)),
        "lru_conv_w": nrm((DEPTH, CONV_WIDTH, LRU_WIDTH), CONV_WIDTH ** -0.5),
        "lru_conv_b": nrm((DEPTH, LRU_WIDTH), 0.02),
        "lru_wa": nrm((DEPTH, LRU_BLOCKS, LRU_BLOCK, LRU_BLOCK), LRU_BLOCK ** -0.5),
        "lru_ba": nrm((DEPTH, LRU_BLOCKS, LRU_BLOCK), 0.02),
        "lru_wx": nrm((DEPTH, LRU_BLOCKS, LRU_BLOCK, LRU_BLOCK), LRU_BLOCK ** -0.5),
        "lru_bx": nrm((DEPTH, LRU_BLOCKS, LRU_BLOCK), 0.02),
        "lru_lambda": lru_lambda,
        "hg_lb_logits": nrm((DEPTH, HG_HEADS * HG_DK), 1.0),
        "mla_gq": gain((DEPTH, MLA_Q_RANK)),
        "mla_w_uq": nrm((DEPTH, MLA_Q_RANK, MLA_HEADS * (MLA_NOPE + MLA_ROPE)), MLA_Q_RANK ** -0.5),
        "mla_gkv": gain((DEPTH, MLA_KV_RANK)),
        "mla_w_ukv": nrm((DEPTH, MLA_KV_RANK, MLA_HEADS * (MLA_NOPE + MLA_V)), MLA_KV_RANK ** -0.5),
        "mla_gqn": gain((DEPTH, MLA_NOPE + MLA_ROPE)),
        "mla_gkn": gain((DEPTH, MLA_NOPE + MLA_ROPE)),
        "fox_gqn": gain((DEPTH, FOX_HD)),
        "fox_gkn": gain((DEPTH, FOX_HD)),
        "fox_bf": 2.0 + nrm((DEPTH, FOX_HEADS), 0.5),
        "ffn_w_gate": nrm((N_DENSE, D_MODEL, D_FF), D_MODEL ** -0.5),
        "ffn_w_up": nrm((N_DENSE, D_MODEL, D_FF), D_MODEL ** -0.5),
        "ffn_w_down": nrm((N_DENSE, D_FF, D_MODEL), D_FF ** -0.5),
        "moe_w_router": nrm((N_MOE, D_MODEL, N_EXPERTS), D_MODEL ** -0.5),
        "moe_w_gate": nrm((N_MOE, N_EXPERTS, D_MODEL, D_FF_EXPERT), D_MODEL ** -0.5),
        "moe_w_up": nrm((N_MOE, N_EXPERTS, D_MODEL, D_FF_EXPERT), D_MODEL ** -0.5),
        "moe_w_down": nrm((N_MOE, N_EXPERTS, D_FF_EXPERT, D_MODEL), D_FF_EXPERT ** -0.5),
    }


def reference(x, meta, norm1_g, norm2_g, w_in, w_out, out_norm_g,
              lru_conv_w, lru_conv_b, lru_wa, lru_ba, lru_wx, lru_bx, lru_lambda,
              hg_lb_logits,
              mla_gq, mla_w_uq, mla_gkv, mla_w_ukv, mla_gqn, mla_gkn,
              fox_gqn, fox_gkn, fox_bf,
              ffn_w_gate, ffn_w_up, ffn_w_down,
              moe_w_router, moe_w_gate, moe_w_up, moe_w_down):
    B = x.shape[0]
    L = N_META + x.shape[1]
    Lp = -(-L // Q_BLOCK) * Q_BLOCK
    h = jnp.concatenate([jnp.broadcast_to(meta[None].astype(x.dtype), (B, N_META, D_MODEL)), x], axis=1)
    h = jnp.pad(h, ((0, 0), (0, Lp - L), (0, 0)))
    pos = jnp.arange(Lp, dtype=jnp.int32)
    cid = chunk_ids(pos)
    lb_cum = jnp.cumsum(jax.nn.softmax(hg_lb_logits.astype(F32), axis=0), axis=0)
    split_at = np.cumsum(IN_SIZES)[:-1].tolist()
    for l in range(DEPTH):
        u = rmsnorm(h, norm1_g[l])
        z = u @ w_in[l]
        (xa, ga, hq, hf, hi, hg, cq, ckv, kr, fq, fk, fv, ff) = jnp.split(z, split_at, axis=-1)
        ya = rglru_mixer(xa, ga, lru_conv_w[l], lru_conv_b[l], lru_wa[l], lru_ba[l],
                         lru_wx[l], lru_bx[l], lru_lambda[l])
        yb = hgrn2_mixer(hq, hf, hi, hg, lb_cum[l] - lb_cum[0])
        yc = mla_mixer(cq, ckv, kr, pos, cid, mla_gq[l], mla_w_uq[l], mla_gkv[l], mla_w_ukv[l],
                       mla_gqn[l], mla_gkn[l])
        yd = fox_mixer(fq, fk, fv, ff, pos, fox_bf[l], fox_gqn[l], fox_gkn[l])
        y = group_rmsnorm(jnp.concatenate([ya, yb, yc, yd], axis=-1), out_norm_g[l])
        h = h + y @ w_out[l]
        u = rmsnorm(h, norm2_g[l])
        if l % 2 == 0:
            h = h + swiglu(u, ffn_w_gate[l // 2], ffn_w_up[l // 2], ffn_w_down[l // 2])
        else:
            h = h + moe_swiglu(u, moe_w_router[l // 2], moe_w_gate[l // 2],
                               moe_w_up[l // 2], moe_w_down[l // 2])
    return h[:, N_META:L]
```

```cpp
#include <hip/hip_runtime.h>
#include <cstdint>
#include <cstdio>

#define LAS __attribute__((address_space(3)))
#define GAS __attribute__((address_space(1)))
#define DI __device__ __forceinline__
typedef unsigned short bf16_t;
typedef short bf16x8 __attribute__((ext_vector_type(8)));
typedef short s16x4 __attribute__((ext_vector_type(4)));
typedef float f32x2 __attribute__((ext_vector_type(2)));
typedef int i32x4 __attribute__((ext_vector_type(4)));
typedef float f32x4 __attribute__((ext_vector_type(4)));
typedef float f32x16 __attribute__((ext_vector_type(16)));
typedef unsigned u32x2 __attribute__((ext_vector_type(2)));
typedef unsigned u32x4 __attribute__((ext_vector_type(4)));
typedef __bf16 bf16x2_t __attribute__((ext_vector_type(2)));

#ifndef STAGE
#define STAGE 2
#endif
#if STAGE >= 2
#define NLAYER 2
#else
#define NLAYER 1
#endif

constexpr int NB = 4, SEQ = 8192, D = 1024, NR = NB * SEQ;
constexpr int MB0 = NR, META_OFF = 48, NMETA = 16;
constexpr int MROW0 = MB0 + META_OFF;
constexpr int TM = NR + 256;
constexpr int ZC = 2816;
constexpr float EPS = 1e-6f;
constexpr int ZC_XA = 0, ZC_GA = 256, ZC_HQ = 512, ZC_HF = 768, ZC_HV = 1024, ZC_HG = 1280, ZC_CQ = 1536, ZC_CKV = 1792, ZC_KR = 1920, ZC_FF = 1952, ZC_FQ = 2048, ZC_FK = 2304, ZC_FV = 2560;
constexpr int Y_LRU = 0, Y_HG = 256, Y_MLA = 512, Y_FOX = 768;
constexpr int DFF = 2816, DFE = 3584, NEXP = 8;
constexpr int NSEG = 128;

constexpr size_t MiB = 1u << 20;
constexpr size_t WS_CTL = 0, CTL_BYTES = 8 * MiB;
constexpr size_t WS_WIN = 8 * MiB;
constexpr size_t WS_WOUT = 19 * MiB;
constexpr size_t WS_WGU = 23 * MiB;
constexpr size_t WS_WD = 34 * MiB;
constexpr size_t WS_WSM = 40 * MiB;
constexpr size_t WS_BUFA = 41 * MiB;
constexpr size_t WS_BUFB = 106 * MiB;
constexpr size_t WS_Z = 171 * MiB;
constexpr size_t WS_ATT = 349 * MiB;
constexpr size_t WS_LRU = 430 * MiB;
constexpr size_t WS_HG = 465 * MiB;
constexpr size_t WS_SSP = 499 * MiB;
constexpr size_t WS_GSP = 503 * MiB;
constexpr size_t WS_END = 508 * MiB;
constexpr size_t SM_LRUW = 0;
constexpr size_t SM_WUQ = 131072;
constexpr size_t SM_WUKV = 131072 + 294912;
constexpr size_t SM_ROPE = 131072 + 294912 + 262144;
constexpr int CW_BAR = 4096;
constexpr int CW_SS = 16384;
constexpr int CW_GSS = CW_SS + 3 * TM;
constexpr int CW_ENDW = CW_GSS + 2 * TM * 4;
static_assert((size_t)CW_ENDW * 4 <= CTL_BYTES, "ctl");
constexpr size_t LRU_LA = 0, LRU_BC = (size_t)TM * 256 * 2, LRU_AGGA = 2 * (size_t)TM * 256 * 2, LRU_AGGB = LRU_AGGA + (size_t)(NB * NSEG + 1) * 256 * 4, LRU_HIN = LRU_AGGB + (size_t)(NB * NSEG + 1) * 256 * 4;
static_assert(LRU_HIN + (size_t)(NB * NSEG + 1) * 256 * 4 <= 35 * MiB, "lru");
constexpr int HG_SLOTS = NB * 4 * NSEG + 4;
constexpr size_t HG_UT = 0, HG_DL = (size_t)HG_SLOTS * 4096 * 4;
static_assert(HG_DL + (size_t)HG_SLOTS * 64 * 4 <= 34 * MiB, "hg");
constexpr size_t AT_MQ = 0, AT_MK = (size_t)TM * 384 * 2, AT_MVT = 2 * (size_t)TM * 384 * 2, AT_FVT = AT_MVT + (size_t)256 * TM * 2, AT_END = AT_FVT + (size_t)256 * TM * 2;
static_assert(AT_END <= 81 * MiB, "att");
constexpr size_t LRU_FC = ((LRU_HIN + (size_t)(NB * NSEG + 1) * 256 * 4 + 255) / 256) * 256, LRU_FLF = LRU_FC + (size_t)4 * TM * 4;
constexpr size_t LRU_FJ0 = LRU_FLF + (size_t)4 * TM * 4;
static_assert(LRU_HIN + (size_t)(NB * NSEG + 1) * 256 * 4 <= LRU_FC && LRU_FJ0 + 4 * 4 * 32 * 4 <= 35 * MiB, "lru2");
constexpr size_t HG_ROPE = 33 * MiB - 256 * 1024;
static_assert(HG_DL + (size_t)HG_SLOTS * 64 * 4 <= HG_ROPE && HG_ROPE + (size_t)8208 * 16 * 8 <= 34 * MiB, "hg2");

constexpr size_t WS_MGU = 106 * MiB;
constexpr size_t WS_MD = 162 * MiB;
constexpr size_t WS_MACT = 190 * MiB;
static_assert(WS_MACT + (size_t)136 * 256 * DFE <= WS_LRU, "moe act");
constexpr size_t WS_MAS = 309 * MiB;
static_assert(WS_MAS + (size_t)2 * 136 * 256 * 1024 <= WS_LRU, "moe sorted A");
constexpr size_t WS_H8 = 377 * MiB;
static_assert(WS_MAS + (size_t)2 * 136 * 256 * 1024 <= WS_H8 && WS_H8 + (size_t)NR * 1024 <= WS_LRU, "h8");
constexpr size_t WS_FGU8 = 409 * MiB, WS_FD8 = 415 * MiB;
static_assert(WS_FD8 + (size_t)D * DFF <= WS_LRU, "ffn fp8");
constexpr size_t WS_MACT1 = 377 * MiB;
static_assert(WS_MACT1 + (size_t)136 * 256 * DFE <= WS_SSP, "moe act1");
constexpr float W8_SCALE = 256.f, ACT8_SCALE = 16.f;
constexpr size_t WS_TOKREC = 497 * MiB, WS_PAIRH = 498 * MiB;
constexpr size_t CTL_LIST = 2 * MiB, CTL_LRS = 4 * MiB, CTL_LGATE = 6 * MiB;
constexpr int CW_MCNT = CW_ENDW + 64;
constexpr size_t WS_HMETA = WS_GSP + 4456448;
static_assert(2 * (size_t)TM * 16 * 4 <= 4456448 && WS_HMETA + 2 * 16 * 1024 * 4 <= WS_END && (size_t)(CW_MCNT + 16) * 4 <= CTL_LIST, "misc");

constexpr int RING_BYTES = 131072;
constexpr int GST_OFF = RING_BYTES, GST_BYTES = 24576;
constexpr int MISC_OFF = GST_OFF + GST_BYTES;
constexpr int LDS_BYTES = MISC_OFF + 512;

DI unsigned cvtpk(float lo, float hi) { f32x2 v = {lo, hi}; bf16x2_t b = __builtin_convertvector(v, bf16x2_t); return __builtin_bit_cast(unsigned, b); }
DI bf16_t f2bf(float f) { return (bf16_t)(cvtpk(f, 0.f) & 0xffffu); }
DI float bf2f(bf16_t h) { return __uint_as_float(((unsigned)h) << 16); }
DI float bflo(unsigned w) { return __uint_as_float(w << 16); }
DI float bfhi(unsigned w) { return __uint_as_float(w & 0xffff0000u); }
DI float clamp8(float x) { return __builtin_amdgcn_fmed3f(x, -440.f, 440.f); }
DI unsigned pk4_fp8(float a, float b, float c, float d) { unsigned w = __builtin_amdgcn_cvt_pk_fp8_f32(clamp8(a), clamp8(b), 0u, false); return __builtin_amdgcn_cvt_pk_fp8_f32(clamp8(c), clamp8(d), w, true); }
DI u32x2 swiglu8_fp8(const f32x4 g0, const f32x4 g1, const f32x4 u0, const f32x4 u1, float rs) {
    const float rsu = rs * ACT8_SCALE; f32x2 a[4];
#pragma unroll
    for (int q = 0; q < 4; ++q) { const f32x4 gv = q < 2 ? g0 : g1, uv = q < 2 ? u0 : u1; const int o = 2 * (q & 1);
        const f32x2 g = (f32x2){gv[o], gv[o + 1]} * rs, u = (f32x2){uv[o], uv[o + 1]} * rsu, t = g * -1.4426950408889634f;
        const f32x2 d = (f32x2){__builtin_amdgcn_exp2f(t.x), __builtin_amdgcn_exp2f(t.y)} + 1.f;
        a[q] = (g * u) * (f32x2){__builtin_amdgcn_rcpf(d.x), __builtin_amdgcn_rcpf(d.y)}; }
    u32x2 w; w.x = pk4_fp8(a[0].x, a[0].y, a[1].x, a[1].y); w.y = pk4_fp8(a[2].x, a[2].y, a[3].x, a[3].y); return w;
}
DI u32x4 zero4() { unsigned z = 0u; asm volatile("" : "+v"(z)); return (u32x4){z, z, z, z}; }
DI float wave_sum(float v) {
#pragma unroll
    for (int o = 1; o < 64; o <<= 1) v += __shfl_xor(v, o);
    return v;
}
constexpr int TIDTAB_LDS = 131072 + 24576 + 256;
DI int fresh_tid() {
    const int slot = (int)(__builtin_amdgcn_s_getreg((5 << 11) | 4) & 63u);
    const int w = __builtin_amdgcn_readfirstlane(*(volatile LAS int*)(unsigned)(TIDTAB_LDS + 4 * slot));
    int l0 = 0; asm volatile("v_mbcnt_lo_u32_b32 %0, -1, 0\n\tv_mbcnt_hi_u32_b32 %0, -1, %0" : "=v"(l0));
    return w * 64 + l0;
}
DI float sigmoidf_(float x) { return __builtin_amdgcn_rcpf(1.f + __expf(-x)); }
DI float gelu_tanh(float x) { const float u = 0.7978845608028654f * (x + 0.044715f * x * x * x); const float e = __expf(2.f * u); const float t = 1.f - 2.f * __builtin_amdgcn_rcpf(e + 1.f); return 0.5f * x * (1.f + t); }
#define LDS_WAIT() asm volatile("s_waitcnt lgkmcnt(0)" ::: "memory")
#define VM_WAIT() asm volatile("s_waitcnt vmcnt(0)" ::: "memory")

#define XB_TMO      128
#define XB_XCNT(j)  (256  + 64 * (j))
#define XB_XSUB(j)  (1280 + 64 * (j))
#define XB_XGEN(j)  (2304 + 64 * (j))
#define XB_TOP      3328
#define XB_TOPGEN   3392
#define XCD_BAR_WORDS 3456
#define XB_SPIN_CAP (1u << 22)
DI unsigned xb_ld(unsigned* p)              { return __hip_atomic_load(p, __ATOMIC_RELAXED, __HIP_MEMORY_SCOPE_AGENT); }
DI unsigned xb_add(unsigned* p, unsigned v) { return __hip_atomic_fetch_add(p, v, __ATOMIC_RELAXED, __HIP_MEMORY_SCOPE_AGENT); }
DI unsigned xb_xcc_id() { return (unsigned)__builtin_amdgcn_s_getreg((3 << 11) | 20) & 0xFu; }
#define XB_SPIN(cond, bar) do { unsigned _sp = 0; while (cond) { __builtin_amdgcn_s_sleep(1); \
    if ((++_sp & 255u) == 0u) { if (xb_ld(&(bar)[XB_TMO])) break; if (_sp > XB_SPIN_CAP) { atomicAdd(&(bar)[XB_TMO], 1u); break; } } } } while (0)
struct XcdBarrier { unsigned* bar; unsigned x; volatile LAS unsigned* st; };
DI XcdBarrier xcd_barrier_post(unsigned* bar, volatile LAS unsigned* st) {
    XcdBarrier b; b.bar = bar; b.x = xb_xcc_id(); b.st = st;
    if (fresh_tid() == 0) (void)xb_add(&bar[XB_XCNT(b.x)], 1u);
    return b;
}
DI void xcd_barrier_complete(unsigned* bar, unsigned x, unsigned& nloc, unsigned& nx) {
    const unsigned G = gridDim.x * gridDim.y * gridDim.z;
    unsigned sum, cnt, mine, sp = 0u;
    for (;;) {
        sum = 0u; cnt = 0u; mine = 0u;
#pragma unroll
        for (unsigned j = 0; j < 16; ++j) { const unsigned c = xb_ld(&bar[XB_XCNT(j)]); sum += c; cnt += (c > 0u) ? 1u : 0u; mine = (j == x) ? c : mine; }
        if (sum == G) break;
        __builtin_amdgcn_s_sleep(1);
        if ((++sp & 255u) == 0u) { if (xb_ld(&bar[XB_TMO])) break; if (sp > XB_SPIN_CAP) { atomicAdd(&bar[XB_TMO], 1u); break; } }
    }
    nloc = mine > 0u ? mine : 1u; nx = cnt > 0u ? cnt : 1u;
}
DI void xcd_barrier(const XcdBarrier& b) {
    asm volatile("s_waitcnt vmcnt(0)" ::: "memory");
    __syncthreads();
    if (fresh_tid() == 0) {
        unsigned* bar = b.bar; unsigned bx_ = b.x; asm volatile("" : "+s"(bx_), "+s"(bar));
        __builtin_amdgcn_s_waitcnt(0);
        unsigned nloc = b.st[0], nx = b.st[1];
        if (nloc == 0u) { xcd_barrier_complete(bar, bx_, nloc, nx); b.st[0] = nloc; b.st[1] = nx; }
        const unsigned old = xb_add(&bar[XB_XSUB(bx_)], 1u);
        const unsigned gen = old / nloc;
        if (old + 1u == (gen + 1u) * nloc) {
            __builtin_amdgcn_fence(__ATOMIC_RELEASE, "agent");
            asm volatile("s_waitcnt vmcnt(0)" ::: "memory");
            const unsigned og = xb_add(&bar[XB_TOP], 1u);
            const unsigned tg = og / nx;
            if (og + 1u == (tg + 1u) * nx) xb_add(&bar[XB_TOPGEN], 1u);
            else XB_SPIN(xb_ld(&bar[XB_TOPGEN]) == tg, bar);
            __builtin_amdgcn_fence(__ATOMIC_ACQUIRE, "agent");
            xb_add(&bar[XB_XGEN(bx_)], 1u);
            asm volatile("s_waitcnt vmcnt(0)" ::: "memory");
        } else {
            XB_SPIN(xb_ld(&bar[XB_XGEN(bx_)]) == gen, bar);
            __builtin_amdgcn_fence(__ATOMIC_ACQUIRE, "agent");
            asm volatile("s_waitcnt vmcnt(0)" ::: "memory");
        }
    }
    __syncthreads();
}

namespace pg8 {
typedef int v8i_t __attribute__((ext_vector_type(8))); typedef int v4i_t __attribute__((ext_vector_type(4)));
DI void mfma8(f32x4& c, v8i_t b, v8i_t a) { asm volatile("v_mfma_f32_16x16x128_f8f6f4 %0, %1, %2, %0" : "+v"(c) : "v"(b), "v"(a)); }
DI v8i_t cat8(bf16x8 a, bf16x8 b) { const v4i_t x = __builtin_bit_cast(v4i_t, a), y = __builtin_bit_cast(v4i_t, b); return __builtin_shufflevector(x, y, 0, 1, 2, 3, 4, 5, 6, 7); }
constexpr int BM = 256, BK = 64, HALF = 128, HTB = HALF * BK * 2, STAGE_BYTES = 8 * HTB;
__host__ __device__ __forceinline__ int lds_byte(int r, int c) { const int st = (r >> 4) * 2 + (c >> 5), rr = r & 15, cc = c & 31, ob = rr * 64 + cc * 2; return st * 1024 + (ob ^ (((ob >> 9) & 1) << 5)); }
__host__ __device__ __forceinline__ void stage_rc(int b, int& R, int& C) { const int st = b / 1024, sb = b % 1024, swz = sb ^ (((sb >> 9) & 1) << 5); R = (st >> 1) * 16 + swz / 64; C = (st & 1) * 32 + (swz % 64) / 2; }
__host__ __device__ __forceinline__ int perm32(int rho) { const int n = rho >> 4, i = rho & 15; return 8 * (i >> 2) + 4 * n + (i & 3); }
struct Unit { int pm, pn, e; };

template <class Epi, class Sched, bool GATHER, bool GS, bool FP8 = false>
DI void gemm_phase(LAS unsigned char* lds, const int lda, const int K, const Sched& S, const Epi& E, const LAS float* gstab) {
    const int tid = fresh_tid(), wid = __builtin_amdgcn_readfirstlane(tid >> 6), lane = tid & 63, wr = wid >> 2, wc = wid & 3, fr = lane & 15, fq = lane >> 4;
    const int nt = K / BK;
    unsigned voffA0[2], voffA1[2], voffB[2], nvA0[2], nvA1[2]; int RA[2], CA[2];
#pragma unroll
    for (int i = 0; i < 2; ++i) { int R, C; stage_rc(tid * 16 + i * 8192, R, C); const int Rb = (R & ~31) + perm32(R & 31);
        RA[i] = R; CA[i] = C * 2; voffA0[i] = (unsigned)(R * lda + C) * 2u; voffA1[i] = (unsigned)((R + HALF) * lda + C) * 2u; voffB[i] = (unsigned)(Rb * K + C) * 2u; nvA0[i] = voffA0[i]; nvA1[i] = voffA1[i]; }
    const size_t kstep = (size_t)(BK * 2);
    const size_t hstepB = (size_t)HALF * K * 2;
    const size_t hstepA = (size_t)HALF * lda * 2;
    const size_t q64A = (size_t)64 * lda * 2, q64B = (size_t)64 * K * 2;
    const unsigned ldsw = (unsigned)wid * 1024u;
    const int aoff = lds_byte(wr * 64 + fr, fq * 8), boff = lds_byte(wc * 32 + fr, fq * 8);
#define PG8_SA(b, h) (((b) * 2 + (h)) * HTB)
#define PG8_SB(b, h) ((4 + (b) * 2 + (h)) * HTB)
#define PG8_STAGE2(bufoff, gbase, o0, o1) do { \
        __builtin_amdgcn_global_load_lds((const unsigned*)((const char*)(gbase) + (o0)), (LAS unsigned*)(lds + (bufoff) + ldsw), 16, 0, 0); \
        __builtin_amdgcn_global_load_lds((const unsigned*)((const char*)(gbase) + (o1)), (LAS unsigned*)(lds + (bufoff) + ldsw + 8192), 16, 0, 0); } while (0)
#define PG8_STAGE_B(bufoff, gbase) do { \
        __builtin_amdgcn_global_load_lds((const unsigned*)((const char*)(gbase) + voffB[0]), (LAS unsigned*)(lds + (bufoff) + ldsw), 16, 0, 0); \
        __builtin_amdgcn_global_load_lds((const unsigned*)((const char*)(gbase) + q64B + voffB[0]), (LAS unsigned*)(lds + (bufoff) + ldsw + 8192), 16, 0, 0); } while (0)
#define PG8_STAGE_A0(bufoff, gbase, o0, o1) do { if constexpr (GATHER) PG8_STAGE2(bufoff, gbase, o0, o1); else { \
        __builtin_amdgcn_global_load_lds((const unsigned*)((const char*)(gbase) + (o0)), (LAS unsigned*)(lds + (bufoff) + ldsw), 16, 0, 0); \
        __builtin_amdgcn_global_load_lds((const unsigned*)((const char*)(gbase) + q64A + (o0)), (LAS unsigned*)(lds + (bufoff) + ldsw + 8192), 16, 0, 0); } } while (0)
#define PG8_STAGE_A1(bufoff, gbase, o0, o1, p0, p1) do { if constexpr (GATHER) PG8_STAGE2(bufoff, gbase, o0, o1); else PG8_STAGE_A0(bufoff, (gbase) + hstepA, p0, p1); } while (0)
#define PG8_LDA(dst, b, h) do { _Pragma("unroll") for (int m = 0; m < 4; ++m) _Pragma("unroll") for (int k = 0; k < 2; ++k) dst[m][k] = *(const LAS bf16x8*)(lds + PG8_SA(b, h) + aoff + m * 2048 + k * 1024); } while (0)
#define PG8_LDB(dst, b, h) do { _Pragma("unroll") for (int n = 0; n < 2; ++n) _Pragma("unroll") for (int k = 0; k < 2; ++k) dst[n][k] = *(const LAS bf16x8*)(lds + PG8_SB(b, h) + boff + n * 2048 + k * 1024); } while (0)
#define PG8_MMA(ai, bj, At, Bt) do { __builtin_amdgcn_s_setprio(1); _Pragma("unroll") for (int m = 0; m < 4; ++m) _Pragma("unroll") for (int n = 0; n < 2; ++n) { \
        if constexpr (FP8) { mfma8(acc[ai][bj][m][n], cat8(Bt[n][0], Bt[n][1]), cat8(At[m][0], At[m][1])); } \
        else { _Pragma("unroll") for (int k = 0; k < 2; ++k) acc[ai][bj][m][n] = __builtin_amdgcn_mfma_f32_16x16x32_bf16(Bt[n][k], At[m][k], acc[ai][bj][m][n], 0, 0, 0); } } if constexpr (FP8) asm volatile("s_nop 7\n\ts_nop 7" ::: "memory"); __builtin_amdgcn_s_setprio(0); } while (0)
#define PG8_WAIT_V(n) asm volatile("s_waitcnt vmcnt(" #n ")" ::: "memory")
#define PG8_WAIT_L(n) asm volatile("s_waitcnt lgkmcnt(" #n ")" ::: "memory")
#define PG8_BAR __builtin_amdgcn_s_barrier()
#define PG8_SCHED __builtin_amdgcn_sched_barrier(0)
    Unit cur, nxt; int ui = 0;
    if (!S.next(0, cur)) return;
    f32x4 acc[2][2][4][2];
#pragma unroll
    for (int a = 0; a < 2; ++a)
#pragma unroll
        for (int b = 0; b < 2; ++b)
#pragma unroll
            for (int m = 0; m < 4; ++m)
#pragma unroll
                for (int n = 0; n < 2; ++n) acc[a][b][m][n] = (f32x4){0.f, 0.f, 0.f, 0.f};
    bf16x8 At[4][2], B0[2][2], B1[2][2];
    const char* cA = S.abase(cur); const char* cB = S.bbase(cur);
    if constexpr (GATHER) {
#pragma unroll
        for (int i = 0; i < 2; ++i) { voffA0[i] = S.arow_off(cur, RA[i]) + (unsigned)CA[i]; voffA1[i] = S.arow_off(cur, RA[i] + HALF) + (unsigned)CA[i]; nvA0[i] = voffA0[i]; nvA1[i] = voffA1[i]; }
    }
    PG8_STAGE_B(PG8_SB(0, 0), cB); PG8_STAGE_B(PG8_SB(0, 1), cB + hstepB); PG8_STAGE_A0(PG8_SA(0, 0), cA, voffA0[0], voffA0[1]); PG8_STAGE_A1(PG8_SA(0, 1), cA, voffA1[0], voffA1[1], voffA0[0], voffA0[1]);
    if (wr == 1) PG8_BAR;
    PG8_WAIT_V(2); PG8_BAR;
    PG8_STAGE_B(PG8_SB(1, 0), cB + kstep); PG8_STAGE_A0(PG8_SA(1, 0), cA + kstep, voffA0[0], voffA0[1]); PG8_STAGE_B(PG8_SB(1, 1), cB + hstepB + kstep);
    PG8_WAIT_V(6); PG8_BAR;
    for (;;) {
        const bool has_next = S.next(ui + 1, nxt);
        const char* nA = has_next ? S.abase(nxt) : cA; const char* nB = has_next ? S.bbase(nxt) : cB;
        for (int t = 0; t < nt; t += 2) {
            const bool last = (t == nt - 2);
            const char* a1 = cA + (size_t)(t + 1) * kstep;
            const char* a2 = last ? nA : cA + (size_t)(t + 2) * kstep; const char* b2 = last ? nB : cB + (size_t)(t + 2) * kstep;
            const char* a3 = a2 + kstep; const char* b3 = b2 + kstep;
            if constexpr (GATHER) {
                if (t == nt - 4) {
                    if (has_next) { const int tid2 = fresh_tid();
#pragma unroll
                        for (int i = 0; i < 2; ++i) { int R2, C2; stage_rc(tid2 * 16 + i * 8192, R2, C2); nvA0[i] = S.arow_off(nxt, R2) + (unsigned)(C2 * 2); nvA1[i] = S.arow_off(nxt, R2 + HALF) + (unsigned)(C2 * 2); }
                    } else {
#pragma unroll
                        for (int i = 0; i < 2; ++i) { nvA0[i] = voffA0[i]; nvA1[i] = voffA1[i]; }
                    }
                }
            }
            unsigned xo0[2], xo1[2];
#pragma unroll
            for (int i = 0; i < 2; ++i) { xo0[i] = (GATHER && last) ? nvA0[i] : voffA0[i]; xo1[i] = (GATHER && last) ? nvA1[i] : voffA1[i]; }
            if constexpr (GS) {
                PG8_SCHED;
                if (t != 0 && (t & 3) == 0) {
                    const int g = (t >> 2) - 1; const int fr2 = fresh_tid() & 15;
#pragma unroll
                    for (int ai = 0; ai < 2; ++ai)
#pragma unroll
                        for (int m = 0; m < 4; ++m) { const float f = gstab[((ui & 3) * 256 + ai * HALF + wr * 64 + m * 16 + fr2) * 4 + g];
#pragma unroll
                            for (int bj = 0; bj < 2; ++bj)
#pragma unroll
                                for (int n = 0; n < 2; ++n) acc[ai][bj][m][n] *= f; }
                }
                PG8_SCHED;
            }
            PG8_LDB(B0, 0, 0); PG8_LDB(B1, 0, 1); PG8_SCHED; PG8_LDA(At, 0, 0); PG8_STAGE_A1(PG8_SA(1, 1), a1, voffA1[0], voffA1[1], voffA0[0], voffA0[1]);
            PG8_WAIT_V(8); PG8_WAIT_L(0); PG8_BAR; PG8_MMA(0, 0, At, B0); PG8_MMA(0, 1, At, B1); PG8_BAR; PG8_SCHED;
            PG8_LDA(At, 0, 1); PG8_STAGE_B(PG8_SB(0, 0), b2); PG8_STAGE_B(PG8_SB(0, 1), b2 + hstepB); PG8_STAGE_A0(PG8_SA(0, 0), a2, xo0[0], xo0[1]);
            PG8_WAIT_V(8); PG8_WAIT_L(0); PG8_BAR; PG8_MMA(1, 0, At, B0); PG8_MMA(1, 1, At, B1); PG8_BAR; PG8_SCHED;
            PG8_LDB(B0, 1, 0); PG8_LDB(B1, 1, 1); PG8_SCHED; PG8_LDA(At, 1, 0); PG8_STAGE_A1(PG8_SA(0, 1), a2, xo1[0], xo1[1], xo0[0], xo0[1]);
            PG8_WAIT_V(8); PG8_WAIT_L(0); PG8_BAR; PG8_MMA(0, 0, At, B0); PG8_MMA(0, 1, At, B1); PG8_BAR; PG8_SCHED;
            PG8_LDA(At, 1, 1); PG8_STAGE_B(PG8_SB(1, 0), b3); PG8_STAGE_B(PG8_SB(1, 1), b3 + hstepB); PG8_STAGE_A0(PG8_SA(1, 0), a3, xo0[0], xo0[1]);
            PG8_WAIT_V(8); PG8_WAIT_L(0); PG8_BAR; PG8_MMA(1, 0, At, B0); PG8_MMA(1, 1, At, B1); PG8_BAR; PG8_SCHED;
        }
        if (wr == 0) PG8_BAR;
        if constexpr (FP8) asm volatile("s_nop 15\n\ts_nop 15" ::: "memory");
        { const int l2 = fresh_tid() & 63; E(acc, cur, ui, wr, wc, l2 & 15, l2 >> 4, gstab); }
        if (!has_next) break;
#pragma unroll
        for (int a = 0; a < 2; ++a)
#pragma unroll
            for (int b = 0; b < 2; ++b)
#pragma unroll
                for (int m = 0; m < 4; ++m)
#pragma unroll
                    for (int n = 0; n < 2; ++n) acc[a][b][m][n] = (f32x4){0.f, 0.f, 0.f, 0.f};
        cur = nxt; cA = nA; cB = nB; ++ui;
        if constexpr (GATHER) {
#pragma unroll
            for (int i = 0; i < 2; ++i) { voffA0[i] = nvA0[i]; voffA1[i] = nvA1[i]; }
        }
        if (wr == 1) PG8_BAR;
    }
    PG8_WAIT_V(0);
    PG8_BAR;
#undef PG8_SA
#undef PG8_SB
#undef PG8_STAGE2
#undef PG8_STAGE_B
#undef PG8_STAGE_A0
#undef PG8_STAGE_A1
#undef PG8_LDA
#undef PG8_LDB
#undef PG8_MMA
#undef PG8_WAIT_V
#undef PG8_WAIT_L
#undef PG8_BAR
#undef PG8_SCHED
}
}
using pg8::Unit;

constexpr int XR = 4;
struct SchedPlain {
    const char* A; const char* Bt; int lda, K, nM, nN, G, c;
    DI bool next(int i, Unit& u) const {
        const int U = nM * nN, U8 = (U + 7) >> 3, o = i * (G >> 3) + (c >> 3), L = (c & 7) * U8 + o; if (o >= U8 || L >= U) return false;
        const int grp = L / (XR * nN), rem = L - grp * (XR * nN), fm = grp * XR, gsz = (nM - fm) < XR ? (nM - fm) : XR;
        u.pm = fm + rem % gsz; u.pn = rem / gsz; u.e = 0; return true;
    }
    DI int xcnt(int x) const { const int U = nM * nN, U8 = (U + 7) >> 3; const int n = U - x * U8; return n < 0 ? 0 : (n > U8 ? U8 : n); }
    DI const char* abase(const Unit& u) const { return A + (size_t)u.pm * 256 * lda * 2; }
    DI const char* bbase(const Unit& u) const { return Bt + (size_t)u.pn * 256 * K * 2; }
    DI unsigned arow_off(const Unit&, int) const { return 0u; }
    DI void a_ready(const Unit&) const {}
};

DI float ss_sum(const float* ss, int row, int nslot) {
    if (nslot == 1) return ss[row];
    const f32x4* q = (const f32x4*)(ss + (size_t)row * 16); const f32x4 a = q[0], b = q[1], c = q[2], d = q[3];
    return (((a[0] + a[1]) + (a[2] + a[3])) + ((b[0] + b[1]) + (b[2] + b[3]))) + (((c[0] + c[1]) + (c[2] + c[3])) + ((d[0] + d[1]) + (d[2] + d[3])));
}
struct EpiZ {
    bf16_t* Z;
    DI void operator()(const f32x4 (&acc)[2][2][4][2], const Unit& u, int ui, int wr, int wc, int fr, int fq, const LAS float* rst) const {
        const int row0 = u.pm * 256 + wr * 64 + fr, col0 = u.pn * 256 + wc * 32 + 8 * fq;
#pragma unroll
        for (int ai = 0; ai < 2; ++ai)
#pragma unroll
            for (int m = 0; m < 4; ++m) { const int row = row0 + ai * 128 + m * 16; const float rs = rst[ui * 256 + ai * 128 + wr * 64 + m * 16 + fr];
                bf16_t* rowp = Z + (size_t)row * ZC + col0;
#pragma unroll
                for (int bj = 0; bj < 2; ++bj) { const f32x4 v0 = acc[ai][bj][m][0] * rs, v1 = acc[ai][bj][m][1] * rs; u32x4 w;
                    w.x = cvtpk(v0[0], v0[1]); w.y = cvtpk(v0[2], v0[3]); w.z = cvtpk(v1[0], v1[1]); w.w = cvtpk(v1[2], v1[3]); *(u32x4*)(rowp + bj * 128) = w; } }
    }
};
struct EpiRes {
    bf16_t* hb; float* ss_out; int gs; unsigned char* h8; float ascale;
    DI void operator()(const f32x4 (&acc)[2][2][4][2], const Unit& u, int ui, int wr, int wc, int fr, int fq, const LAS float* gstab) const {
        const int row0 = u.pm * 256 + wr * 64 + fr, col0 = u.pn * 256 + wc * 32 + 8 * fq;
#pragma unroll
        for (int ai = 0; ai < 2; ++ai) {
        u32x4 rw[1][4][2];
#pragma unroll
            for (int m = 0; m < 4; ++m)
#pragma unroll
                for (int bj = 0; bj < 2; ++bj) rw[0][m][bj] = *(const u32x4*)(hb + (size_t)(row0 + ai * 128 + m * 16) * D + col0 + bj * 128);
        asm volatile("" ::: "memory");
#pragma unroll
            for (int m = 0; m < 4; ++m) { const int row = row0 + ai * 128 + m * 16; const size_t off = (size_t)row * D + col0;
                const float f = gs ? gstab[((ui & 3) * 256 + ai * 128 + wr * 64 + m * 16 + fr) * 4 + 3] : ascale; float sq = 0.f;
#pragma unroll
                for (int bj = 0; bj < 2; ++bj) { const u32x4 r = rw[0][m][bj];
                    const f32x4 r0 = {bflo(r.x), bfhi(r.x), bflo(r.y), bfhi(r.y)}, r1 = {bflo(r.z), bfhi(r.z), bflo(r.w), bfhi(r.w)};
                    const f32x4 v0 = r0 + acc[ai][bj][m][0] * f, v1 = r1 + acc[ai][bj][m][1] * f;
                    u32x4 w; w.x = cvtpk(v0[0], v0[1]); w.y = cvtpk(v0[2], v0[3]); w.z = cvtpk(v1[0], v1[1]); w.w = cvtpk(v1[2], v1[3]); *(u32x4*)(hb + off + bj * 128) = w;
                    if (h8) { u32x2 w8; w8.x = pk4_fp8(v0[0], v0[1], v0[2], v0[3]); w8.y = pk4_fp8(v1[0], v1[1], v1[2], v1[3]); *(u32x2*)(h8 + off + bj * 128) = w8; }
                    sq += (v0[0] * v0[0] + v0[1] * v0[1]) + (v0[2] * v0[2] + v0[3] * v0[3]) + (v1[0] * v1[0] + v1[1] * v1[1]) + (v1[2] * v1[2] + v1[3] * v1[3]); }
                sq += __shfl_xor(sq, 16); sq += __shfl_xor(sq, 32);
                if (fq == 0 && ss_out) ss_out[(size_t)row * 16 + u.pn * 4 + wc] = sq; }
        asm volatile("" ::: "memory"); }
    }
};


struct EpiGU {
    bf16_t* ACT; int ldact; const float* ss;
    DI void operator()(const f32x4 (&acc)[2][2][4][2], const Unit& u, int, int wr, int wc, int fr, int fq, const LAS float*) const {
        const int row0 = u.pm * 256 + wr * 64 + fr, col0 = u.pn * 128 + wc * 32 + 8 * fq;
#pragma unroll
        for (int ai = 0; ai < 2; ++ai)
#pragma unroll
            for (int m = 0; m < 4; ++m) { const int row = row0 + ai * 128 + m * 16; const float rs = rsqrtf(ss_sum(ss, row, 16) * (1.f / 1024.f) + EPS); float a[8];
#pragma unroll
                for (int n = 0; n < 2; ++n)
#pragma unroll
                    for (int e = 0; e < 4; ++e) { const float g = acc[ai][0][m][n][e] * rs, uu = acc[ai][1][m][n][e] * rs; a[4 * n + e] = g * uu * __builtin_amdgcn_rcpf(1.f + __expf(-g)); }
                u32x4 w; w.x = cvtpk(a[0], a[1]); w.y = cvtpk(a[2], a[3]); w.z = cvtpk(a[4], a[5]); w.w = cvtpk(a[6], a[7]);
                *(u32x4*)(ACT + (size_t)row * ldact + col0) = w; }
    }
};
struct EpiGU8 {
    unsigned char* ACT; int ldact; float wsc;
    DI void operator()(const f32x4 (&acc)[2][2][4][2], const Unit& u, int ui, int wr, int wc, int fr, int fq, const LAS float* rst) const {
        const int row0 = u.pm * 256 + wr * 64 + fr, col0 = u.pn * 128 + wc * 32 + 8 * fq;
#pragma unroll
        for (int ai = 0; ai < 2; ++ai)
#pragma unroll
            for (int m = 0; m < 4; ++m) { const int row = row0 + ai * 128 + m * 16; const float rs = rst[ui * 256 + ai * 128 + wr * 64 + m * 16 + fr] * wsc;
                *(u32x2*)(ACT + (size_t)row * ldact + col0) = swiglu8_fp8(acc[ai][0][m][0], acc[ai][0][m][1], acc[ai][1][m][0], acc[ai][1][m][1], rs); asm volatile("" ::: "memory"); }
    }
};
struct SchedMoe {
    const char* A; const char* B0; size_t bstride; int lda, K, nT, nN, G, c; const LAS int* tab; const int* list; bool gather; unsigned rowbytes; int nh, skew;
    DI bool next(int i, Unit& u) const { int o; const int U = nT * nN, U8 = (U + 7) >> 3, B = G >> 3, j = c >> 3;
        if (nh == 0) o = i * B + j;
        else if (j >= nh) o = (i < skew) ? i * (B - nh) + (j - nh) : skew * (B - nh) + (i - skew) * B + j;
        else o = skew * (B - nh) + i * B + j;
        const int L = (c & 7) * U8 + o; if (o >= U8 || L >= U) return false;
        const int grp = L / (XR * nN), rem = L - grp * (XR * nN), fm = grp * XR, gsz = (nT - fm) < XR ? (nT - fm) : XR;
        u.pm = fm + rem % gsz; u.pn = rem / gsz; u.e = tab[u.pm * 4]; return true; }
    DI const char* abase(const Unit& u) const { return gather ? A : A + (size_t)u.pm * 256 * lda * 2; }
    DI const char* bbase(const Unit& u) const { return B0 + (size_t)u.e * bstride + (size_t)u.pn * 256 * K * 2; }
    DI unsigned arow_off(const Unit& u, int r) const { const int off = tab[u.pm * 4 + 1], n = tab[u.pm * 4 + 2]; const int idx = off + r; const int tok = idx < n ? list[u.e * 32768 + idx] : 0; return (unsigned)tok * rowbytes; }
    DI void a_ready(const Unit&) const {}
};
struct EpiMoeGU {
    unsigned char* ACT; const float* lrs; const LAS int* tab;
    DI void operator()(const f32x4 (&acc)[2][2][4][2], const Unit& u, int ui, int wr, int wc, int fr, int fq, const LAS float* rst) const {
        const int r0 = wr * 64 + fr, col0 = u.pn * 128 + wc * 32 + 8 * fq; const LAS float* rsp = rst + ui * 256 + r0;
#pragma unroll
        for (int ai = 0; ai < 2; ++ai)
#pragma unroll
            for (int m = 0; m < 4; ++m) { const int r = r0 + ai * 128 + m * 16; const float rs = rsp[ai * 128 + m * 16] * (1.f / W8_SCALE);
                *(u32x2*)(ACT + (size_t)(u.pm * 256 + r) * DFE + col0) = swiglu8_fp8(acc[ai][0][m][0], acc[ai][0][m][1], acc[ai][1][m][0], acc[ai][1][m][1], rs); }
    }
};
struct EpiMoeDown {
    float* out; const int* list; const float* lgate; const LAS int* tab; bf16_t* hb; bool last;
    DI void operator()(const f32x4 (&acc)[2][2][4][2], const Unit& u, int, int wr, int wc, int fr, int fq, const LAS float*) const {
        const int off = tab[u.pm * 4 + 1], n = tab[u.pm * 4 + 2]; const int r0 = wr * 64 + fr, col0 = u.pn * 256 + wc * 32 + 8 * fq;
        int tok[2][4]; float gt[2][4];
#pragma unroll
        for (int ai = 0; ai < 2; ++ai)
#pragma unroll
            for (int m = 0; m < 4; ++m) { const int idx = off + r0 + ai * 128 + m * 16, ci = idx < n ? idx : n - 1;
                tok[ai][m] = list[u.e * 32768 + ci]; gt[ai][m] = lgate[u.e * 32768 + ci] * (1.f / (W8_SCALE * ACT8_SCALE)); }
        u32x4 rw[2][4][2];
#pragma unroll
        for (int ai = 0; ai < 2; ++ai)
#pragma unroll
            for (int m = 0; m < 4; ++m)
#pragma unroll
                for (int bj = 0; bj < 2; ++bj) rw[ai][m][bj] = *(const u32x4*)(hb + (size_t)tok[ai][m] * D + col0 + bj * 128);
        asm volatile("" ::: "memory");
#pragma unroll
        for (int ai = 0; ai < 2; ++ai)
#pragma unroll
            for (int m = 0; m < 4; ++m) if (off + r0 + ai * 128 + m * 16 < n) { const size_t ro = (size_t)tok[ai][m] * D + col0; const float g = gt[ai][m];
#pragma unroll
                for (int bj = 0; bj < 2; ++bj) { const u32x4 r = rw[ai][m][bj];
                    const f32x4 v0 = (f32x4){bflo(r.x), bfhi(r.x), bflo(r.y), bfhi(r.y)} + acc[ai][bj][m][0] * g, v1 = (f32x4){bflo(r.z), bfhi(r.z), bflo(r.w), bfhi(r.w)} + acc[ai][bj][m][1] * g;
                    if (last) { *(f32x4*)(out + ro + bj * 128) = v0; *(f32x4*)(out + ro + bj * 128 + 4) = v1; }
                    else { u32x4 w; w.x = cvtpk(v0[0], v0[1]); w.y = cvtpk(v0[2], v0[3]); w.z = cvtpk(v1[0], v1[1]); w.w = cvtpk(v1[2], v1[3]); *(u32x4*)(hb + ro + bj * 128) = w; } } }
    }
};
DI f32x4 skinny_acc(const bf16_t* A, int lda, const bf16_t* Bt, int K, int n0, int k0, int k1, int lane) {
    const int fr = lane & 15, g = lane >> 4; f32x4 acc = {0.f, 0.f, 0.f, 0.f};
    const bf16_t* ap = A + (size_t)fr * lda + 8 * g; const bf16_t* bp = Bt + (size_t)(n0 + fr) * K + 8 * g;
#pragma unroll 4
    for (int k = k0; k < k1; k += 32) { const bf16x8 a = *(const bf16x8*)(ap + k), b = *(const bf16x8*)(bp + k); acc = __builtin_amdgcn_mfma_f32_16x16x32_bf16(b, a, acc, 0, 0, 0); }
    return acc;
}

DI f32x4 skinny_block(LAS unsigned char* lds, const bf16_t* A, int lda, const bf16_t* Bt, int K, int n0, int kc, float scale, int tid) {
    const int lane = tid & 63, wave = tid >> 6;
    const f32x4 part = skinny_acc(A, lda, Bt, K, n0, wave * kc, wave * kc + kc, lane) * scale;
    LAS f32x4* red = (LAS f32x4*)lds; red[wave * 64 + lane] = part;
    __syncthreads();
    f32x4 tot = red[lane];
#pragma unroll
    for (int w = 1; w < 8; ++w) tot = tot + red[w * 64 + lane];
    __syncthreads();
    return tot;
}
DI void meta_rs(LAS float* rsm, const float* hm, int tid) {
    const int row = tid >> 5, l32 = tid & 31; const f32x4* q = (const f32x4*)(hm + (size_t)row * D) + l32; float sv = 0.f;
#pragma unroll
    for (int j = 0; j < 8; ++j) { const f32x4 v = q[32 * j]; sv += (v[0] * v[0] + v[1] * v[1]) + (v[2] * v[2] + v[3] * v[3]); }
    sv += __shfl_xor(sv, 1); sv += __shfl_xor(sv, 2); sv += __shfl_xor(sv, 4); sv += __shfl_xor(sv, 8); sv += __shfl_xor(sv, 16);
    if (l32 == 0) rsm[row] = rsqrtf(sv * (1.f / 1024.f) + EPS);
    __syncthreads();
}

template <class Sched> DI void fill_rs_table(const Sched& S, const float* ss, int nslot, LAS float* rst, int tid) {
    Unit u;
    for (int i = 0; i < 16 && S.next(i, u); ++i) if (tid < 256) rst[i * 256 + tid] = rsqrtf(ss_sum(ss, u.pm * 256 + tid, nslot) * (1.f / 1024.f) + EPS);
    __syncthreads();
}
DI void fill_moe_rs_table(const SchedMoe& S, const float* lrs, LAS float* rst, int tid) {
    Unit u;
    for (int i = 0; i < 16 && S.next(i, u); ++i) if (tid < 256) rst[i * 256 + tid] = lrs[u.e * 32768 + S.tab[u.pm * 4 + 1] + tid];
    __syncthreads();
}
struct Params {
    const float* x; const float* meta; const float* norm1_g; const float* norm2_g; const float* w_in; const float* w_out; const float* out_norm_g;
    const float* lru_conv_w; const float* lru_conv_b; const float* lru_wa; const float* lru_ba; const float* lru_wx; const float* lru_bx; const float* lru_lambda;
    const float* hg_lb_logits; const float* mla_gq; const float* mla_w_uq; const float* mla_gkv; const float* mla_w_ukv; const float* mla_gqn; const float* mla_gkn;
    const float* fox_gqn; const float* fox_gkn; const float* fox_bf; const float* ffn_w_gate; const float* ffn_w_up; const float* ffn_w_down;
    const float* moe_w_router; const float* moe_w_gate; const float* moe_w_up; const float* moe_w_down;
    float* out; unsigned char* ws;
};

struct Frame {
    LAS unsigned char* lds; int G, vcu;
};
#define TID_VARS const int tid = fresh_tid(); const int lane = tid & 63; const int wave = __builtin_amdgcn_readfirstlane(tid >> 6); (void)lane; (void)wave

DI void wt_item(const float* W, int ldw, int c0, int nv, const float* g, bf16_t* WT, int K, int n0, int k0, LAS float* scr, int lane) {
    { const int c4 = (lane & 7) * 4; f32x4 v[8];
#pragma unroll
      for (int i = 0; i < 8; ++i) { const int kk = 8 * i + (lane >> 3); const float* src = W + (size_t)(k0 + kk) * ldw + c0 + c4;
          if (c4 + 3 < nv) v[i] = *(const f32x4*)src; else { v[i] = (f32x4){0.f, 0.f, 0.f, 0.f}; if (c4 < nv) v[i][0] = src[0]; if (c4 + 1 < nv) v[i][1] = src[1]; if (c4 + 2 < nv) v[i][2] = src[2]; } }
#pragma unroll
      for (int i = 0; i < 8; ++i) { const int kk = 8 * i + (lane >> 3); const float gs = g ? g[k0 + kk] : 1.f; LAS float* d = scr + kk * 33 + c4; d[0] = v[i][0] * gs; d[1] = v[i][1] * gs; d[2] = v[i][2] * gs; d[3] = v[i][3] * gs; } }
    LDS_WAIT(); asm volatile("" ::: "memory");
    const int c = lane & 7;
#pragma unroll
    for (int j = 0; j < 4; ++j) { const int n = (lane >> 3) + 8 * j; const LAS float* s = scr + (8 * c) * 33 + n;
        u32x4 o; o.x = cvtpk(s[0 * 33], s[1 * 33]); o.y = cvtpk(s[2 * 33], s[3 * 33]); o.z = cvtpk(s[4 * 33], s[5 * 33]); o.w = cvtpk(s[6 * 33], s[7 * 33]);
        *(u32x4*)(WT + (size_t)(n0 + n) * K + k0 + 8 * c) = o; }
    LDS_WAIT(); asm volatile("" ::: "memory");
}
DI void wt_item8(const float* W, int ldw, int c0, const float* g, float scale, unsigned char* WT, int K8, int n0, int k0, LAS float* scr, int lane) {
    { const int c4 = (lane & 7) * 4; f32x4 v[8];
#pragma unroll
      for (int i = 0; i < 8; ++i) { const int kk = 8 * i + (lane >> 3); v[i] = *(const f32x4*)(W + (size_t)(k0 + kk) * ldw + c0 + c4); }
#pragma unroll
      for (int i = 0; i < 8; ++i) { const int kk = 8 * i + (lane >> 3); const float gs = g ? g[k0 + kk] * scale : scale; LAS float* d = scr + kk * 33 + c4; d[0] = v[i][0] * gs; d[1] = v[i][1] * gs; d[2] = v[i][2] * gs; d[3] = v[i][3] * gs; } }
    LDS_WAIT(); asm volatile("" ::: "memory");
    const int c = lane & 3;
#pragma unroll
    for (int j = 0; j < 2; ++j) { const int n = (lane >> 2) + 16 * j; const LAS float* sp = scr + (16 * c) * 33 + n; u32x4 o;
        o.x = pk4_fp8(sp[0 * 33], sp[1 * 33], sp[2 * 33], sp[3 * 33]); o.y = pk4_fp8(sp[4 * 33], sp[5 * 33], sp[6 * 33], sp[7 * 33]); o.z = pk4_fp8(sp[8 * 33], sp[9 * 33], sp[10 * 33], sp[11 * 33]); o.w = pk4_fp8(sp[12 * 33], sp[13 * 33], sp[14 * 33], sp[15 * 33]);
        *(u32x4*)(WT + (size_t)(n0 + n) * K8 + k0 + 16 * c) = o; }
    LDS_WAIT(); asm volatile("" ::: "memory");
}
DI void inmap(int nb, int& c0, int& nv) {
    nv = 32;
    if (nb < 48) c0 = 32 * nb;
    else if (nb < 54) c0 = 1536 + 32 * (nb - 48);
    else if (nb < 56) { c0 = 0; nv = 0; }
    else if (nb < 60) c0 = 1728 + 32 * (nb - 56);
    else if (nb == 60) c0 = 1856;
    else if (nb == 61) { c0 = 2656; nv = 4; }
    else if (nb < 64) { c0 = 0; nv = 0; }
    else if (nb < 72) c0 = 1888 + 32 * (nb - 64);
    else if (nb < 80) c0 = 2144 + 32 * (nb - 72);
    else c0 = 2400 + 32 * (nb - 80);
}
DI float row_to_bf16(const float* xrow, bf16_t* orow, int lane) {
    const f32x4* xr = (const f32x4*)xrow + lane; f32x4 v[4]; float s = 0.f;
#pragma unroll
    for (int j = 0; j < 4; ++j) { v[j] = xr[64 * j]; s += (v[j].x * v[j].x + v[j].y * v[j].y) + (v[j].z * v[j].z + v[j].w * v[j].w); }
    u32x2* o8 = (u32x2*)orow + lane;
#pragma unroll
    for (int j = 0; j < 4; ++j) { u32x2 w; w.x = cvtpk(v[j].x, v[j].y); w.y = cvtpk(v[j].z, v[j].w); o8[64 * j] = w; }
    return wave_sum(s);
}

constexpr int CV_I_IN = 88 * 16, CV_I_OUT = 32 * 16, CV_I_G = 88 * 16, CV_I_D = 32 * 44, CV_NITEMS = 2 * CV_I_IN + 2 * CV_I_OUT + 2 * CV_I_G + CV_I_D;
DI void convert_weights(const Params& p, LAS float* scr, int it0, int it1, int gw, int NGW, int lane) {
    bf16_t* Win = (bf16_t*)(p.ws + WS_WIN); bf16_t* Wout = (bf16_t*)(p.ws + WS_WOUT); bf16_t* Wgu = (bf16_t*)(p.ws + WS_WGU); bf16_t* Wd = (bf16_t*)(p.ws + WS_WD);
    constexpr int I_IN = CV_I_IN, I_OUT = CV_I_OUT, I_G = CV_I_G;
    for (int it = it0 + gw; it < it1; it += NGW) {
        int r = it;
        if (r < 2 * I_IN) { const int l = r / I_IN; r %= I_IN; const int nb = r / 16, kb = r % 16; int c0, nv; inmap(nb, c0, nv);
            wt_item(p.w_in + (size_t)l * D * 2660, 2660, c0, nv, p.norm1_g + l * D, Win + (size_t)l * ZC * D, D, 32 * nb, 64 * kb, scr, lane); continue; }
        r -= 2 * I_IN;
        if (r < 2 * I_OUT) { const int l = r / I_OUT; r %= I_OUT; const int nb = r / 16, kb = r % 16;
            wt_item(p.w_out + (size_t)l * D * D, D, 32 * nb, 32, p.out_norm_g + l * D, Wout + (size_t)l * D * D, D, 32 * nb, 64 * kb, scr, lane); continue; }
        r -= 2 * I_OUT;
        if (r < 2 * I_G) { const int up = r / I_G; r %= I_G; const int sb = r / 16, kb = r % 16;
            wt_item(up ? p.ffn_w_up : p.ffn_w_gate, DFF, 32 * sb, 32, p.norm2_g, Wgu, D, 256 * (sb >> 2) + 128 * up + 32 * (sb & 3), 64 * kb, scr, lane); continue; }
        r -= 2 * I_G;
        { const int sb = r / 44, kb = r % 44; wt_item(p.ffn_w_down, D, 32 * sb, 32, nullptr, Wd, DFF, 32 * sb, 64 * kb, scr, lane); }
    }
}
DI void p0_prologue(const Params& p, const Frame& F, float* ss0) {
    TID_VARS;
    LAS float* scr = (LAS float*)(F.lds + wave * 16384);
    const int gw = F.vcu * 8 + wave, NGW = F.G * 8;
    bf16_t* Win = (bf16_t*)(p.ws + WS_WIN); bf16_t* Wout = (bf16_t*)(p.ws + WS_WOUT); bf16_t* Wgu = (bf16_t*)(p.ws + WS_WGU); bf16_t* Wd = (bf16_t*)(p.ws + WS_WD);
    convert_weights(p, scr, 0, CV_I_IN, gw, NGW, lane);
    { bf16_t* LW = (bf16_t*)(p.ws + WS_WSM + SM_LRUW); const int gt = F.vcu * 512 + tid, NT = F.G * 512;
      for (int i = gt; i < 2 * 2 * 4 * 64 * 64; i += NT) { const int c = i & 63, d = (i >> 6) & 63, blk = (i >> 12) & 3, mat = (i >> 14) & 1, l = i >> 15;
          const float* src = mat ? p.lru_wx : p.lru_wa; LW[i] = f2bf(src[((size_t)(l * 4 + blk) * 64 + c) * 64 + d]); } }
    { const int gt = F.vcu * 512 + tid, NT = F.G * 512;
      bf16_t* WQ = (bf16_t*)(p.ws + WS_WSM + SM_WUQ); bf16_t* WKV = (bf16_t*)(p.ws + WS_WSM + SM_WUKV);
      for (int i = gt; i < 2 * 384 * 192; i += NT) { const int k = i % 192, n = (i / 192) % 384, l = i / (192 * 384); WQ[i] = f2bf(p.mla_w_uq[((size_t)l * 192 + k) * 384 + n] * p.mla_gq[l * 192 + k]); }
      for (int i = gt; i < 2 * 512 * 128; i += NT) { const int k = i % 128, n = (i / 128) % 512, l = i / (128 * 512); WKV[i] = f2bf(p.mla_w_ukv[((size_t)l * 128 + k) * 512 + n] * p.mla_gkv[l * 128 + k]); }
      float* ROPE = (float*)(p.ws + WS_HG + HG_ROPE);
      for (int i = gt; i < 8208 * 16; i += NT) { const int pos = i >> 4, fi = i & 15, a = fi >> 2, bq = fi & 3;
          const double base = bq == 0 ? 1.0 : bq == 1 ? 0.5623413251903491 : bq == 2 ? 0.31622776601683794 : 0.1778279410038923;
          const double sc = a == 0 ? 1.0 : a == 1 ? 0.1 : a == 2 ? 0.01 : 0.001;
          double rev = (double)pos * (base * sc) * 0.15915494309189535; rev -= __builtin_floor(rev);
          ROPE[2 * i] = __builtin_amdgcn_cosf((float)rev); ROPE[2 * i + 1] = __builtin_amdgcn_sinf((float)rev); } }
    bf16_t* bufA = (bf16_t*)(p.ws + WS_BUFA);
    for (int m0 = 4 * gw; m0 < NR; m0 += 4 * NGW) {
        f32x4 v[4][4];
#pragma unroll
        for (int r = 0; r < 4; ++r)
#pragma unroll
            for (int j = 0; j < 4; ++j) v[r][j] = ((const f32x4*)(p.x + (size_t)(m0 + r) * D) + lane)[64 * j];
#pragma unroll
        for (int r = 0; r < 4; ++r) { float sq = 0.f; u32x2* o8 = (u32x2*)(bufA + (size_t)(m0 + r) * D) + lane;
#pragma unroll
            for (int j = 0; j < 4; ++j) { sq += (v[r][j].x * v[r][j].x + v[r][j].y * v[r][j].y) + (v[r][j].z * v[r][j].z + v[r][j].w * v[r][j].w); u32x2 w; w.x = cvtpk(v[r][j].x, v[r][j].y); w.y = cvtpk(v[r][j].z, v[r][j].w); o8[64 * j] = w; }
            sq = wave_sum(sq); if (lane == 0) ss0[m0 + r] = sq; } }
    for (int m = gw; m < 256; m += NGW) {
        const int row = MB0 + m;
        if (m >= META_OFF && m < META_OFF + NMETA) { const float s = row_to_bf16(p.meta + (size_t)(m - META_OFF) * D, bufA + (size_t)row * D, lane); if (lane == 0) ss0[row] = s; }
        else { u32x4* o = (u32x4*)(bufA + (size_t)row * D) + lane; o[0] = zero4(); o[64] = zero4(); if (lane == 0) ss0[row] = 0.f; }
    }
}

template <int nrows> DI void lru_local_unit(const Params& p, const Frame& F, int l, int r0, int hrow, int aggidx) {
    const bf16_t* Z = (const bf16_t*)(p.ws + WS_Z);
    bf16_t* LA = (bf16_t*)(p.ws + WS_LRU + LRU_LA); bf16_t* LB = (bf16_t*)(p.ws + WS_LRU + LRU_BC);
    float* AGGA = (float*)(p.ws + WS_LRU + LRU_AGGA); float* AGGB = (float*)(p.ws + WS_LRU + LRU_AGGB);
    constexpr int UP = 264;
    LAS bf16_t* U = (LAS bf16_t*)F.lds;
    LAS bf16_t* TLA = (LAS bf16_t*)(F.lds + 64 * UP * 2);
    LAS bf16_t* TLB = (LAS bf16_t*)(F.lds + 64 * UP * 2 + 64 * 256 * 2);
    TID_VARS; const int w = wave;
    { const int c = tid & 255, half = tid >> 8; constexpr int nh = nrows >> 1; const int t0 = half * nh;
      const float cw0 = p.lru_conv_w[(l * 4 + 0) * 256 + c], cw1 = p.lru_conv_w[(l * 4 + 1) * 256 + c], cw2 = p.lru_conv_w[(l * 4 + 2) * 256 + c], cw3 = p.lru_conv_w[(l * 4 + 3) * 256 + c], cb = p.lru_conv_b[l * 256 + c];
      bf16_t xr[nh + 3];
#pragma unroll
      for (int i = 0; i < 3; ++i) xr[i] = Z[(size_t)((t0 == 0 ? hrow : r0 + t0 - 3) + i) * ZC + ZC_XA + c];
#pragma unroll
      for (int t = 0; t < nh; ++t) xr[3 + t] = Z[(size_t)(r0 + t0 + t) * ZC + ZC_XA + c];
#pragma unroll
      for (int t = 0; t < nh; ++t) { const float u = cb + cw0 * bf2f(xr[t]) + cw1 * bf2f(xr[t + 1]) + cw2 * bf2f(xr[t + 2]) + cw3 * bf2f(xr[t + 3]); U[(t0 + t) * UP + c] = f2bf(u); } }
    __syncthreads();
    { const int blk = w >> 1, fr = lane & 15, fq = lane >> 4;
      const bf16_t* LW = (const bf16_t*)(p.ws + WS_WSM + SM_LRUW) + (size_t)l * 2 * 4 * 4096;
      for (int cbk = 0; cbk < 2; ++cbk) { const int dbase = 16 * (2 * (w & 1) + cbk), ch4 = blk * 64 + dbase + 4 * fq;
          bf16x8 ba[2], bx[2];
#pragma unroll
          for (int ks = 0; ks < 2; ++ks) { ba[ks] = *(const bf16x8*)(LW + ((size_t)(0 * 4 + blk) * 64 + dbase + fr) * 64 + 32 * ks + 8 * fq); bx[ks] = *(const bf16x8*)(LW + ((size_t)(1 * 4 + blk) * 64 + dbase + fr) * 64 + 32 * ks + 8 * fq); }
          const f32x4 bav = *(const f32x4*)(p.lru_ba + l * 256 + ch4), bxv = *(const f32x4*)(p.lru_bx + l * 256 + ch4), lam = *(const f32x4*)(p.lru_lambda + l * 256 + ch4);
          float sp[4];
#pragma unroll
          for (int j = 0; j < 4; ++j) sp[j] = log1pf(__expf(-lam[j]));
          for (int rb = 0; rb < (nrows >> 4); ++rb) {
              f32x4 ar = {0.f, 0.f, 0.f, 0.f}, ai = {0.f, 0.f, 0.f, 0.f};
#pragma unroll
              for (int ks = 0; ks < 2; ++ks) { const bf16x8 a = *(const LAS bf16x8*)(U + (16 * rb + fr) * UP + blk * 64 + 32 * ks + 8 * fq);
                  ar = __builtin_amdgcn_mfma_f32_16x16x32_bf16(ba[ks], a, ar, 0, 0, 0); ai = __builtin_amdgcn_mfma_f32_16x16x32_bf16(bx[ks], a, ai, 0, 0, 0); }
              const int t = 16 * rb + fr;
              const u32x2 uw = *(const LAS u32x2*)(U + t * UP + ch4); const float uv[4] = {bflo(uw.x), bfhi(uw.x), bflo(uw.y), bfhi(uw.y)};
              float la[4], bc[4];
#pragma unroll
              for (int j = 0; j < 4; ++j) { const float r = sigmoidf_(ar[j] + bav[j]), ig = sigmoidf_(ai[j] + bxv[j]);
                  la[j] = -8.f * r * sp[j]; const float x2 = 2.f * la[j];
                  const float om = (x2 > -0.1f) ? -x2 * (1.f + x2 * (0.5f + x2 * (1.f / 6.f + x2 * (1.f / 24.f + x2 * (1.f / 120.f))))) : 1.f - __expf(x2);
                  bc[j] = sqrtf(om) * ig * uv[j]; }
              u32x2 wa, wb; wa.x = cvtpk(la[0], la[1]); wa.y = cvtpk(la[2], la[3]); wb.x = cvtpk(bc[0], bc[1]); wb.y = cvtpk(bc[2], bc[3]);
              *(LAS u32x2*)(TLA + t * 256 + ch4) = wa; *(LAS u32x2*)(TLB + t * 256 + ch4) = wb;
              *(u32x2*)(LA + (size_t)(r0 + t) * 256 + ch4) = wa; *(u32x2*)(LB + (size_t)(r0 + t) * 256 + ch4) = wb; } } }
    __syncthreads();
    { const int c = tid & 255, qd = tid >> 8; constexpr int RH = nrows >> 1; float h = 0.f, sl = 0.f;
#pragma unroll
      for (int t = 0; t < RH; ++t) { const float la = bf2f(TLA[(qd * RH + t) * 256 + c]), bc = bf2f(TLB[(qd * RH + t) * 256 + c]); h = __expf(la) * h + bc; sl += la; }
      LAS float* XA = (LAS float*)U;
      __syncthreads();
      XA[(qd * 256 + c) * 2] = sl; XA[(qd * 256 + c) * 2 + 1] = h;
      __syncthreads();
      if (tid < 256) { const float s0 = XA[c * 2], h0 = XA[c * 2 + 1], s1 = XA[(256 + c) * 2], h1 = XA[(256 + c) * 2 + 1];
          AGGA[(size_t)aggidx * 256 + c] = s0 + s1; AGGB[(size_t)aggidx * 256 + c] = __expf(s1) * h0 + h1; } }
    __syncthreads();
}
DI void lru_carry(const Params& p, int b, int c) {
    const float* AGGA = (const float*)(p.ws + WS_LRU + LRU_AGGA); const float* AGGB = (const float*)(p.ws + WS_LRU + LRU_AGGB); float* HIN = (float*)(p.ws + WS_LRU + LRU_HIN);
    float h = AGGB[(size_t)(NB * NSEG) * 256 + c];
    for (int hf = 0; hf < 4; ++hf) {
        float a[32], bb[32];
#pragma unroll
        for (int s = 0; s < 32; ++s) { const size_t i = (size_t)(b * NSEG + hf * 32 + s) * 256 + c; a[s] = AGGA[i]; bb[s] = AGGB[i]; }
#pragma unroll
        for (int s = 0; s < 32; ++s) { const float hin = h; h = __expf(a[s]) * h + bb[s]; a[s] = hin; }
#pragma unroll
        for (int s = 0; s < 32; ++s) { const size_t i = (size_t)(b * NSEG + hf * 32 + s) * 256 + c; HIN[i] = a[s]; }
    }
}
template <int nrows> DI void lru_fix_unit(const Params& p, const Frame& F, int l, int r0, int aggidx, bool meta, float* gss) {
    const bf16_t* Z = (const bf16_t*)(p.ws + WS_Z); const bf16_t* LA = (const bf16_t*)(p.ws + WS_LRU + LRU_LA); const bf16_t* LB = (const bf16_t*)(p.ws + WS_LRU + LRU_BC);
    const float* HIN = (const float*)(p.ws + WS_LRU + LRU_HIN); bf16_t* Y = (bf16_t*)(p.ws + WS_BUFB);
    LAS float* AG = (LAS float*)F.lds;
    LAS float* red = (LAS float*)(F.lds + 8192);
    TID_VARS; constexpr int RQ = nrows >> 2; const int c2 = tid & 127, rq = tid >> 7;
    unsigned la2[RQ], bc2[RQ], ga2[RQ];
#pragma unroll
    for (int t = 0; t < RQ; ++t) { const size_t row = (size_t)(r0 + rq * RQ + t); la2[t] = *(const unsigned*)(LA + row * 256 + 2 * c2); bc2[t] = *(const unsigned*)(LB + row * 256 + 2 * c2); ga2[t] = *(const unsigned*)(Z + row * ZC + ZC_GA + 2 * c2); }
    float hin0 = 0.f, hin1 = 0.f; if (!meta) { const f32x2 hv = *(const f32x2*)(HIN + (size_t)aggidx * 256 + 2 * c2); hin0 = hv.x; hin1 = hv.y; }
    float hl0[RQ], hl1[RQ], ac0[RQ], ac1[RQ]; float h0 = 0.f, h1 = 0.f, A0 = 1.f, A1 = 1.f;
#pragma unroll
    for (int t = 0; t < RQ; ++t) { const float a0 = __expf(bflo(la2[t])), a1 = __expf(bfhi(la2[t])); h0 = a0 * h0 + bflo(bc2[t]); h1 = a1 * h1 + bfhi(bc2[t]); A0 *= a0; A1 *= a1; hl0[t] = h0; hl1[t] = h1; ac0[t] = A0; ac1[t] = A1; }
    *(LAS f32x4*)(AG + (rq * 128 + c2) * 4) = (f32x4){A0, h0, A1, h1};
    __syncthreads();
    for (int q = 0; q < rq; ++q) { const f32x4 v = *(const LAS f32x4*)(AG + (q * 128 + c2) * 4); hin0 = v[0] * hin0 + v[1]; hin1 = v[2] * hin1 + v[3]; }
#pragma unroll
    for (int t = 0; t < RQ; ++t) { const size_t row = (size_t)(r0 + rq * RQ + t);
        const float y0 = (hl0[t] + ac0[t] * hin0) * gelu_tanh(bflo(ga2[t])), y1 = (hl1[t] + ac1[t] * hin1) * gelu_tanh(bfhi(ga2[t]));
        const unsigned w = cvtpk(y0, y1); *(unsigned*)(Y + row * D + Y_LRU + 2 * c2) = w;
        const float z0 = bflo(w), z1 = bfhi(w); const float sv = wave_sum(z0 * z0 + z1 * z1); if (lane == 0) red[(rq * RQ + t) * 2 + (wave & 1)] = sv; }
    __syncthreads();
    if (tid < nrows) *(f32x4*)(gss + (size_t)(r0 + tid) * 16) = (f32x4){red[tid * 2] + red[tid * 2 + 1], 0.f, 0.f, 0.f};
    __syncthreads();
}


constexpr int HG_WL = 11776;
DI void hg_local_wave(const Params& p, LAS unsigned char* wl, int l, int r0, int nrows, int h, int slot, int lane) {
    bf16_t* Z = (bf16_t*)(p.ws + WS_Z);
    float* UT = (float*)(p.ws + WS_HG + HG_UT) + (size_t)slot * 4096; float* DL = (float*)(p.ws + WS_HG + HG_DL) + (size_t)slot * 64;
    LAS bf16_t* QD = (LAS bf16_t*)wl; LAS bf16_t* KD = QD + 16 * 72; LAS bf16_t* KET = KD + 16 * 72; LAS bf16_t* VT = KET + 64 * 24; LAS bf16_t* ATT = VT + 64 * 24; LAS float* DEC = (LAS float*)(ATT + 16 * 24);
    const int fr = lane & 15, g = lane >> 4;
    float lbv = 0.f;
    if (l == 1) { const float l0 = p.hg_lb_logits[h * 64 + lane], l1 = p.hg_lb_logits[256 + h * 64 + lane]; lbv = sigmoidf_(l1 - l0); }
    f32x4 S[4][4];
#pragma unroll
    for (int a = 0; a < 4; ++a)
#pragma unroll
        for (int b = 0; b < 4; ++b) S[a][b] = (f32x4){0.f, 0.f, 0.f, 0.f};
    float Bseg = 0.f;
    const bf16x8 zero8 = {0, 0, 0, 0, 0, 0, 0, 0};
    for (int c = 0; c < (nrows >> 4); ++c) {
        const int rc = r0 + 16 * c;
        float bsum = 0.f; float kdv[16];
#pragma unroll
        for (int t = 0; t < 16; ++t) {
            const size_t zo = (size_t)(rc + t) * ZC + 64 * h + lane;
            const float fz = bf2f(Z[zo + ZC_HF]), q = bf2f(Z[zo + ZC_HQ]); const bf16_t vraw = Z[zo + ZC_HV];
            const float sg = sigmoidf_(fz); const float f = lbv + (1.f - lbv) * sg; const float k = (1.f - lbv) * (1.f - sg);
            bsum += __logf(f);
            const float eb = __expf(bsum), enb = __expf(-bsum);
            QD[t * 72 + lane] = f2bf(q * eb); kdv[t] = k * enb; KD[t * 72 + lane] = f2bf(kdv[t]); VT[lane * 24 + t] = vraw;
            Z[zo + ZC_HQ] = f2bf(q * __expf(Bseg + bsum));
        }
        const float eend = __expf(bsum);
#pragma unroll
        for (int t = 0; t < 16; ++t) KET[lane * 24 + t] = f2bf(kdv[t] * eend);
        DEC[lane] = eend; Bseg += bsum;
        LDS_WAIT();
        f32x4 at = {0.f, 0.f, 0.f, 0.f};
#pragma unroll
        for (int ks = 0; ks < 2; ++ks) { const bf16x8 a = *(const LAS bf16x8*)(KD + fr * 72 + 32 * ks + 8 * g), b = *(const LAS bf16x8*)(QD + fr * 72 + 32 * ks + 8 * g);
            at = __builtin_amdgcn_mfma_f32_16x16x32_bf16(a, b, at, 0, 0, 0); }
#pragma unroll
        for (int j = 0; j < 4; ++j) if (4 * g + j > fr) at[j] = 0.f;
        { u32x2 w; w.x = cvtpk(at[0], at[1]); w.y = cvtpk(at[2], at[3]); *(LAS u32x2*)(ATT + fr * 24 + 4 * g) = w; }
        LDS_WAIT();
        const bf16x8 aatt = (g < 2) ? *(const LAS bf16x8*)(ATT + fr * 24 + 8 * g) : zero8;
        bf16x8 bv[4], aket[4];
#pragma unroll
        for (int i = 0; i < 4; ++i) { bv[i] = (g < 2) ? *(const LAS bf16x8*)(VT + (fr + 16 * i) * 24 + 8 * g) : zero8; aket[i] = (g < 2) ? *(const LAS bf16x8*)(KET + (fr + 16 * i) * 24 + 8 * g) : zero8; }
        f32x4 o[4];
#pragma unroll
        for (int cb = 0; cb < 4; ++cb) o[cb] = __builtin_amdgcn_mfma_f32_16x16x32_bf16(bv[cb], aatt, (f32x4){0.f, 0.f, 0.f, 0.f}, 0, 0, 0);
#pragma unroll
        for (int ks = 0; ks < 2; ++ks) {
            const u32x2 q0 = *(const LAS u32x2*)(QD + fr * 72 + 32 * ks + 4 * g), q1 = *(const LAS u32x2*)(QD + fr * 72 + 32 * ks + 16 + 4 * g);
            const bf16x8 aq = __builtin_bit_cast(bf16x8, (u32x4){q0.x, q0.y, q1.x, q1.y});
#pragma unroll
            for (int cb = 0; cb < 4; ++cb) { const f32x4 s0 = S[2 * ks][cb], s1 = S[2 * ks + 1][cb];
                const bf16x8 bs = __builtin_bit_cast(bf16x8, (u32x4){cvtpk(s0[0], s0[1]), cvtpk(s0[2], s0[3]), cvtpk(s1[0], s1[1]), cvtpk(s1[2], s1[3])});
                o[cb] = __builtin_amdgcn_mfma_f32_16x16x32_bf16(bs, aq, o[cb], 0, 0, 0); }
        }
#pragma unroll
        for (int cb = 0; cb < 4; ++cb) { u32x2 w; w.x = cvtpk(o[cb][0], o[cb][1]); w.y = cvtpk(o[cb][2], o[cb][3]); *(u32x2*)(Z + (size_t)(rc + fr) * ZC + ZC_HF + 64 * h + 16 * cb + 4 * g) = w; }
#pragma unroll
        for (int rb = 0; rb < 4; ++rb) { const f32x4 d4 = *(const LAS f32x4*)(DEC + 16 * rb + 4 * g);
#pragma unroll
            for (int cb = 0; cb < 4; ++cb) { const f32x4 u = __builtin_amdgcn_mfma_f32_16x16x32_bf16(aket[rb], bv[cb], (f32x4){0.f, 0.f, 0.f, 0.f}, 0, 0, 0); S[rb][cb] = S[rb][cb] * d4 + u; } }
        LDS_WAIT();
    }
#pragma unroll
    for (int rb = 0; rb < 4; ++rb)
#pragma unroll
        for (int cb = 0; cb < 4; ++cb) *(f32x4*)(UT + (fr + 16 * cb) * 64 + 16 * rb + 4 * g) = S[rb][cb];
    DL[lane] = Bseg;
}
DI void hg_carry_block(const Params& p, LAS unsigned char* lds, int bh, int part, int tid) {
    float* UT = (float*)(p.ws + WS_HG + HG_UT); const float* DL = (const float*)(p.ws + WS_HG + HG_DL);
    LAS float* DEC = (LAS float*)lds;
    for (int i = tid; i < 128 * 64; i += 512) DEC[i] = __expf(DL[(size_t)bh * 128 * 64 + i]);
    const int e = part * 512 + tid, dk = e & 63;
    float s = UT[(size_t)(2048 + (bh & 3)) * 4096 + e];
    __syncthreads();
    for (int hf = 0; hf < 2; ++hf) {
        float u[64];
#pragma unroll
        for (int i = 0; i < 64; ++i) u[i] = UT[(size_t)(bh * 128 + hf * 64 + i) * 4096 + e];
#pragma unroll
        for (int i = 0; i < 64; ++i) { const float sin_ = s; s = DEC[(hf * 64 + i) * 64 + dk] * s + u[i]; u[i] = sin_; }
#pragma unroll
        for (int i = 0; i < 64; ++i) UT[(size_t)(bh * 128 + hf * 64 + i) * 4096 + e] = u[i];
    }
    __syncthreads();
}
DI void hg_fix_wave(const Params& p, int r0, int nrows, int h, int slot, bool meta, float* gss, int lane) {
    const bf16_t* Z = (const bf16_t*)(p.ws + WS_Z); bf16_t* Y = (bf16_t*)(p.ws + WS_BUFB);
    const float* SI = (const float*)(p.ws + WS_HG + HG_UT) + (size_t)slot * 4096;
    const int fr = lane & 15, g = lane >> 4;
    bf16x8 bS[2][4];
    if (!meta) {
#pragma unroll
        for (int ks = 0; ks < 2; ++ks)
#pragma unroll
            for (int cb = 0; cb < 4; ++cb) { const f32x4 s0 = *(const f32x4*)(SI + (fr + 16 * cb) * 64 + 32 * ks + 8 * g), s1 = *(const f32x4*)(SI + (fr + 16 * cb) * 64 + 32 * ks + 8 * g + 4);
                bS[ks][cb] = __builtin_bit_cast(bf16x8, (u32x4){cvtpk(s0[0], s0[1]), cvtpk(s0[2], s0[3]), cvtpk(s1[0], s1[1]), cvtpk(s1[2], s1[3])}); }
    }
    for (int rbk = 0; rbk < (nrows >> 4); ++rbk) {
        f32x4 o[4];
#pragma unroll
        for (int cb = 0; cb < 4; ++cb) o[cb] = (f32x4){0.f, 0.f, 0.f, 0.f};
        if (!meta) {
#pragma unroll
            for (int ks = 0; ks < 2; ++ks) { const bf16x8 a = *(const bf16x8*)(Z + (size_t)(r0 + 16 * rbk + fr) * ZC + ZC_HQ + 64 * h + 32 * ks + 8 * g);
#pragma unroll
                for (int cb = 0; cb < 4; ++cb) o[cb] = __builtin_amdgcn_mfma_f32_16x16x32_bf16(bS[ks][cb], a, o[cb], 0, 0, 0); }
        }
        const size_t row = (size_t)(r0 + 16 * rbk + fr); float sq = 0.f;
#pragma unroll
        for (int cb = 0; cb < 4; ++cb) { const int col4 = 64 * h + 16 * cb + 4 * g;
            const u32x2 ow = *(const u32x2*)(Z + row * ZC + ZC_HF + col4), gw = *(const u32x2*)(Z + row * ZC + ZC_HG + col4);
            const float ol[4] = {bflo(ow.x), bfhi(ow.x), bflo(ow.y), bfhi(ow.y)}, gg[4] = {bflo(gw.x), bfhi(gw.x), bflo(gw.y), bfhi(gw.y)}; float val[4];
#pragma unroll
            for (int j = 0; j < 4; ++j) val[j] = (o[cb][j] + ol[j]) * (gg[j] * sigmoidf_(gg[j]));
            u32x2 w; w.x = cvtpk(val[0], val[1]); w.y = cvtpk(val[2], val[3]); *(u32x2*)(Y + row * D + Y_HG + col4) = w;
            const float z0 = bflo(w.x), z1 = bfhi(w.x), z2 = bflo(w.y), z3 = bfhi(w.y); sq += (z0 * z0 + z1 * z1) + (z2 * z2 + z3 * z3); }
        sq += __shfl_xor(sq, 16); sq += __shfl_xor(sq, 32);
        if (g == 0) gss[row * 16 + 4 + h] = sq;
    }
}

constexpr float LOG2E = 1.4426950408889634f;
constexpr float QS_FOX = 0.125f * LOG2E, QS_MLA = 0.10206207261596575f * LOG2E;
DI int row_pos(int row) { return row < NR ? 16 + (row & (SEQ - 1)) : row - MROW0; }
DI float swap_other(float x, bool domax) { auto rr = __builtin_amdgcn_permlane32_swap(__float_as_uint(x), __float_as_uint(x), false, false); const float a = __uint_as_float(rr[0]), b = __uint_as_float(rr[1]); return domax ? fmaxf(a, b) : a + b; }

template <int nrows> DI void fox_prep_unit(const Params& p, const Frame& F, int l, int r0) {
    TID_VARS; bf16_t* Z = (bf16_t*)(p.ws + WS_Z); bf16_t* FVT = (bf16_t*)(p.ws + WS_ATT + AT_FVT); float* FLF = (float*)(p.ws + WS_LRU + LRU_FLF);
    LAS bf16_t* VTILE = (LAS bf16_t*)F.lds;
    const int d0 = (4 * lane) & 63;
    const f32x4 gq = *(const f32x4*)(p.fox_gqn + l * 64 + d0), gk = *(const f32x4*)(p.fox_gkn + l * 64 + d0);
    { constexpr int NT = nrows / 8; u32x2 qw[NT], kw[NT], vw[NT]; float fx[NT];
#pragma unroll
      for (int i = 0; i < NT; ++i) { const size_t row = (size_t)(r0 + wave + 8 * i); qw[i] = *(const u32x2*)(Z + row * ZC + ZC_FQ + 4 * lane); kw[i] = *(const u32x2*)(Z + row * ZC + ZC_FK + 4 * lane); vw[i] = *(const u32x2*)(Z + row * ZC + ZC_FV + 4 * lane);
          fx[i] = bf2f(Z[row * ZC + ZC_FF + (lane & 3)]); }
#pragma unroll
      for (int i = 0; i < NT; ++i) { const int t = wave + 8 * i; const size_t row = (size_t)(r0 + t);
        { const u32x2 w = qw[i]; const float a0 = bflo(w.x), a1 = bfhi(w.x), a2 = bflo(w.y), a3 = bfhi(w.y);
          float ss = (a0 * a0 + a1 * a1) + (a2 * a2 + a3 * a3); ss += __shfl_xor(ss, 1); ss += __shfl_xor(ss, 2); ss += __shfl_xor(ss, 4); ss += __shfl_xor(ss, 8);
          const float rs = rsqrtf(ss * (1.f / 64.f) + EPS) * QS_FOX; u32x2 o; o.x = cvtpk(a0 * rs * gq[0], a1 * rs * gq[1]); o.y = cvtpk(a2 * rs * gq[2], a3 * rs * gq[3]); *(u32x2*)(Z + row * ZC + ZC_FQ + 4 * lane) = o; }
        { const u32x2 w = kw[i]; const float a0 = bflo(w.x), a1 = bfhi(w.x), a2 = bflo(w.y), a3 = bfhi(w.y);
          float ss = (a0 * a0 + a1 * a1) + (a2 * a2 + a3 * a3); ss += __shfl_xor(ss, 1); ss += __shfl_xor(ss, 2); ss += __shfl_xor(ss, 4); ss += __shfl_xor(ss, 8);
          const float rs = rsqrtf(ss * (1.f / 64.f) + EPS); u32x2 o; o.x = cvtpk(a0 * rs * gk[0], a1 * rs * gk[1]); o.y = cvtpk(a2 * rs * gk[2], a3 * rs * gk[3]); *(u32x2*)(Z + row * ZC + ZC_FK + 4 * lane) = o; }
        *(LAS u32x2*)(VTILE + t * 264 + 4 * lane) = vw[i];
        if (lane < 4) { const float x = fx[i] + p.fox_bf[l * 4 + lane]; const float ls = fminf(x, 0.f) - log1pf(__expf(-fabsf(x))); FLF[(size_t)lane * TM + row] = ls * LOG2E; } } }
    __syncthreads();
    { const int hd = tid & 255, half = tid >> 8, ng = nrows >> 4;
      for (int gi = half; gi < ng; gi += 2) { unsigned short v[16];
#pragma unroll
          for (int ko = 0; ko < 16; ++ko) v[8 * ((ko >> 2) & 1) + (ko & 3) + 4 * (ko >> 3)] = VTILE[(16 * gi + ko) * 264 + hd];
          u32x4 w0, w1; w0.x = v[0] | ((unsigned)v[1] << 16); w0.y = v[2] | ((unsigned)v[3] << 16); w0.z = v[4] | ((unsigned)v[5] << 16); w0.w = v[6] | ((unsigned)v[7] << 16);
          w1.x = v[8] | ((unsigned)v[9] << 16); w1.y = v[10] | ((unsigned)v[11] << 16); w1.z = v[12] | ((unsigned)v[13] << 16); w1.w = v[14] | ((unsigned)v[15] << 16);
          u32x4* dst = (u32x4*)(FVT + (size_t)hd * TM + r0 + 16 * gi); dst[0] = w0; dst[1] = w1; } }
    __syncthreads();
}
DI void fox_cscan_block(const Params& p, LAS unsigned char* lds, int l, int b, int h, int tid) {
    const float* FLF = (const float*)(p.ws + WS_LRU + LRU_FLF) + (size_t)h * TM; float* FC = (float*)(p.ws + WS_LRU + LRU_FC) + (size_t)h * TM;
    LAS float* wt = (LAS float*)lds;
    const int lane = tid & 63, wave = tid >> 6;
    float cm = 0.f;
    for (int i = 0; i < 16; ++i) { cm += FLF[MROW0 + i]; if (b == 0 && tid == 0) FC[MROW0 + i] = cm; }
    const f32x4* src = (const f32x4*)(FLF + (size_t)b * SEQ + 16 * tid); f32x4 v[4];
#pragma unroll
    for (int j = 0; j < 4; ++j) v[j] = src[j];
    float run = 0.f;
#pragma unroll
    for (int j = 0; j < 4; ++j) { run += v[j].x; v[j].x = run; run += v[j].y; v[j].y = run; run += v[j].z; v[j].z = run; run += v[j].w; v[j].w = run; }
    float inc = run;
#pragma unroll
    for (int o = 1; o < 64; o <<= 1) { const float t = __shfl_up(inc, o); if (lane >= o) inc += t; }
    if (lane == 63) wt[wave] = inc;
    __syncthreads();
    float base = cm + (inc - run);
    for (int w = 0; w < wave; ++w) base += wt[w];
    f32x4* dst = (f32x4*)(FC + (size_t)b * SEQ + 16 * tid);
    LAS f32x4* cl = (LAS f32x4*)(lds + 256);
#pragma unroll
    for (int j = 0; j < 4; ++j) { const f32x4 cvv = v[j] + base; dst[j] = cvv; cl[4 * tid + j] = cvv; }
    __syncthreads();
    if (tid < 32) { const LAS float* c1 = (const LAS float*)cl; const int qb = tid; float gq = 0.f, gk = 0.f;
        for (int i = 0; i < 64; ++i) { gq = fmaxf(gq, fabsf(p.fox_gqn[l * 64 + i])); gk = fmaxf(gk, fabsf(p.fox_gkn[l * 64 + i])); }
        const float T = 150.f + 12.f * gq * gk;
        const float cq0 = c1[256 * qb];
        int lo = 0, hi = 4 * qb;
        while (lo < hi) { const int mid = (lo + hi) >> 1; if (cq0 - c1[64 * mid + 63] >= -T) hi = mid; else lo = mid + 1; }
        const bool meta_on = (cq0 - cm) >= -T;
        ((int*)(p.ws + WS_LRU + LRU_FJ0))[(h * NB + b) * 32 + qb] = meta_on ? 0 : ((1 + lo) & ~1); }
    __syncthreads();
}
DI void mla_prep_unit(const Params& p, const Frame& F, int l, int r0, int nrows, int part, int hp) {
    TID_VARS; const bf16_t* Z = (const bf16_t*)(p.ws + WS_Z);
    bf16_t* MQ = (bf16_t*)(p.ws + WS_ATT + AT_MQ); bf16_t* MK = (bf16_t*)(p.ws + WS_ATT + AT_MK); bf16_t* MVT = (bf16_t*)(p.ws + WS_ATT + AT_MVT);
    const float* ROPE = (const float*)(p.ws + WS_HG + HG_ROPE);
    const int KW = part ? 128 : 192, WP = KW + 8, NWR = part ? 256 : 192, CH = KW / 8;
    const bf16_t* Wg = part ? (const bf16_t*)(p.ws + WS_WSM + SM_WUKV) + (size_t)l * 512 * 128 + (size_t)256 * hp * 128 : (const bf16_t*)(p.ws + WS_WSM + SM_WUQ) + (size_t)l * 384 * 192 + (size_t)192 * hp * 192;
    LAS bf16_t* WL = (LAS bf16_t*)F.lds;
    LAS bf16_t* AT = WL + 192 * 200;
    LAS bf16_t* KR = AT + 128 * 200;
    LAS float* RS = (LAS float*)(KR + 128 * 40);
    const int zc0 = part ? ZC_CKV : ZC_CQ;
    { u32x4 wv[10], av[7];
#pragma unroll
      for (int i = 0; i < 10; ++i) { const int c = tid + 512 * i; wv[i] = (u32x4){0u, 0u, 0u, 0u}; if (c < NWR * CH) wv[i] = *(const u32x4*)(Wg + (size_t)(c / CH) * KW + 8 * (c % CH)); }
#pragma unroll
      for (int i = 0; i < 7; ++i) { const int c = tid + 512 * i; av[i] = (u32x4){0u, 0u, 0u, 0u}; if (c < nrows * CH) av[i] = *(const u32x4*)(Z + (size_t)(r0 + c / CH) * ZC + zc0 + 8 * (c % CH)); }
      u32x4 kv = {0u, 0u, 0u, 0u}; if (part && tid < nrows * 4) kv = *(const u32x4*)(Z + (size_t)(r0 + (tid >> 2)) * ZC + ZC_KR + 8 * (tid & 3));
#pragma unroll
      for (int i = 0; i < 10; ++i) { const int c = tid + 512 * i; if (c < NWR * CH) *(LAS u32x4*)(WL + (c / CH) * WP + 8 * (c % CH)) = wv[i]; }
#pragma unroll
      for (int i = 0; i < 7; ++i) { const int c = tid + 512 * i; if (c < nrows * CH) *(LAS u32x4*)(AT + (c / CH) * WP + 8 * (c % CH)) = av[i]; }
      if (part && tid < nrows * 4) *(LAS u32x4*)(KR + (tid >> 2) * 40 + 8 * (tid & 3)) = kv; }
    __syncthreads();
    { const int row = tid >> 2, qd = tid & 3, nq = KW / 4; float ss = 0.f;
      if (row < nrows) { for (int c = 0; c < nq; c += 8) { const u32x4 w = *(const LAS u32x4*)(AT + row * WP + qd * nq + c);
            ss += (bflo(w.x) * bflo(w.x) + bfhi(w.x) * bfhi(w.x)) + (bflo(w.y) * bflo(w.y) + bfhi(w.y) * bfhi(w.y)) + (bflo(w.z) * bflo(w.z) + bfhi(w.z) * bfhi(w.z)) + (bflo(w.w) * bflo(w.w) + bfhi(w.w) * bfhi(w.w)); } }
      ss += __shfl_xor(ss, 1); ss += __shfl_xor(ss, 2);
      if (qd == 0 && row < nrows) RS[row] = rsqrtf(ss / (float)KW + EPS); }
    __syncthreads();
    const int hh = wave & 1, rbp = wave >> 1, h = 2 * hp + hh, fr = lane & 15, g = lane >> 4; const int nrb = nrows >> 4;
    const int rb0 = 2 * rbp; const bool two = rb0 + 1 < nrb;
    if (rb0 < nrb) {
      if (part == 0) {
        f32x4 acc[2][6];
#pragma unroll
        for (int r = 0; r < 2; ++r)
#pragma unroll
            for (int i = 0; i < 6; ++i) acc[r][i] = (f32x4){0.f, 0.f, 0.f, 0.f};
#pragma unroll
        for (int ks = 0; ks < 6; ++ks) { const bf16x8 a0 = *(const LAS bf16x8*)(AT + (16 * rb0 + fr) * 200 + 32 * ks + 8 * g), a1 = *(const LAS bf16x8*)(AT + (16 * (two ? rb0 + 1 : rb0) + fr) * 200 + 32 * ks + 8 * g);
#pragma unroll
            for (int i = 0; i < 6; ++i) { const bf16x8 bw = *(const LAS bf16x8*)(WL + (96 * hh + 16 * i + fr) * 200 + 32 * ks + 8 * g);
                acc[0][i] = __builtin_amdgcn_mfma_f32_16x16x32_bf16(bw, a0, acc[0][i], 0, 0, 0); acc[1][i] = __builtin_amdgcn_mfma_f32_16x16x32_bf16(bw, a1, acc[1][i], 0, 0, 0); } }
        f32x4 gq[6];
#pragma unroll
        for (int i = 0; i < 6; ++i) gq[i] = *(const f32x4*)(p.mla_gqn + l * 96 + 16 * i + 4 * g);
#pragma unroll
        for (int r = 0; r < 2; ++r) { if (r == 1 && !two) break;
            const int t = 16 * (rb0 + r) + fr; const int pos = row_pos(r0 + t);
            const f32x4 rc0 = *(const f32x4*)(ROPE + ((size_t)pos * 16 + 4 * g) * 2), rc1 = *(const f32x4*)(ROPE + ((size_t)pos * 16 + 4 * g) * 2 + 4);
            const float cs[4] = {rc0[0], rc0[2], rc1[0], rc1[2]}, sn[4] = {rc0[1], rc0[3], rc1[1], rc1[3]};
            const float rq = RS[t]; float ss = 0.f;
#pragma unroll
            for (int i = 0; i < 6; ++i) { acc[r][i] = acc[r][i] * rq; ss += (acc[r][i][0] * acc[r][i][0] + acc[r][i][1] * acc[r][i][1]) + (acc[r][i][2] * acc[r][i][2] + acc[r][i][3] * acc[r][i][3]); }
            ss += __shfl_xor(ss, 16); ss += __shfl_xor(ss, 32);
            const float rn = rsqrtf(ss * (1.f / 96.f) + EPS);
#pragma unroll
            for (int i = 0; i < 6; ++i) acc[r][i] = acc[r][i] * gq[i] * rn;
#pragma unroll
            for (int j = 0; j < 4; ++j) { const float t1 = acc[r][4][j], t2 = acc[r][5][j]; acc[r][4][j] = t1 * cs[j] - t2 * sn[j]; acc[r][5][j] = t1 * sn[j] + t2 * cs[j]; }
            bf16_t* dst = MQ + (size_t)(r0 + t) * 384 + 96 * h + 4 * g;
#pragma unroll
            for (int i = 0; i < 6; ++i) { u32x2 w; w.x = cvtpk(acc[r][i][0] * QS_MLA, acc[r][i][1] * QS_MLA); w.y = cvtpk(acc[r][i][2] * QS_MLA, acc[r][i][3] * QS_MLA); *(u32x2*)(dst + 16 * i) = w; } }
      } else {
        f32x4 acc[2][4], accv[2][4];
#pragma unroll
        for (int r = 0; r < 2; ++r)
#pragma unroll
            for (int i = 0; i < 4; ++i) { acc[r][i] = (f32x4){0.f, 0.f, 0.f, 0.f}; accv[r][i] = (f32x4){0.f, 0.f, 0.f, 0.f}; }
#pragma unroll
        for (int ks = 0; ks < 4; ++ks) { const bf16x8 a0 = *(const LAS bf16x8*)(AT + (16 * rb0 + fr) * 136 + 32 * ks + 8 * g), a1 = *(const LAS bf16x8*)(AT + (16 * (two ? rb0 + 1 : rb0) + fr) * 136 + 32 * ks + 8 * g);
#pragma unroll
            for (int i = 0; i < 4; ++i) { const bf16x8 bw = *(const LAS bf16x8*)(WL + (128 * hh + 16 * i + fr) * 136 + 32 * ks + 8 * g), bv2 = *(const LAS bf16x8*)(WL + (128 * hh + 64 + 16 * i + fr) * 136 + 32 * ks + 8 * g);
                acc[0][i] = __builtin_amdgcn_mfma_f32_16x16x32_bf16(bw, a0, acc[0][i], 0, 0, 0); acc[1][i] = __builtin_amdgcn_mfma_f32_16x16x32_bf16(bw, a1, acc[1][i], 0, 0, 0);
                accv[0][i] = __builtin_amdgcn_mfma_f32_16x16x32_bf16(a0, bv2, accv[0][i], 0, 0, 0); accv[1][i] = __builtin_amdgcn_mfma_f32_16x16x32_bf16(a1, bv2, accv[1][i], 0, 0, 0); } }
        f32x4 gk[6];
#pragma unroll
        for (int i = 0; i < 6; ++i) gk[i] = *(const f32x4*)(p.mla_gkn + l * 96 + 16 * i + 4 * g);
#pragma unroll
        for (int r = 0; r < 2; ++r) { if (r == 1 && !two) break;
            const int rb = rb0 + r; const int t = 16 * rb + fr; const int pos = row_pos(r0 + t);
            const f32x4 rc0 = *(const f32x4*)(ROPE + ((size_t)pos * 16 + 4 * g) * 2), rc1 = *(const f32x4*)(ROPE + ((size_t)pos * 16 + 4 * g) * 2 + 4);
            const float cs[4] = {rc0[0], rc0[2], rc1[0], rc1[2]}, sn[4] = {rc0[1], rc0[3], rc1[1], rc1[3]};
            const float rk = RS[t]; float ss = 0.f;
#pragma unroll
            for (int i = 0; i < 4; ++i) { acc[r][i] = acc[r][i] * rk; ss += (acc[r][i][0] * acc[r][i][0] + acc[r][i][1] * acc[r][i][1]) + (acc[r][i][2] * acc[r][i][2] + acc[r][i][3] * acc[r][i][3]); }
            const u32x2 k1w = *(const LAS u32x2*)(KR + t * 40 + 4 * g), k2w = *(const LAS u32x2*)(KR + t * 40 + 16 + 4 * g);
            f32x4 k1 = {bflo(k1w.x), bfhi(k1w.x), bflo(k1w.y), bfhi(k1w.y)}, k2 = {bflo(k2w.x), bfhi(k2w.x), bflo(k2w.y), bfhi(k2w.y)};
            ss += (k1[0] * k1[0] + k1[1] * k1[1]) + (k1[2] * k1[2] + k1[3] * k1[3]) + (k2[0] * k2[0] + k2[1] * k2[1]) + (k2[2] * k2[2] + k2[3] * k2[3]);
            ss += __shfl_xor(ss, 16); ss += __shfl_xor(ss, 32);
            const float rn = rsqrtf(ss * (1.f / 96.f) + EPS);
#pragma unroll
            for (int i = 0; i < 4; ++i) acc[r][i] = acc[r][i] * gk[i] * rn;
            k1 = k1 * gk[4] * rn; k2 = k2 * gk[5] * rn;
            f32x4 o1, o2;
#pragma unroll
            for (int j = 0; j < 4; ++j) { o1[j] = k1[j] * cs[j] - k2[j] * sn[j]; o2[j] = k1[j] * sn[j] + k2[j] * cs[j]; }
            bf16_t* dst = MK + (size_t)(r0 + t) * 384 + 96 * h + 4 * g;
#pragma unroll
            for (int i = 0; i < 4; ++i) { u32x2 w; w.x = cvtpk(acc[r][i][0], acc[r][i][1]); w.y = cvtpk(acc[r][i][2], acc[r][i][3]); *(u32x2*)(dst + 16 * i) = w; }
            { u32x2 w; w.x = cvtpk(o1[0], o1[1]); w.y = cvtpk(o1[2], o1[3]); *(u32x2*)(dst + 64) = w; w.x = cvtpk(o2[0], o2[1]); w.y = cvtpk(o2[2], o2[3]); *(u32x2*)(dst + 80) = w; }
            const float r0k = RS[16 * rb + 4 * g], r1k = RS[16 * rb + 4 * g + 1], r2k = RS[16 * rb + 4 * g + 2], r3k = RS[16 * rb + 4 * g + 3];
#pragma unroll
            for (int i = 0; i < 4; ++i) { u32x2 w; w.x = cvtpk(accv[r][i][0] * r0k, accv[r][i][1] * r1k); w.y = cvtpk(accv[r][i][2] * r2k, accv[r][i][3] * r3k);
                *(u32x2*)(MVT + (size_t)(64 * h + 16 * i + fr) * TM + r0 + 16 * rb + 8 * (g & 1) + 4 * (g >> 1)) = w; } }
      }
    }
    __syncthreads();
}

DI int crow(int r, int hi) { return (r & 3) + 8 * (r >> 2) + 4 * hi; }
template <int DK, bool FOX>
DI void attn_unit(LAS unsigned char* lds, const bf16_t* Qp, int qpitch, const bf16_t* Kp, int kpitch, const bf16_t* VT, const float* C, bf16_t* Yp, float* gss, int grp, int hslot, int b, int qb, int jt0) {
    TID_VARS; const int r32 = lane & 31, hi = lane >> 5;
    constexpr int KC = DK / 8, KP = DK + 8, NKS = DK / 16;
    constexpr int KB_BYTES = 64 * KP * 2, VB_BYTES = 64 * 72 * 2, BUF_BYTES = KB_BYTES + VB_BYTES + 256;
    const bool meta = qb < 0;
    const int q0 = meta ? MB0 : b * SEQ + 256 * qb;
    const int NT = meta ? 1 : 1 + 4 * (qb + 1);
    const int qrow = q0 + 32 * wave + r32;
    const bool wave_on = !meta || wave < 2;
    bf16x8 qf[NKS];
#pragma unroll
    for (int ks = 0; ks < NKS; ++ks) qf[ks] = *(const GAS bf16x8*)(Qp + (size_t)qrow * qpitch + 16 * ks + 8 * hi);
    float cq = 0.f; if (FOX) cq = C[qrow];
    bf16x8 bqx = {0, 0, 0, 0, 0, 0, 0, 0};
    if (FOX) { const unsigned h1 = cvtpk(cq, 0.f) & 0xffffu; const float r1 = cq - __uint_as_float(h1 << 16);
        const unsigned h2 = cvtpk(r1, 0.f) & 0xffffu; const float r2 = r1 - __uint_as_float(h2 << 16); const unsigned h3 = cvtpk(r2, 0.f) & 0xffffu;
        u32x4 bw = {0x3f803f80u, 0x3f80u | (h1 << 16), h2 | (h3 << 16), 0u};
        if (hi) bw = (u32x4){0u, 0u, 0u, 0u};
        bqx = __builtin_bit_cast(bf16x8, bw); }
    f32x16 o0 = {0.f, 0.f, 0.f, 0.f, 0.f, 0.f, 0.f, 0.f, 0.f, 0.f, 0.f, 0.f, 0.f, 0.f, 0.f, 0.f}, o1 = o0;
    float m = 0.f, lsum = 0.f;
    u32x4 kreg0, kreg1 = {0u, 0u, 0u, 0u}, vreg, creg = {0u, 0u, 0u, 0u};
#define AT_LOAD(jt_) do { const int tr_ = ((jt_) == 0) ? MB0 : b * SEQ + 64 * ((jt_) - 1); \
        kreg0 = *(const GAS u32x4*)(Kp + (size_t)(tr_ + tid / KC) * kpitch + 8 * (tid % KC)); \
        if (DK == 96 && tid < 256) kreg1 = *(const GAS u32x4*)(Kp + (size_t)(tr_ + (512 + tid) / KC) * kpitch + 8 * ((512 + tid) % KC)); \
        vreg = *(const GAS u32x4*)(VT + (size_t)(tid >> 3) * TM + tr_ + 8 * (tid & 7)); \
        if (FOX && tid < 16) creg = *(const GAS u32x4*)(C + tr_ + 4 * tid); } while (0)
#define AT_STORE(buf_) do { LAS unsigned char* bb_ = lds + (buf_) * BUF_BYTES; \
        *(LAS u32x4*)(bb_ + ((tid / KC) * KP + 8 * (tid % KC)) * 2) = kreg0; \
        if (DK == 96 && tid < 256) *(LAS u32x4*)(bb_ + (((512 + tid) / KC) * KP + 8 * ((512 + tid) % KC)) * 2) = kreg1; \
        *(LAS u32x4*)(bb_ + KB_BYTES + ((tid >> 3) * 72 + 8 * (tid & 7)) * 2) = vreg; \
        if (FOX && tid < 16) *(LAS u32x4*)(bb_ + KB_BYTES + VB_BYTES + 16 * tid) = creg; } while (0)
#define AT_LOADX(K0, K1, V, CR, jt_) do { const int tr_ = ((jt_) == 0) ? MB0 : b * SEQ + 64 * ((jt_) - 1); \
        K0 = *(const GAS u32x4*)(Kp + (size_t)(tr_ + tid / KC) * kpitch + 8 * (tid % KC)); \
        if (DK == 96 && tid < 256) K1 = *(const GAS u32x4*)(Kp + (size_t)(tr_ + (512 + tid) / KC) * kpitch + 8 * ((512 + tid) % KC)); \
        V = *(const GAS u32x4*)(VT + (size_t)(tid >> 3) * TM + tr_ + 8 * (tid & 7)); \
        if (FOX && tid < 16) CR = *(const GAS u32x4*)(C + tr_ + 4 * tid); } while (0)
#define AT_STOREX(K0, K1, V, CR, buf_) do { LAS unsigned char* bb_ = lds + (buf_) * BUF_BYTES; \
        *(LAS u32x4*)(bb_ + ((tid / KC) * KP + 8 * (tid % KC)) * 2) = K0; \
        if (DK == 96 && tid < 256) *(LAS u32x4*)(bb_ + (((512 + tid) / KC) * KP + 8 * ((512 + tid) % KC)) * 2) = K1; \
        *(LAS u32x4*)(bb_ + KB_BYTES + ((tid >> 3) * 72 + 8 * (tid & 7)) * 2) = V; \
        if (FOX && tid < 16) *(LAS u32x4*)(bb_ + KB_BYTES + VB_BYTES + 16 * tid) = CR; } while (0)
#define AT_COMPUTE(jt) do { \
        bool vis = wave_on, elem = false; const int jr = jt - 1; const int qlo = 256 * qb + 32 * wave; \
        if (jt > 0) { if (FOX) { if (64 * jr > qlo + 31) vis = false; else elem = (64 * jr + 63 > qlo); } else { if (jr > (qlo >> 6)) vis = false; } } \
        if (vis) { \
            const LAS unsigned char* bb = lds + (jt & 1) * BUF_BYTES; \
 \
            f32x16 s0 = {0.f, 0.f, 0.f, 0.f, 0.f, 0.f, 0.f, 0.f, 0.f, 0.f, 0.f, 0.f, 0.f, 0.f, 0.f, 0.f}, s1 = s0; \
_Pragma("unroll") \
            for (int ks = 0; ks < NKS; ++ks) { const bf16x8 a0 = *(const LAS bf16x8*)(bb + (r32 * KP + 16 * ks + 8 * hi) * 2), a1 = *(const LAS bf16x8*)(bb + ((32 + r32) * KP + 16 * ks + 8 * hi) * 2); \
                s0 = __builtin_amdgcn_mfma_f32_32x32x16_bf16(a0, qf[ks], s0, 0, 0, 0); s1 = __builtin_amdgcn_mfma_f32_32x32x16_bf16(a1, qf[ks], s1, 0, 0, 0); } \
            if (FOX) { \
                const LAS float* cb = (const LAS float*)(bb + KB_BYTES + VB_BYTES); \
_Pragma("unroll") \
                for (int kb = 0; kb < 2; ++kb) { const float cv = -cb[32 * kb + r32]; \
                    const unsigned h1 = cvtpk(cv, 0.f) & 0xffffu; const float r1 = cv - __uint_as_float(h1 << 16); \
                    const unsigned h2 = cvtpk(r1, 0.f) & 0xffffu; const float r2 = r1 - __uint_as_float(h2 << 16); \
                    const unsigned h3 = cvtpk(r2, 0.f) & 0xffffu; \
                    u32x4 aw = {h1 | (h2 << 16), h3 | 0x3f800000u, 0x3f803f80u, 0u}; \
                    if (hi) aw = (u32x4){0u, 0u, 0u, 0u}; \
                    const bf16x8 ax = __builtin_bit_cast(bf16x8, aw); \
                    if (kb == 0) s0 = __builtin_amdgcn_mfma_f32_32x32x16_bf16(ax, bqx, s0, 0, 0, 0); else s1 = __builtin_amdgcn_mfma_f32_32x32x16_bf16(ax, bqx, s1, 0, 0, 0); } } \
            if (__any(m != 0.f)) { \
_Pragma("unroll") \
                for (int r = 0; r < 16; ++r) { s0[r] -= m; s1[r] -= m; } } \
            if (jt == 0 || elem) { \
_Pragma("unroll") \
                for (int r = 0; r < 16; ++r) { const int k0 = crow(r, hi), k1 = 32 + k0; bool ok0, ok1; \
                    if (jt == 0) { ok0 = false; ok1 = k1 >= 48; if (FOX && meta) ok1 = ok1 && (k1 <= 32 * wave + r32); } \
                    else { ok0 = (64 * jr + k0 <= qlo + r32); ok1 = (64 * jr + k1 <= qlo + r32); } \
                    s0[r] = ok0 ? s0[r] : -INFINITY; s1[r] = ok1 ? s1[r] : -INFINITY; } \
            } \
            float ta = __builtin_fmaxf(__builtin_fmaxf(s0[0], s0[1]), s1[0]), tb = __builtin_fmaxf(__builtin_fmaxf(s0[2], s0[3]), s1[1]); ta = __builtin_fmaxf(__builtin_fmaxf(ta, s1[2]), s1[3]); \
_Pragma("unroll") \
            for (int r = 4; r < 16; r += 4) { ta = __builtin_fmaxf(__builtin_fmaxf(ta, s0[r]), s0[r + 1]); tb = __builtin_fmaxf(__builtin_fmaxf(tb, s0[r + 2]), s0[r + 3]); ta = __builtin_fmaxf(__builtin_fmaxf(ta, s1[r]), s1[r + 1]); tb = __builtin_fmaxf(__builtin_fmaxf(tb, s1[r + 2]), s1[r + 3]); } \
            const float tmax = swap_other(__builtin_fmaxf(ta, tb), true); \
            if (__any(tmax > 8.f)) { \
                const float dl = tmax > 8.f ? tmax : 0.f; m += dl; const float al = __builtin_amdgcn_exp2f(-dl); lsum *= al; \
_Pragma("unroll") \
                for (int r = 0; r < 16; ++r) { s0[r] -= dl; s1[r] -= dl; o0[r] *= al; o1[r] *= al; } } \
            float ps0 = 0.f, ps1 = 0.f; \
_Pragma("unroll") \
            for (int r = 0; r < 16; ++r) { s0[r] = __builtin_amdgcn_exp2f(s0[r]); s1[r] = __builtin_amdgcn_exp2f(s1[r]); ps0 += s0[r]; ps1 += s1[r]; } \
            lsum += ps0 + ps1; \
            const LAS unsigned char* vb = bb + KB_BYTES; \
_Pragma("unroll") \
            for (int kb = 0; kb < 2; ++kb) \
_Pragma("unroll") \
                for (int hf = 0; hf < 2; ++hf) { u32x4 pw; \
                    if (kb == 0) { pw.x = cvtpk(s0[8 * hf + 0], s0[8 * hf + 1]); pw.y = cvtpk(s0[8 * hf + 2], s0[8 * hf + 3]); pw.z = cvtpk(s0[8 * hf + 4], s0[8 * hf + 5]); pw.w = cvtpk(s0[8 * hf + 6], s0[8 * hf + 7]); } \
                    else { pw.x = cvtpk(s1[8 * hf + 0], s1[8 * hf + 1]); pw.y = cvtpk(s1[8 * hf + 2], s1[8 * hf + 3]); pw.z = cvtpk(s1[8 * hf + 4], s1[8 * hf + 5]); pw.w = cvtpk(s1[8 * hf + 6], s1[8 * hf + 7]); } \
                    const bf16x8 pb = __builtin_bit_cast(bf16x8, pw); \
                    const bf16x8 v0 = *(const LAS bf16x8*)(vb + (r32 * 72 + 32 * kb + 16 * hf + 8 * hi) * 2), v1 = *(const LAS bf16x8*)(vb + ((32 + r32) * 72 + 32 * kb + 16 * hf + 8 * hi) * 2); \
                    o0 = __builtin_amdgcn_mfma_f32_32x32x16_bf16(v0, pb, o0, 0, 0, 0); o1 = __builtin_amdgcn_mfma_f32_32x32x16_bf16(v1, pb, o1, 0, 0, 0); } \
        } \
    } while (0)
    u32x4 kB0 = kreg0, kB1 = kreg1, vB = vreg, cB = creg;
    AT_LOADX(kreg0, kreg1, vreg, creg, jt0); AT_STOREX(kreg0, kreg1, vreg, creg, 0); if (jt0 + 1 < NT) AT_LOADX(kreg0, kreg1, vreg, creg, jt0 + 1);
    __syncthreads();
    for (int jt = jt0; jt < NT; jt += 2) {
        if (jt + 2 < NT) AT_LOADX(kB0, kB1, vB, cB, jt + 2);
        AT_COMPUTE(jt);
        if (jt + 1 < NT) AT_STOREX(kreg0, kreg1, vreg, creg, (jt + 1) & 1);
        __syncthreads();
        if (jt + 1 >= NT) break;
        if (jt + 3 < NT) AT_LOADX(kreg0, kreg1, vreg, creg, jt + 3);
        { const int j1 = jt + 1; AT_COMPUTE(j1); }
        if (jt + 2 < NT) AT_STOREX(kB0, kB1, vB, cB, (jt + 2) & 1);
        __syncthreads();
    }
#undef AT_LOADX
#undef AT_STOREX
#undef AT_COMPUTE
#undef AT_LOAD
#undef AT_STORE
    if (wave_on) {
        const float lt = swap_other(lsum, false); const float inv = lt > 0.f ? 1.f / lt : 0.f;
        const bool valid = !meta || (32 * wave + r32 >= META_OFF);
        float sq = 0.f; bf16_t* yrow = Yp + (size_t)qrow * D;
#pragma unroll
        for (int db = 0; db < 2; ++db)
#pragma unroll
            for (int i = 0; i < 4; ++i) { float y0, y1, y2, y3;
                if (db == 0) { y0 = o0[4 * i] * inv; y1 = o0[4 * i + 1] * inv; y2 = o0[4 * i + 2] * inv; y3 = o0[4 * i + 3] * inv; } else { y0 = o1[4 * i] * inv; y1 = o1[4 * i + 1] * inv; y2 = o1[4 * i + 2] * inv; y3 = o1[4 * i + 3] * inv; }
                u32x2 w; w.x = cvtpk(y0, y1); w.y = cvtpk(y2, y3);
                if (valid) *(u32x2*)(yrow + 32 * db + 8 * i + 4 * hi) = w;
                const float z0 = bflo(w.x), z1 = bfhi(w.x), z2 = bflo(w.y), z3 = bfhi(w.y); sq += (z0 * z0 + z1 * z1) + (z2 * z2 + z3 * z3); }
        sq = swap_other(sq, false);
        if (hi == 0 && valid) gss[(size_t)qrow * 16 + 4 * grp + hslot] = sq;
    }
}
DI void attn_dispatch(const Params& p, const Frame& F, int mixer, int b, int h, int qb, float* gss) {
    bf16_t* Y = (bf16_t*)(p.ws + WS_BUFB);
    if (mixer == 0) { const bf16_t* MQ = (const bf16_t*)(p.ws + WS_ATT + AT_MQ) + 96 * h; const bf16_t* MK = (const bf16_t*)(p.ws + WS_ATT + AT_MK) + 96 * h; const bf16_t* MVT = (const bf16_t*)(p.ws + WS_ATT + AT_MVT) + (size_t)64 * h * TM;
        attn_unit<96, false>(F.lds, MQ, 384, MK, 384, MVT, nullptr, Y + Y_MLA + 64 * h, gss, 2, h, b, qb, 0); }
    else { const bf16_t* Z = (const bf16_t*)(p.ws + WS_Z); const bf16_t* FVT = (const bf16_t*)(p.ws + WS_ATT + AT_FVT) + (size_t)64 * h * TM; const float* FC = (const float*)(p.ws + WS_LRU + LRU_FC) + (size_t)h * TM;
        const int jt0 = qb < 0 ? 0 : __builtin_amdgcn_readfirstlane(((const int*)(p.ws + WS_LRU + LRU_FJ0))[(h * NB + b) * 32 + qb]);
        attn_unit<64, true>(F.lds, Z + ZC_FQ + 64 * h, ZC, Z + ZC_FK + 64 * h, ZC, FVT, FC, Y + Y_FOX + 64 * h, gss, 3, h, b, qb, jt0); }
}

__global__ void __launch_bounds__(512, 2) hymba_fwd(Params p) {
    extern __shared__ __attribute__((aligned(16))) unsigned char lds_raw[];
    Frame F; F.lds = (LAS unsigned char*)lds_raw;
    F.G = gridDim.x; { const int bx = blockIdx.x; F.vcu = (F.G % 8 == 0) ? (bx % 8) * (F.G / 8) + bx / 8 : bx; }
    volatile LAS unsigned* MISC = (volatile LAS unsigned*)(F.lds + MISC_OFF);
    { const int t0 = threadIdx.x; if (t0 < 64) MISC[t0] = 0u;
      if ((t0 & 63) == 0) *(volatile LAS int*)(unsigned)(TIDTAB_LDS + 4 * (int)(__builtin_amdgcn_s_getreg((5 << 11) | 4) & 63u)) = t0 >> 6; }
    __syncthreads();
    unsigned* ctl = (unsigned*)(p.ws + WS_CTL);
    XcdBarrier bar = xcd_barrier_post(ctl + CW_BAR, MISC + 8);
    LAS float* gstab = (LAS float*)(F.lds + GST_OFF);
#define PHASE_PARAMS Params pp = p; Frame FF = F; int bid = blockIdx.x; { unsigned char* w_ = p.ws; asm volatile("" : "+s"(w_), "+s"(FF.vcu), "+s"(FF.G), "+s"(bid)); pp.ws = w_; } (void)pp; (void)bid
#define ssb ((float*)(pp.ws + WS_CTL) + CW_SS)
#define ss_in0 ((float*)(pp.ws + WS_WSM + 786432))
#define gssb ((float*)(pp.ws + WS_GSP))
#define ssp0 ((float*)(pp.ws + WS_SSP))
#define ssp1 ((float*)(pp.ws + WS_SSP) + (size_t)NR * 16)
#define hmeta2 ((float*)(pp.ws + WS_HMETA) + 16 * D)
#define bufA ((bf16_t*)(pp.ws + WS_BUFA))
#define bufB ((bf16_t*)(pp.ws + WS_BUFB))
#define Zb ((bf16_t*)(pp.ws + WS_Z))
#define hmeta ((float*)(pp.ws + WS_HMETA))

    { PHASE_PARAMS; p0_prologue(pp, FF, ss_in0); }
    xcd_barrier(bar);

    for (int l = 0; l < NLAYER; ++l) {
#define ss1 ((l == 0) ? ss_in0 : ssb + TM)
#define gss (gssb + (size_t)l * TM * 16)
        { PHASE_PARAMS; SchedPlain S{(const char*)bufA, (const char*)(pp.ws + WS_WIN + (size_t)l * ZC * D * 2), D, D, l == 0 ? 129 : 128, 11, FF.G, bid};
          { TID_VARS; fill_rs_table(S, l == 0 ? ss_in0 : ssp1, l == 0 ? 1 : 16, gstab, tid); }
          EpiZ E{Zb};
          pg8::gemm_phase<EpiZ, SchedPlain, false, false>(FF.lds, D, D, S, E, gstab);
          if (l == 0) { const int B = FF.G >> 3, U8 = (129 * 11 + 7) >> 3, last = ((U8 + B - 1) / B - 1) * B;
              int rank = 0, nidle = 0, mine = 0;
              for (int x = 0; x < 8; ++x) { int a = S.xcnt(x) - last; a = a < 0 ? 0 : (a > B ? B : a); if (x < (bid & 7)) rank += B - a; if (x == (bid & 7)) mine = a; nidle += B - a; }
              if ((bid >> 3) >= mine) { TID_VARS; convert_weights(pp, (LAS float*)(FF.lds + wave * 16384), CV_I_IN, CV_NITEMS, (rank + (bid >> 3) - mine) * 8 + wave, nidle * 8, lane); } }
          if (l == 1) { TID_VARS; const int fr = lane & 15, g = lane >> 4; LAS float* rsm = (LAS float*)(FF.lds + 8192);
              if (FF.vcu < ZC / 16) meta_rs(rsm, hmeta2, tid);
              for (int u = FF.vcu; u < ZC / 16; u += FF.G) { const f32x4 a = skinny_block(FF.lds, bufA + (size_t)MROW0 * D, D, (const bf16_t*)(pp.ws + WS_WIN + (size_t)ZC * D * 2), D, 16 * u, 128, 1.f, tid);
                  if (wave == 0) { const float rs = rsm[fr]; u32x2 w; w.x = cvtpk(a[0] * rs, a[1] * rs); w.y = cvtpk(a[2] * rs, a[3] * rs); *(u32x2*)(Zb + (size_t)(MROW0 + fr) * ZC + 16 * u + 4 * g) = w; } } }
        }
        xcd_barrier(bar);
        { PHASE_PARAMS; const int NU = NB * NSEG + 1;
          for (int u = bid; u < NU; u += FF.G) {
              if (u < NB * NSEG) { const int b = u / NSEG, s = u % NSEG; const int r0 = b * SEQ + 64 * s; lru_local_unit<64>(pp, FF, l, r0, s == 0 ? MB0 + 61 : r0 - 3, u); }
              else lru_local_unit<16>(pp, FF, l, MROW0, MB0 + 45, NB * NSEG);
          }
          for (int u = bid; u < 5 * 256; u += FF.G) { const int mx = u >> 8, r0 = 128 * (u & 255);
              if (mx < 4) mla_prep_unit(pp, FF, l, r0, 128, mx >> 1, mx & 1); else fox_prep_unit<128>(pp, FF, l, r0); }
          { const int mx = FF.G - 1 - bid; if (mx < 4) mla_prep_unit(pp, FF, l, MROW0, 16, mx >> 1, mx & 1); else if (mx == 4) fox_prep_unit<16>(pp, FF, l, MROW0); }
          { TID_VARS; const int gt = FF.vcu * 512 + tid, NTH = FF.G * 512;
            for (int i = gt; i < 2 * 256 * 6; i += NTH) { const int c = i % 6, hd = (i / 6) & 255, arr = i / (6 * 256);
                *(u32x4*)((bf16_t*)(pp.ws + WS_ATT + (arr ? AT_FVT : AT_MVT)) + (size_t)hd * TM + MB0 + 8 * c) = zero4(); } }
          { TID_VARS; const int NW = NB * 4 * NSEG + 4;
            for (int wu = (FF.vcu * 8 + wave); wu < NW; wu += FF.G * 8) {
                if (wu < NB * 4 * NSEG) { const int bh = wu / NSEG, sg = wu % NSEG; hg_local_wave(pp, FF.lds + wave * HG_WL, l, (bh >> 2) * SEQ + 64 * sg, 64, bh & 3, wu, lane); }
                else hg_local_wave(pp, FF.lds + wave * HG_WL, l, MROW0, 16, wu - NB * 4 * NSEG, wu, lane);
            } }
        }
        xcd_barrier(bar);
        { PHASE_PARAMS; TID_VARS; const int bx = FF.G - 1 - bid;
          if (bx < 2) { const int i = bx * 512 + tid; lru_carry(pp, i >> 8, i & 255); }
          for (int u = bid; u < 128; u += FF.G) hg_carry_block(pp, FF.lds, u >> 3, u & 7, tid);
          for (int u = bid - 128; u >= 0 && u < 16; u += FF.G) fox_cscan_block(pp, FF.lds, l, u >> 2, u & 3, tid); }
        xcd_barrier(bar);
        { PHASE_PARAMS;
          for (int u = bid; u < NB * NSEG + 1; u += FF.G) {
              if (u < NB * NSEG) { const int b = u / NSEG, sg = u % NSEG; lru_fix_unit<64>(pp, FF, l, b * SEQ + 64 * sg, u, false, gss); }
              else lru_fix_unit<16>(pp, FF, l, MROW0, NB * NSEG, true, gss);
          }
          { TID_VARS; const int NW = NB * 4 * NSEG + 4;
            for (int wu = (FF.vcu * 8 + wave); wu < NW; wu += FF.G * 8) {
                if (wu < NB * 4 * NSEG) { const int bh = wu / NSEG, sg = wu % NSEG; hg_fix_wave(pp, (bh >> 2) * SEQ + 64 * sg, 64, bh & 3, wu, false, gss, lane); }
                else hg_fix_wave(pp, MROW0, 16, wu - NB * 4 * NSEG, wu, true, gss, lane);
            } }
          __syncthreads();
          for (int u = FF.vcu; u < 1024; u += FF.G) { const int mx = u >> 9, i = u & 511, bh = (i & 255) >> 4, sidx = i & 15, qb = (i >> 8) ? 31 - sidx : sidx;
              attn_dispatch(pp, FF, mx, bh >> 2, bh & 3, qb, gss); }
          if (FF.vcu < 8) attn_dispatch(pp, FF, FF.vcu >> 2, 0, FF.vcu & 3, -1, gss);
        }
        xcd_barrier(bar);
        { PHASE_PARAMS; SchedPlain S{(const char*)bufB, (const char*)(pp.ws + WS_WOUT + (size_t)l * D * D * 2), D, D, 128, 4, FF.G, bid};
          { TID_VARS; Unit u; for (int i = 0; i < 4 && S.next(i, u); ++i) { if (tid < 256) { const int row = u.pm * 256 + tid; const f32x4* gq = (const f32x4*)(gss + (size_t)row * 16); float gsum[4];
#pragma unroll
                    for (int q = 0; q < 4; ++q) { const f32x4 v = gq[q]; gsum[q] = (v[0] + v[1]) + (v[2] + v[3]); }
                    const float r0 = rsqrtf(gsum[0] * (1.f / 256.f) + EPS), r1 = rsqrtf(gsum[1] * (1.f / 256.f) + EPS), r2 = rsqrtf(gsum[2] * (1.f / 256.f) + EPS), r3 = rsqrtf(gsum[3] * (1.f / 256.f) + EPS);
                    *(LAS f32x4*)(gstab + (i * 256 + tid) * 4) = (f32x4){r0 / r1, r1 / r2, r2 / r3, r3}; } }
            __syncthreads(); }
#ifdef FFN_GU_FP8
          EpiRes E{bufA, l == 0 ? ssp0 : nullptr, 1, (unsigned char*)(pp.ws + WS_H8), 1.f};
#else
          EpiRes E{bufA, l == 0 ? ssp0 : nullptr, 1, l == 0 ? nullptr : (unsigned char*)(pp.ws + WS_H8), 1.f};
#endif
          pg8::gemm_phase<EpiRes, SchedPlain, false, true>(FF.lds, D, D, S, E, gstab);
          if (l == 0) { TID_VARS; LAS float* scr = (LAS float*)(FF.lds + 16384 + wave * 8704); const int gw = FF.vcu * 8 + wave, NGW = FF.G * 8;
              constexpr int I_G = 88 * 16, I_D = 32 * 44;
#ifdef FFN_GU_FP8
              for (int it = gw; it < 2 * I_G + I_D; it += NGW) { int r = it;
#else
              for (int it = gw + 2 * I_G; it < 2 * I_G + I_D; it += NGW) { int r = it;
#endif
                  if (r < 2 * I_G) { const int up = r / I_G; r %= I_G; const int sb = r / 16, kb = r % 16;
                      wt_item8(up ? pp.ffn_w_up : pp.ffn_w_gate, DFF, 32 * sb, pp.norm2_g, W8_SCALE, (unsigned char*)(pp.ws + WS_FGU8), D, 256 * (sb >> 2) + 128 * up + 32 * (sb & 3), 64 * kb, scr, lane); }
                  else { r -= 2 * I_G; const int sb = r / 44, kb = r % 44; wt_item8(pp.ffn_w_down, D, 32 * sb, nullptr, W8_SCALE, (unsigned char*)(pp.ws + WS_FD8), DFF, 32 * sb, 64 * kb, scr, lane); } }
              __syncthreads(); }
          if (l == 0) { TID_VARS; const int fr = lane & 15, g = lane >> 4;
              for (int u = FF.vcu; u < 64; u += FF.G) { const size_t row = (size_t)(MROW0 + fr);
                  const f32x4 gv = *(const f32x4*)(gss + row * 16 + 4 * (wave >> 1)); const float sc = rsqrtf(((gv[0] + gv[1]) + (gv[2] + gv[3])) * (1.f / 256.f) + EPS);
                  const f32x4 o = skinny_block(FF.lds, bufB + (size_t)MROW0 * D, D, (const bf16_t*)(pp.ws + WS_WOUT), D, 16 * u, 128, sc, tid);
                  if (wave == 0) { const f32x4 hn = *(const f32x4*)(pp.meta + (size_t)fr * D + 16 * u + 4 * g) + o; *(f32x4*)(hmeta + (size_t)fr * D + 16 * u + 4 * g) = hn;
                      u32x2 w; w.x = cvtpk(hn[0], hn[1]); w.y = cvtpk(hn[2], hn[3]); *(u32x2*)(bufA + row * D + 16 * u + 4 * g) = w; } } }
        }
        xcd_barrier(bar);
        if (l == 0) {
#ifdef FFN_GU_FP8
            { PHASE_PARAMS; SchedPlain S{(const char*)(pp.ws + WS_H8), (const char*)(pp.ws + WS_FGU8), 512, 512, 128, 22, FF.G, bid};
              { TID_VARS; fill_rs_table(S, ssp0, 16, gstab, tid); }
              EpiGU8 E{(unsigned char*)Zb, DFF, 1.f / W8_SCALE};
              pg8::gemm_phase<EpiGU8, SchedPlain, false, false, true>(FF.lds, 512, 512, S, E, gstab);
#else
            { PHASE_PARAMS; SchedPlain S{(const char*)bufA, (const char*)(pp.ws + WS_WGU), D, D, 128, 22, FF.G, bid};
              { TID_VARS; fill_rs_table(S, ssp0, 16, gstab, tid); }
              EpiGU8 E{(unsigned char*)Zb, DFF, 1.f};
              pg8::gemm_phase<EpiGU8, SchedPlain, false, false, false>(FF.lds, D, D, S, E, gstab);
#endif
              { TID_VARS; const int fr = lane & 15, g = lane >> 4; LAS float* rsm = (LAS float*)(FF.lds + 8192);
                if (FF.vcu < DFF / 16) meta_rs(rsm, hmeta, tid);
                for (int u = FF.vcu; u < DFF / 16; u += FF.G) { const int c0 = 16 * u, tj = c0 >> 7, wi = c0 & 127;
                    const f32x4 ag = skinny_block(FF.lds, bufA + (size_t)MROW0 * D, D, (const bf16_t*)(pp.ws + WS_WGU), D, 256 * tj + wi, 128, 1.f, tid);
                    const f32x4 au = skinny_block(FF.lds, bufA + (size_t)MROW0 * D, D, (const bf16_t*)(pp.ws + WS_WGU), D, 256 * tj + 128 + wi, 128, 1.f, tid);
                    if (wave == 0) { const float rs = rsm[fr]; float a[4];
#pragma unroll
                        for (int j = 0; j < 4; ++j) { const float gg = ag[j] * rs, uu = au[j] * rs; a[j] = gg * uu * __builtin_amdgcn_rcpf(1.f + __expf(-gg)); }
                        u32x2 w; w.x = cvtpk(a[0], a[1]); w.y = cvtpk(a[2], a[3]); *(u32x2*)(Zb + (size_t)(MROW0 + fr) * DFF + c0 + 4 * g) = w; } } }
            }
            xcd_barrier(bar);
            { PHASE_PARAMS; SchedPlain S{(const char*)Zb, (const char*)(pp.ws + WS_FD8), DFF / 2, DFF / 2, 128, 4, FF.G, bid};
              EpiRes E{bufA, ssp1, 0, nullptr, 1.f / (W8_SCALE * ACT8_SCALE)};
              pg8::gemm_phase<EpiRes, SchedPlain, false, false, true>(FF.lds, DFF / 2, DFF / 2, S, E, gstab);
              { TID_VARS; const int fr = lane & 15, g = lane >> 4;
                for (int u = FF.vcu; u < 64; u += FF.G) {
                    const f32x4 o = skinny_block(FF.lds, Zb + (size_t)MROW0 * DFF, DFF, (const bf16_t*)(pp.ws + WS_WD), DFF, 16 * u, 352, 1.f, tid);
                    if (wave == 0) { const f32x4 hn = *(const f32x4*)(hmeta + (size_t)fr * D + 16 * u + 4 * g) + o; *(f32x4*)(hmeta2 + (size_t)fr * D + 16 * u + 4 * g) = hn;
                        u32x2 w; w.x = cvtpk(hn[0], hn[1]); w.y = cvtpk(hn[2], hn[3]); *(u32x2*)(bufA + (size_t)(MROW0 + fr) * D + 16 * u + 4 * g) = w; } } }
            }
            xcd_barrier(bar);
        }
    }
#if STAGE >= 2
#define mlist ((int*)(pp.ws + WS_CTL + CTL_LIST))
#define mlrs ((float*)(pp.ws + WS_CTL + CTL_LRS))
#define mlgate ((float*)(pp.ws + WS_CTL + CTL_LGATE))
#define mcnt ((unsigned*)(pp.ws + WS_CTL) + CW_MCNT)
    { PHASE_PARAMS; TID_VARS;
      LAS float* WR = (LAS float*)FF.lds;
      LAS int* ph = (LAS int*)(FF.lds + 32768);
      for (int i = tid; i < 1024 * 8; i += 512) WR[i] = pp.moe_w_router[i] * pp.norm2_g[D + (i >> 3)];
      for (int u = bid; u < NR / 128; u += FF.G) {
          if (tid < 64) ph[tid] = 0;
          __syncthreads();
          {
              const int t16 = lane & 15, kq = lane >> 4, tl = wave * 16 + t16, tok = u * 128 + tl;
              float ss = 0.f, lg[8];
#pragma unroll
              for (int e = 0; e < 8; ++e) lg[e] = 0.f;
              const bf16_t* hrow = bufA + (size_t)tok * D + 256 * kq;
#pragma unroll 4
              for (int c = 0; c < 32; ++c) { const u32x4 hw = *(const u32x4*)(hrow + 8 * c); const float hv[8] = {bflo(hw.x), bfhi(hw.x), bflo(hw.y), bfhi(hw.y), bflo(hw.z), bfhi(hw.z), bflo(hw.w), bfhi(hw.w)};
#pragma unroll
                  for (int q = 0; q < 8; ++q) { const float hx = hv[q]; ss += hx * hx; const int k = 256 * kq + 8 * c + q; const f32x4 w0 = *(const LAS f32x4*)(WR + k * 8), w1 = *(const LAS f32x4*)(WR + k * 8 + 4);
                      lg[0] += hx * w0[0]; lg[1] += hx * w0[1]; lg[2] += hx * w0[2]; lg[3] += hx * w0[3]; lg[4] += hx * w1[0]; lg[5] += hx * w1[1]; lg[6] += hx * w1[2]; lg[7] += hx * w1[3]; } }
              ss += __shfl_xor(ss, 16); ss += __shfl_xor(ss, 32);
#pragma unroll
              for (int e = 0; e < 8; ++e) { lg[e] += __shfl_xor(lg[e], 16); lg[e] += __shfl_xor(lg[e], 32); }
              if (kq == 0) { const float rs = rsqrtf(ss * (1.f / 1024.f) + EPS);
                  int e1 = 0; float v1 = lg[0];
#pragma unroll
                  for (int e = 1; e < 8; ++e) if (lg[e] > v1) { v1 = lg[e]; e1 = e; }
                  int e2 = -1; float v2 = -INFINITY;
#pragma unroll
                  for (int e = 0; e < 8; ++e) if (e != e1 && lg[e] > v2) { v2 = lg[e]; e2 = e; }
                  const float g1 = 1.f / (1.f + __expf((v2 - v1) * rs)), g2 = 1.f - g1;
                  const int lo = e1 < e2 ? e1 : e2, hi = e1 < e2 ? e2 : e1; const float glo = e1 < e2 ? g1 : g2, ghi = e1 < e2 ? g2 : g1;
                  __hip_atomic_fetch_add(&ph[lo * 8 + hi], 1, __ATOMIC_RELAXED, __HIP_MEMORY_SCOPE_WORKGROUP);
                  *(f32x4*)(pp.ws + WS_TOKREC + (size_t)tok * 16) = (f32x4){__int_as_float(lo | (hi << 8)), glo, ghi, rs}; } }
          __syncthreads();
          if (tid < 64) ((int*)(pp.ws + WS_PAIRH))[u * 64 + tid] = ph[tid];
          __syncthreads();
      }
      { LAS float* scr = (LAS float*)(FF.lds + 49152 + wave * 8704);
        const int gw = FF.vcu * 8 + wave, NGW = FF.G * 8; constexpr int I_GU = 112 * 16, I_DN = 32 * 56, I_E = 2 * I_GU + I_DN;
        for (int it = gw; it < NEXP * I_E; it += NGW) { const int e = it / I_E; int r = it % I_E;
            if (r < 2 * I_GU) { const int up = r / I_GU; r %= I_GU; const int sb = r / 16, kb = r % 16;
                wt_item8((up ? pp.moe_w_up : pp.moe_w_gate) + (size_t)e * D * DFE, DFE, 32 * sb, pp.norm2_g + D, W8_SCALE, (unsigned char*)(pp.ws + WS_MGU) + (size_t)e * 7168 * D, D, 256 * (sb >> 2) + 128 * up + 32 * (sb & 3), 64 * kb, scr, lane); }
            else { r -= 2 * I_GU; const int sb = r / 56, kb = r % 56;
                wt_item8(pp.moe_w_down + (size_t)e * DFE * D, D, 32 * sb, nullptr, W8_SCALE, (unsigned char*)(pp.ws + WS_MD) + (size_t)e * D * DFE, DFE, 32 * sb, 64 * kb, scr, lane); } } }
    }
    xcd_barrier(bar);
    { PHASE_PARAMS; TID_VARS;
      LAS int* part = (LAS int*)FF.lds;
      LAS int* Tt = part + 512;
      LAS int* Qt = Tt + 64;
      LAS int* pfx = Qt + 64;
      LAS int* typ = pfx + 64;
      LAS int* lc = typ + 128;
      LAS int* pq = lc + 32;
      LAS int* tmpq = pq + 32;
      const int* PH = (const int*)(pp.ws + WS_PAIRH);
      { const int p = tid & 63, ch = tid >> 6; int a = 0;
        for (int i = 0; i < 32; ++i) a += PH[(ch * 32 + i) * 64 + p];
        part[ch * 64 + p] = a; }
      __syncthreads();
      if (tid < 64) { int a = 0; for (int ch = 0; ch < 8; ++ch) a += part[ch * 64 + tid]; Tt[tid] = a; Qt[tid] = 0; }
      __syncthreads();
      if (tid == 0) {
          for (int e = 0; e < 8; ++e) { int c = 0; for (int lo = 0; lo < 8; ++lo) c += Tt[lo * 8 + e]; pq[e] = c; }
          int qh = 0, qt = 0, carry = 0;
          for (int e = 7; e >= 1; --e) { const int r = pq[e] & 255, need = (256 - r) & 255;
              if (r == 0) continue;
              if (carry >= need) { int rem = need; carry -= need;
                  while (rem > 0) { const int sx = pq[8 + qh], n = rem < pq[16 + qh] ? rem : pq[16 + qh]; Qt[e * 8 + sx] += n; pq[16 + qh] -= n; rem -= n; if (pq[16 + qh] == 0) ++qh; } }
              else { pq[8 + qt] = e; pq[16 + qt] = r; ++qt; carry += r; } }
          for (; qh < qt; ++qh) if (pq[16 + qh] > 0) Qt[pq[8 + qh]] += pq[16 + qh];
          bool ok = true; for (int p = 0; p < 64; ++p) ok = ok && (Qt[p] <= Tt[p]);
          if (!ok) for (int p = 0; p < 64; ++p) Qt[p] = 0; }
      __syncthreads();
      for (int u = bid; u < NR / 128; u += FF.G) {
          if (tid < 16) lc[tid] = 0;
          { const int p = tid & 63, g = tid >> 6, c0 = u >> 5, i0 = c0 * 32 + 4 * g; int a = 0;
#pragma unroll
            for (int i = 0; i < 4; ++i) { const int v = PH[(i0 + i < NR / 128 ? i0 + i : 0) * 64 + p]; a += (i0 + i < u) ? v : 0; }
            tmpq[g * 64 + p] = a; }
          __syncthreads();
          if (tid < 64) { int a = 0; const int c0 = u >> 5; for (int ch = 0; ch < c0; ++ch) a += part[ch * 64 + tid]; for (int g = 0; g < 8; ++g) a += tmpq[g * 64 + tid]; pfx[tid] = a; }
          f32x4 rec = {0.f, 0.f, 0.f, 0.f}; int lo = 0, hi = 0;
          if (tid < 128) { rec = *(const f32x4*)(pp.ws + WS_TOKREC + (size_t)(u * 128 + tid) * 16); const int pk = __float_as_int(rec[0]); lo = pk & 255; hi = pk >> 8; typ[tid] = lo * 8 + hi; }
          __syncthreads();
          int p0 = 0, p1 = 0, e0 = 0, e1 = 0; float g0 = 0.f, g1 = 0.f;
          if (tid < 128) { const int ty = lo * 8 + hi; int rk = pfx[ty];
              for (int j = 0; j < tid; j += 4) { const i32x4 t4 = *(const LAS i32x4*)(typ + j); rk += ((t4[0] == ty) ? 1 : 0) + ((j + 1 < tid && t4[1] == ty) ? 1 : 0) + ((j + 2 < tid && t4[2] == ty) ? 1 : 0) + ((j + 3 < tid && t4[3] == ty) ? 1 : 0); }
              const bool sw = rk < Qt[ty]; e0 = sw ? hi : lo; e1 = sw ? lo : hi; g0 = sw ? rec[2] : rec[1]; g1 = sw ? rec[1] : rec[2];
              p0 = __hip_atomic_fetch_add(&lc[e0], 1, __ATOMIC_RELAXED, __HIP_MEMORY_SCOPE_WORKGROUP); p1 = __hip_atomic_fetch_add(&lc[8 + e1], 1, __ATOMIC_RELAXED, __HIP_MEMORY_SCOPE_WORKGROUP); }
          __syncthreads();
          if (tid < 16) lc[16 + tid] = (int)atomicAdd(mcnt + tid, (unsigned)lc[tid]);
          __syncthreads();
          if (tid < 128) { const int tok = u * 128 + tid; const float rs = rec[3];
              const int i0 = e0 * 32768 + lc[16 + e0] + p0, i1 = (8 + e1) * 32768 + lc[16 + 8 + e1] + p1;
              mlist[i0] = tok; mlrs[i0] = rs; mlgate[i0] = g0; mlist[i1] = tok; mlrs[i1] = rs; mlgate[i1] = g1; }
          __syncthreads();
      }
    }
    xcd_barrier(bar);
    LAS int* tab0 = (LAS int*)(F.lds + GST_OFF);
    { PHASE_PARAMS; TID_VARS; __syncthreads();
      if (tid < 2) { const int ps = tid; LAS int* tb = tab0 + ps * 640; int t = 0;
          for (int e = 0; e < 8; ++e) { const int n = (int)__hip_atomic_load(mcnt + ps * 8 + e, __ATOMIC_RELAXED, __HIP_MEMORY_SCOPE_AGENT); for (int o = 0; o < n; o += 256) { tb[t * 4] = e; tb[t * 4 + 1] = o; tb[t * 4 + 2] = n; tb[t * 4 + 3] = 0; ++t; } }
          tab0[1280 + ps] = t; }
      __syncthreads();
      const int nT0 = tab0[1280], nT1 = tab0[1281];
      for (int u = FF.vcu; u < nT0 + nT1; u += FF.G) { const int ps = u < nT0 ? 0 : 1, t = ps ? u - nT0 : u; const LAS int* tb = tab0 + ps * 640;
          const int e = tb[t * 4], off = tb[t * 4 + 1], n = tb[t * 4 + 2]; const int* lst = mlist + (ps * 8 + e) * 32768;
          unsigned char* dst = (unsigned char*)(pp.ws + WS_MAS) + ((size_t)(ps * 136 + t) * 256) * 1024; const unsigned char* src = (const unsigned char*)(pp.ws + WS_H8);
#pragma unroll 4
          for (int r = wave; r < 256; r += 8) { u32x4 v = {0u, 0u, 0u, 0u}; if (off + r < n) { const int tok = lst[off + r]; v = *(const u32x4*)(src + (size_t)tok * 1024 + 16 * lane); }
              *(u32x4*)(dst + (size_t)r * 1024 + 16 * lane) = v; } }
    }
    xcd_barrier(bar);
    {
        LAS int* tabA = tab0; LAS int* tabB = tab0 + 640;
        const int nT0 = __builtin_amdgcn_readfirstlane(tab0[1280]), nT1 = __builtin_amdgcn_readfirstlane(tab0[1281]);
        { PHASE_PARAMS; SchedMoe S{(const char*)(pp.ws + WS_MAS), (const char*)(pp.ws + WS_MGU), (size_t)7168 * D, 512, 512, nT0, 28, FF.G, bid, tabA, mlist, false, 0u, 0, 0};
          EpiMoeGU E{(unsigned char*)(pp.ws + WS_MACT), mlrs, tabA};
          { TID_VARS; fill_moe_rs_table(S, mlrs, gstab + 2048, tid); }
          pg8::gemm_phase<EpiMoeGU, SchedMoe, false, false, true>(FF.lds, 512, 512, S, E, gstab + 2048); }
        xcd_barrier(bar);
        { PHASE_PARAMS;
          { SchedMoe S{(const char*)(pp.ws + WS_MACT), (const char*)(pp.ws + WS_MD), (size_t)D * DFE, DFE / 2, DFE / 2, nT0, 4, FF.G, bid, tabA, mlist, false, 0u, 0, 0};
            EpiMoeDown E{pp.out, mlist, mlgate, tabA, bufA, false};
            pg8::gemm_phase<EpiMoeDown, SchedMoe, false, false, true>(FF.lds, DFE / 2, DFE / 2, S, E, gstab); }
          { const int ud8 = (nT0 * 4 + 7) >> 3, udx = nT0 * 4 - (bid & 7) * ud8, udc = udx < ud8 ? udx : ud8;
            const int nheavy = udc > 2 * (FF.G >> 3) ? udc - 2 * (FF.G >> 3) : 0;
            SchedMoe S{(const char*)(pp.ws + WS_MAS) + (size_t)136 * 256 * 1024, (const char*)(pp.ws + WS_MGU), (size_t)7168 * D, 512, 512, nT1, 28, FF.G, bid, tabB, mlist + 8 * 32768, false, 0u, nheavy, 2};
            EpiMoeGU E{(unsigned char*)(pp.ws + WS_MACT1), mlrs + 8 * 32768, tabB};
            { TID_VARS; fill_moe_rs_table(S, mlrs + 8 * 32768, gstab + 2048, tid); }
            pg8::gemm_phase<EpiMoeGU, SchedMoe, false, false, true>(FF.lds, 512, 512, S, E, gstab + 2048); } }
        xcd_barrier(bar);
        { PHASE_PARAMS; SchedMoe S{(const char*)(pp.ws + WS_MACT1), (const char*)(pp.ws + WS_MD), (size_t)D * DFE, DFE / 2, DFE / 2, nT1, 4, FF.G, bid, tabB, mlist + 8 * 32768, false, 0u, 0, 0};
          EpiMoeDown E{pp.out, mlist + 8 * 32768, mlgate + 8 * 32768, tabB, bufA, true};
          pg8::gemm_phase<EpiMoeDown, SchedMoe, false, false, true>(FF.lds, DFE / 2, DFE / 2, S, E, gstab); }
    }
#endif
}

extern "C" void kernel_launch(void* const* d_in, const int* in_sizes, int n_in, void* d_out, int out_size, void* d_ws, size_t ws_size, hipStream_t stream) {
    static int grid = 0;
    if (grid == 0) {
        if (n_in != 31 || out_size != NR * D || ws_size < WS_END) { fprintf(stderr, "kernel_launch: unexpected sizes n_in %d out %d ws %zu\n", n_in, out_size, ws_size); grid = -1; return; }
        int dev = 0, cus = 0, per_cu = 0;
        if (hipGetDevice(&dev) != hipSuccess || hipDeviceGetAttribute(&cus, hipDeviceAttributeMultiprocessorCount, dev) != hipSuccess) { grid = -1; return; }
        if (hipFuncSetAttribute((const void*)hymba_fwd, hipFuncAttributeMaxDynamicSharedMemorySize, LDS_BYTES) != hipSuccess) { fprintf(stderr, "kernel_launch: hipFuncSetAttribute failed\n"); grid = -1; return; }
        if (hipOccupancyMaxActiveBlocksPerMultiprocessor(&per_cu, (const void*)hymba_fwd, 512, LDS_BYTES) != hipSuccess || per_cu < 1) { fprintf(stderr, "kernel_launch: occupancy query says %d\n", per_cu); (void)hipGetLastError(); per_cu = 1; }
        grid = cus;
    }
    if (grid < 0) return;
    (void)hipMemsetAsync((char*)d_ws + WS_CTL, 0, CTL_BYTES, stream);
    Params p{};
    const float** pp = (const float**)&p;
    for (int i = 0; i < 31; ++i) pp[i] = (const float*)d_in[i];
    p.out = (float*)d_out; p.ws = (unsigned char*)d_ws;
    hipLaunchKernelGGL(hymba_fwd, dim3(grid), dim3(512), LDS_BYTES, stream, p);
}
```

```cpp
#include <hip/hip_runtime.h>
#include <cstdint>
#include <cstdio>

#define LAS __attribute__((address_space(3)))
#define GAS __attribute__((address_space(1)))
#define DI __device__ __forceinline__
typedef unsigned short bf16_t;
typedef short bf16x8 __attribute__((ext_vector_type(8)));
typedef short s16x4 __attribute__((ext_vector_type(4)));
typedef float f32x2 __attribute__((ext_vector_type(2)));
typedef int i32x4 __attribute__((ext_vector_type(4)));
typedef float f32x4 __attribute__((ext_vector_type(4)));
typedef float f32x16 __attribute__((ext_vector_type(16)));
typedef unsigned u32x2 __attribute__((ext_vector_type(2)));
typedef unsigned u32x4 __attribute__((ext_vector_type(4)));
typedef __bf16 bf16x2_t __attribute__((ext_vector_type(2)));

#ifndef STAGE
#define STAGE 2
#endif
#if STAGE >= 2
#define NLAYER 2
#else
#define NLAYER 1
#endif

constexpr int NB = 4, SEQ = 8192, D = 1024, NR = NB * SEQ;
constexpr int MB0 = NR, META_OFF = 48, NMETA = 16;
constexpr int MROW0 = MB0 + META_OFF;
constexpr int TM = NR + 256;
constexpr int ZC = 2816;
constexpr float EPS = 1e-6f;
constexpr int ZC_XA = 0, ZC_GA = 256, ZC_HQ = 512, ZC_HF = 768, ZC_HV = 1024, ZC_HG = 1280, ZC_CQ = 1536, ZC_CKV = 1792, ZC_KR = 1920, ZC_FF = 1952, ZC_FQ = 2048, ZC_FK = 2304, ZC_FV = 2560;
constexpr int Y_LRU = 0, Y_HG = 256, Y_MLA = 512, Y_FOX = 768;
constexpr int DFF = 2816, DFE = 3584, NEXP = 8;
constexpr int NSEG = 128;

constexpr size_t MiB = 1u << 20;
constexpr size_t WS_CTL = 0, CTL_BYTES = 8 * MiB;
constexpr size_t WS_WIN = 8 * MiB;
constexpr size_t WS_WOUT = 19 * MiB;
constexpr size_t WS_WGU = 23 * MiB;
constexpr size_t WS_WD = 34 * MiB;
constexpr size_t WS_WSM = 40 * MiB;
constexpr size_t WS_BUFA = 41 * MiB;
constexpr size_t WS_BUFB = 106 * MiB;
constexpr size_t WS_Z = 171 * MiB;
constexpr size_t WS_ATT = 349 * MiB;
constexpr size_t WS_LRU = 430 * MiB;
constexpr size_t WS_HG = 465 * MiB;
constexpr size_t WS_SSP = 499 * MiB;
constexpr size_t WS_GSP = 503 * MiB;
constexpr size_t WS_END = 508 * MiB;
constexpr size_t SM_LRUW = 0;
constexpr size_t SM_WUQ = 131072;
constexpr size_t SM_WUKV = 131072 + 294912;
constexpr size_t SM_ROPE = 131072 + 294912 + 262144;
constexpr int CW_BAR = 4096;
constexpr int CW_SS = 16384;
constexpr int CW_GSS = CW_SS + 3 * TM;
constexpr int CW_ENDW = CW_GSS + 2 * TM * 4;
static_assert((size_t)CW_ENDW * 4 <= CTL_BYTES, "ctl");
constexpr size_t LRU_LA = 0, LRU_BC = (size_t)TM * 256 * 2, LRU_AGGA = 2 * (size_t)TM * 256 * 2, LRU_AGGB = LRU_AGGA + (size_t)(NB * NSEG + 1) * 256 * 4, LRU_HIN = LRU_AGGB + (size_t)(NB * NSEG + 1) * 256 * 4;
static_assert(LRU_HIN + (size_t)(NB * NSEG + 1) * 256 * 4 <= 35 * MiB, "lru");
constexpr int HG_SLOTS = NB * 4 * NSEG + 4;
constexpr size_t HG_UT = 0, HG_DL = (size_t)HG_SLOTS * 4096 * 4;
static_assert(HG_DL + (size_t)HG_SLOTS * 64 * 4 <= 34 * MiB, "hg");
constexpr size_t AT_MQ = 0, AT_MK = (size_t)TM * 384 * 2, AT_MVT = 2 * (size_t)TM * 384 * 2, AT_FVT = AT_MVT + (size_t)256 * TM * 2, AT_END = AT_FVT + (size_t)256 * TM * 2;
static_assert(AT_END <= 81 * MiB, "att");
constexpr size_t LRU_FC = ((LRU_HIN + (size_t)(NB * NSEG + 1) * 256 * 4 + 255) / 256) * 256, LRU_FLF = LRU_FC + (size_t)4 * TM * 4;
constexpr size_t LRU_FJ0 = LRU_FLF + (size_t)4 * TM * 4;
static_assert(LRU_HIN + (size_t)(NB * NSEG + 1) * 256 * 4 <= LRU_FC && LRU_FJ0 + 4 * 4 * 32 * 4 <= 35 * MiB, "lru2");
constexpr size_t HG_ROPE = 33 * MiB - 256 * 1024;
static_assert(HG_DL + (size_t)HG_SLOTS * 64 * 4 <= HG_ROPE && HG_ROPE + (size_t)8208 * 16 * 8 <= 34 * MiB, "hg2");

constexpr size_t WS_MGU = 106 * MiB;
constexpr size_t WS_MD = 162 * MiB;
constexpr size_t WS_MACT = 190 * MiB;
static_assert(WS_MACT + (size_t)136 * 256 * DFE <= WS_LRU, "moe act");
constexpr size_t WS_MAS = 309 * MiB;
static_assert(WS_MAS + (size_t)2 * 136 * 256 * 1024 <= WS_LRU, "moe sorted A");
constexpr size_t WS_H8 = 377 * MiB;
static_assert(WS_MAS + (size_t)2 * 136 * 256 * 1024 <= WS_H8 && WS_H8 + (size_t)NR * 1024 <= WS_LRU, "h8");
constexpr size_t WS_FGU8 = 409 * MiB, WS_FD8 = 415 * MiB;
static_assert(WS_FD8 + (size_t)D * DFF <= WS_LRU, "ffn fp8");
constexpr size_t WS_MACT1 = 377 * MiB;
static_assert(WS_MACT1 + (size_t)136 * 256 * DFE <= WS_SSP, "moe act1");
constexpr float W8_SCALE = 256.f, ACT8_SCALE = 16.f;
constexpr size_t WS_TOKREC = 497 * MiB, WS_PAIRH = 498 * MiB;
constexpr size_t CTL_LIST = 2 * MiB, CTL_LRS = 4 * MiB, CTL_LGATE = 6 * MiB;
constexpr int CW_MCNT = CW_ENDW + 64;
constexpr size_t WS_HMETA = WS_GSP + 4456448;
static_assert(2 * (size_t)TM * 16 * 4 <= 4456448 && WS_HMETA + 2 * 16 * 1024 * 4 <= WS_END && (size_t)(CW_MCNT + 16) * 4 <= CTL_LIST, "misc");

constexpr int RING_BYTES = 131072;
constexpr int GST_OFF = RING_BYTES, GST_BYTES = 24576;
constexpr int MISC_OFF = GST_OFF + GST_BYTES;
constexpr int LDS_BYTES = MISC_OFF + 512;

DI unsigned cvtpk(float lo, float hi) { f32x2 v = {lo, hi}; bf16x2_t b = __builtin_convertvector(v, bf16x2_t); return __builtin_bit_cast(unsigned, b); }
DI bf16_t f2bf(float f) { return (bf16_t)(cvtpk(f, 0.f) & 0xffffu); }
DI float bf2f(bf16_t h) { return __uint_as_float(((unsigned)h) << 16); }
DI float bflo(unsigned w) { return __uint_as_float(w << 16); }
DI float bfhi(unsigned w) { return __uint_as_float(w & 0xffff0000u); }
DI float clamp8(float x) { return __builtin_amdgcn_fmed3f(x, -440.f, 440.f); }
DI unsigned pk4_fp8(float a, float b, float c, float d) { unsigned w = __builtin_amdgcn_cvt_pk_fp8_f32(clamp8(a), clamp8(b), 0u, false); return __builtin_amdgcn_cvt_pk_fp8_f32(clamp8(c), clamp8(d), w, true); }
DI u32x2 swiglu8_fp8(const f32x4 g0, const f32x4 g1, const f32x4 u0, const f32x4 u1, float rs) {
    const float rsu = rs * ACT8_SCALE; f32x2 a[4];
#pragma unroll
    for (int q = 0; q < 4; ++q) { const f32x4 gv = q < 2 ? g0 : g1, uv = q < 2 ? u0 : u1; const int o = 2 * (q & 1);
        const f32x2 g = (f32x2){gv[o], gv[o + 1]} * rs, u = (f32x2){uv[o], uv[o + 1]} * rsu, t = g * -1.4426950408889634f;
        const f32x2 d = (f32x2){__builtin_amdgcn_exp2f(t.x), __builtin_amdgcn_exp2f(t.y)} + 1.f;
        a[q] = (g * u) * (f32x2){__builtin_amdgcn_rcpf(d.x), __builtin_amdgcn_rcpf(d.y)}; }
    u32x2 w; w.x = pk4_fp8(a[0].x, a[0].y, a[1].x, a[1].y); w.y = pk4_fp8(a[2].x, a[2].y, a[3].x, a[3].y); return w;
}
DI u32x4 zero4() { unsigned z = 0u; asm volatile("" : "+v"(z)); return (u32x4){z, z, z, z}; }
DI float wave_sum(float v) {
#pragma unroll
    for (int o = 1; o < 64; o <<= 1) v += __shfl_xor(v, o);
    return v;
}
constexpr int TIDTAB_LDS = 131072 + 24576 + 256;
DI int fresh_tid() {
    const int slot = (int)(__builtin_amdgcn_s_getreg((5 << 11) | 4) & 63u);
    const int w = __builtin_amdgcn_readfirstlane(*(volatile LAS int*)(unsigned)(TIDTAB_LDS + 4 * slot));
    int l0 = 0; asm volatile("v_mbcnt_lo_u32_b32 %0, -1, 0\n\tv_mbcnt_hi_u32_b32 %0, -1, %0" : "=v"(l0));
    return w * 64 + l0;
}
DI float sigmoidf_(float x) { return __builtin_amdgcn_rcpf(1.f + __expf(-x)); }
DI float gelu_tanh(float x) { const float u = 0.7978845608028654f * (x + 0.044715f * x * x * x); const float e = __expf(2.f * u); const float t = 1.f - 2.f * __builtin_amdgcn_rcpf(e + 1.f); return 0.5f * x * (1.f + t); }
#define LDS_WAIT() asm volatile("s_waitcnt lgkmcnt(0)" ::: "memory")
#define VM_WAIT() asm volatile("s_waitcnt vmcnt(0)" ::: "memory")

#define XB_TMO      128
#define XB_XCNT(j)  (256  + 64 * (j))
#define XB_XSUB(j)  (1280 + 64 * (j))
#define XB_XGEN(j)  (2304 + 64 * (j))
#define XB_TOP      3328
#define XB_TOPGEN   3392
#define XCD_BAR_WORDS 3456
#define XB_SPIN_CAP (1u << 22)
DI unsigned xb_ld(unsigned* p)              { return __hip_atomic_load(p, __ATOMIC_RELAXED, __HIP_MEMORY_SCOPE_AGENT); }
DI unsigned xb_add(unsigned* p, unsigned v) { return __hip_atomic_fetch_add(p, v, __ATOMIC_RELAXED, __HIP_MEMORY_SCOPE_AGENT); }
DI unsigned xb_xcc_id() { return (unsigned)__builtin_amdgcn_s_getreg((3 << 11) | 20) & 0xFu; }
#define XB_SPIN(cond, bar) do { unsigned _sp = 0; while (cond) { __builtin_amdgcn_s_sleep(1); \
    if ((++_sp & 255u) == 0u) { if (xb_ld(&(bar)[XB_TMO])) break; if (_sp > XB_SPIN_CAP) { atomicAdd(&(bar)[XB_TMO], 1u); break; } } } } while (0)
struct XcdBarrier { unsigned* bar; unsigned x; volatile LAS unsigned* st; };
DI XcdBarrier xcd_barrier_post(unsigned* bar, volatile LAS unsigned* st) {
    XcdBarrier b; b.bar = bar; b.x = xb_xcc_id(); b.st = st;
    if (fresh_tid() == 0) (void)xb_add(&bar[XB_XCNT(b.x)], 1u);
    return b;
}
DI void xcd_barrier_complete(unsigned* bar, unsigned x, unsigned& nloc, unsigned& nx) {
    const unsigned G = gridDim.x * gridDim.y * gridDim.z;
    unsigned sum, cnt, mine, sp = 0u;
    for (;;) {
        sum = 0u; cnt = 0u; mine = 0u;
#pragma unroll
        for (unsigned j = 0; j < 16; ++j) { const unsigned c = xb_ld(&bar[XB_XCNT(j)]); sum += c; cnt += (c > 0u) ? 1u : 0u; mine = (j == x) ? c : mine; }
        if (sum == G) break;
        __builtin_amdgcn_s_sleep(1);
        if ((++sp & 255u) == 0u) { if (xb_ld(&bar[XB_TMO])) break; if (sp > XB_SPIN_CAP) { atomicAdd(&bar[XB_TMO], 1u); break; } }
    }
    nloc = mine > 0u ? mine : 1u; nx = cnt > 0u ? cnt : 1u;
}
DI void xcd_barrier(const XcdBarrier& b) {
    asm volatile("s_waitcnt vmcnt(0)" ::: "memory");
    __syncthreads();
    if (fresh_tid() == 0) {
        unsigned* bar = b.bar; unsigned bx_ = b.x; asm volatile("" : "+s"(bx_), "+s"(bar));
        __builtin_amdgcn_s_waitcnt(0);
        unsigned nloc = b.st[0], nx = b.st[1];
        if (nloc == 0u) { xcd_barrier_complete(bar, bx_, nloc, nx); b.st[0] = nloc; b.st[1] = nx; }
        const unsigned old = xb_add(&bar[XB_XSUB(bx_)], 1u);
        const unsigned gen = old / nloc;
        if (old + 1u == (gen + 1u) * nloc) {
            __builtin_amdgcn_fence(__ATOMIC_RELEASE, "agent");
            asm volatile("s_waitcnt vmcnt(0)" ::: "memory");
            const unsigned og = xb_add(&bar[XB_TOP], 1u);
            const unsigned tg = og / nx;
            if (og + 1u == (tg + 1u) * nx) xb_add(&bar[XB_TOPGEN], 1u);
            else XB_SPIN(xb_ld(&bar[XB_TOPGEN]) == tg, bar);
            __builtin_amdgcn_fence(__ATOMIC_ACQUIRE, "agent");
            xb_add(&bar[XB_XGEN(bx_)], 1u);
            asm volatile("s_waitcnt vmcnt(0)" ::: "memory");
        } else {
            XB_SPIN(xb_ld(&bar[XB_XGEN(bx_)]) == gen, bar);
            __builtin_amdgcn_fence(__ATOMIC_ACQUIRE, "agent");
            asm volatile("s_waitcnt vmcnt(0)" ::: "memory");
        }
    }
    __syncthreads();
}

namespace pg8 {
typedef int v8i_t __attribute__((ext_vector_type(8))); typedef int v4i_t __attribute__((ext_vector_type(4)));
DI void mfma8(f32x4& c, v8i_t b, v8i_t a) { asm volatile("v_mfma_f32_16x16x128_f8f6f4 %0, %1, %2, %0" : "+v"(c) : "v"(b), "v"(a)); }
DI v8i_t cat8(bf16x8 a, bf16x8 b) { const v4i_t x = __builtin_bit_cast(v4i_t, a), y = __builtin_bit_cast(v4i_t, b); return __builtin_shufflevector(x, y, 0, 1, 2, 3, 4, 5, 6, 7); }
constexpr int BM = 256, BK = 64, HALF = 128, HTB = HALF * BK * 2, STAGE_BYTES = 8 * HTB;
__host__ __device__ __forceinline__ int lds_byte(int r, int c) { const int st = (r >> 4) * 2 + (c >> 5), rr = r & 15, cc = c & 31, ob = rr * 64 + cc * 2; return st * 1024 + (ob ^ (((ob >> 9) & 1) << 5)); }
__host__ __device__ __forceinline__ void stage_rc(int b, int& R, int& C) { const int st = b / 1024, sb = b % 1024, swz = sb ^ (((sb >> 9) & 1) << 5); R = (st >> 1) * 16 + swz / 64; C = (st & 1) * 32 + (swz % 64) / 2; }
__host__ __device__ __forceinline__ int perm32(int rho) { const int n = rho >> 4, i = rho & 15; return 8 * (i >> 2) + 4 * n + (i & 3); }
__host__ __device__ __forceinline__ int perm32x(int rho) { const int n = rho >> 4, i = rho & 15, q = i >> 2, gq = ((q & 1) << 1) | (q >> 1); return 8 * gq + 4 * n + (i & 3); }
struct Unit { int pm, pn, e; };

template <class Epi, class Sched, bool GATHER, bool GS, bool FP8 = false>
DI void gemm_phase(LAS unsigned char* lds, const int lda, const int K, const Sched& S, const Epi& E, const LAS float* gstab) {
    const int tid = fresh_tid(), wid = __builtin_amdgcn_readfirstlane(tid >> 6), lane = tid & 63, wr = wid >> 2, wc = wid & 3, fr = lane & 15, fq = lane >> 4;
    const int nt = K / BK;
    unsigned voffA0[2], voffA1[2], voffB[2], nvA0[2], nvA1[2]; int RA[2], CA[2];
#pragma unroll
    for (int i = 0; i < 2; ++i) { int R, C; stage_rc(tid * 16 + i * 8192, R, C); const int Rb = (R & ~31) + (Epi::PERMX ? perm32x(R & 31) : perm32(R & 31));
        RA[i] = R; CA[i] = C * 2; voffA0[i] = (unsigned)(R * lda + C) * 2u; voffA1[i] = (unsigned)((R + HALF) * lda + C) * 2u; voffB[i] = (unsigned)(Rb * K + C) * 2u; nvA0[i] = voffA0[i]; nvA1[i] = voffA1[i]; }
    const size_t kstep = (size_t)(BK * 2);
    const size_t hstepB = (size_t)HALF * K * 2;
    const size_t hstepA = (size_t)HALF * lda * 2;
    const size_t q64A = (size_t)64 * lda * 2, q64B = (size_t)64 * K * 2;
    const unsigned ldsw = (unsigned)wid * 1024u;
    const int aoff = lds_byte(wr * 64 + fr, fq * 8), boff = lds_byte(wc * 32 + fr, fq * 8);
#define PG8_SA(b, h) (((b) * 2 + (h)) * HTB)
#define PG8_SB(b, h) ((4 + (b) * 2 + (h)) * HTB)
#define PG8_STAGE2(bufoff, gbase, o0, o1) do { \
        __builtin_amdgcn_global_load_lds((const unsigned*)((const char*)(gbase) + (o0)), (LAS unsigned*)(lds + (bufoff) + ldsw), 16, 0, 0); \
        __builtin_amdgcn_global_load_lds((const unsigned*)((const char*)(gbase) + (o1)), (LAS unsigned*)(lds + (bufoff) + ldsw + 8192), 16, 0, 0); } while (0)
#define PG8_STAGE_B(bufoff, gbase) do { \
        __builtin_amdgcn_global_load_lds((const unsigned*)((const char*)(gbase) + voffB[0]), (LAS unsigned*)(lds + (bufoff) + ldsw), 16, 0, 0); \
        __builtin_amdgcn_global_load_lds((const unsigned*)((const char*)(gbase) + q64B + voffB[0]), (LAS unsigned*)(lds + (bufoff) + ldsw + 8192), 16, 0, 0); } while (0)
#define PG8_STAGE_A0(bufoff, gbase, o0, o1) do { if constexpr (GATHER) PG8_STAGE2(bufoff, gbase, o0, o1); else { \
        __builtin_amdgcn_global_load_lds((const unsigned*)((const char*)(gbase) + (o0)), (LAS unsigned*)(lds + (bufoff) + ldsw), 16, 0, 0); \
        __builtin_amdgcn_global_load_lds((const unsigned*)((const char*)(gbase) + q64A + (o0)), (LAS unsigned*)(lds + (bufoff) + ldsw + 8192), 16, 0, 0); } } while (0)
#define PG8_STAGE_A1(bufoff, gbase, o0, o1, p0, p1) do { if constexpr (GATHER) PG8_STAGE2(bufoff, gbase, o0, o1); else PG8_STAGE_A0(bufoff, (gbase) + hstepA, p0, p1); } while (0)
#define PG8_LDA(dst, b, h) do { _Pragma("unroll") for (int m = 0; m < 4; ++m) _Pragma("unroll") for (int k = 0; k < 2; ++k) dst[m][k] = *(const LAS bf16x8*)(lds + PG8_SA(b, h) + aoff + m * 2048 + k * 1024); } while (0)
#define PG8_LDB(dst, b, h) do { _Pragma("unroll") for (int n = 0; n < 2; ++n) _Pragma("unroll") for (int k = 0; k < 2; ++k) dst[n][k] = *(const LAS bf16x8*)(lds + PG8_SB(b, h) + boff + n * 2048 + k * 1024); } while (0)
#define PG8_MMA(ai, bj, At, Bt) do { __builtin_amdgcn_s_setprio(1); _Pragma("unroll") for (int m = 0; m < 4; ++m) _Pragma("unroll") for (int n = 0; n < 2; ++n) { \
        if constexpr (FP8) { mfma8(acc[ai][bj][m][n], cat8(Bt[n][0], Bt[n][1]), cat8(At[m][0], At[m][1])); } \
        else { _Pragma("unroll") for (int k = 0; k < 2; ++k) acc[ai][bj][m][n] = __builtin_amdgcn_mfma_f32_16x16x32_bf16(Bt[n][k], At[m][k], acc[ai][bj][m][n], 0, 0, 0); } } if constexpr (FP8) asm volatile("s_nop 7\n\ts_nop 7" ::: "memory"); __builtin_amdgcn_s_setprio(0); } while (0)
#define PG8_WAIT_V(n) asm volatile("s_waitcnt vmcnt(" #n ")" ::: "memory")
#define PG8_WAIT_L(n) asm volatile("s_waitcnt lgkmcnt(" #n ")" ::: "memory")
#define PG8_BAR __builtin_amdgcn_s_barrier()
#define PG8_SCHED __builtin_amdgcn_sched_barrier(0)
    Unit cur, nxt; int ui = 0;
    if (!S.next(0, cur)) return;
    f32x4 acc[2][2][4][2];
#pragma unroll
    for (int a = 0; a < 2; ++a)
#pragma unroll
        for (int b = 0; b < 2; ++b)
#pragma unroll
            for (int m = 0; m < 4; ++m)
#pragma unroll
                for (int n = 0; n < 2; ++n) acc[a][b][m][n] = (f32x4){0.f, 0.f, 0.f, 0.f};
    bf16x8 At[4][2], B0[2][2], B1[2][2];
    const char* cA = S.abase(cur); const char* cB = S.bbase(cur);
    if constexpr (GATHER) {
#pragma unroll
        for (int i = 0; i < 2; ++i) { voffA0[i] = S.arow_off(cur, RA[i]) + (unsigned)CA[i]; voffA1[i] = S.arow_off(cur, RA[i] + HALF) + (unsigned)CA[i]; nvA0[i] = voffA0[i]; nvA1[i] = voffA1[i]; }
    }
    PG8_STAGE_B(PG8_SB(0, 0), cB); PG8_STAGE_B(PG8_SB(0, 1), cB + hstepB); PG8_STAGE_A0(PG8_SA(0, 0), cA, voffA0[0], voffA0[1]); PG8_STAGE_A1(PG8_SA(0, 1), cA, voffA1[0], voffA1[1], voffA0[0], voffA0[1]);
    if (wr == 1) PG8_BAR;
    PG8_WAIT_V(2); PG8_BAR;
    PG8_STAGE_B(PG8_SB(1, 0), cB + kstep); PG8_STAGE_A0(PG8_SA(1, 0), cA + kstep, voffA0[0], voffA0[1]); PG8_STAGE_B(PG8_SB(1, 1), cB + hstepB + kstep);
    PG8_WAIT_V(6); PG8_BAR;
    for (;;) {
        const bool has_next = S.next(ui + 1, nxt);
        const char* nA = has_next ? S.abase(nxt) : cA; const char* nB = has_next ? S.bbase(nxt) : cB;
        for (int t = 0; t < nt; t += 2) {
            const bool last = (t == nt - 2);
            const char* a1 = cA + (size_t)(t + 1) * kstep;
            const char* a2 = last ? nA : cA + (size_t)(t + 2) * kstep; const char* b2 = last ? nB : cB + (size_t)(t + 2) * kstep;
            const char* a3 = a2 + kstep; const char* b3 = b2 + kstep;
            if constexpr (GATHER) {
                if (t == nt - 4) {
                    if (has_next) { const int tid2 = fresh_tid();
#pragma unroll
                        for (int i = 0; i < 2; ++i) { int R2, C2; stage_rc(tid2 * 16 + i * 8192, R2, C2); nvA0[i] = S.arow_off(nxt, R2) + (unsigned)(C2 * 2); nvA1[i] = S.arow_off(nxt, R2 + HALF) + (unsigned)(C2 * 2); }
                    } else {
#pragma unroll
                        for (int i = 0; i < 2; ++i) { nvA0[i] = voffA0[i]; nvA1[i] = voffA1[i]; }
                    }
                }
            }
            unsigned xo0[2], xo1[2];
#pragma unroll
            for (int i = 0; i < 2; ++i) { xo0[i] = (GATHER && last) ? nvA0[i] : voffA0[i]; xo1[i] = (GATHER && last) ? nvA1[i] : voffA1[i]; }
            if constexpr (GS) {
                PG8_SCHED;
                if (t != 0 && (t & 3) == 0) {
                    const int g = (t >> 2) - 1; const int fr2 = fresh_tid() & 15;
#pragma unroll
                    for (int ai = 0; ai < 2; ++ai)
#pragma unroll
                        for (int m = 0; m < 4; ++m) { const float f = gstab[((ui & 3) * 256 + ai * HALF + wr * 64 + m * 16 + fr2) * 4 + g];
#pragma unroll
                            for (int bj = 0; bj < 2; ++bj)
#pragma unroll
                                for (int n = 0; n < 2; ++n) acc[ai][bj][m][n] *= f; }
                }
                PG8_SCHED;
            }
            PG8_LDB(B0, 0, 0); PG8_LDB(B1, 0, 1); PG8_SCHED; PG8_LDA(At, 0, 0); PG8_STAGE_A1(PG8_SA(1, 1), a1, voffA1[0], voffA1[1], voffA0[0], voffA0[1]);
            PG8_WAIT_V(8); PG8_WAIT_L(0); PG8_BAR; PG8_MMA(0, 0, At, B0); PG8_MMA(0, 1, At, B1); PG8_BAR; PG8_SCHED;
            PG8_LDA(At, 0, 1); PG8_STAGE_B(PG8_SB(0, 0), b2); PG8_STAGE_B(PG8_SB(0, 1), b2 + hstepB); PG8_STAGE_A0(PG8_SA(0, 0), a2, xo0[0], xo0[1]);
            PG8_WAIT_V(8); PG8_WAIT_L(0); PG8_BAR; PG8_MMA(1, 0, At, B0); PG8_MMA(1, 1, At, B1); PG8_BAR; PG8_SCHED;
            PG8_LDB(B0, 1, 0); PG8_LDB(B1, 1, 1); PG8_SCHED; PG8_LDA(At, 1, 0); PG8_STAGE_A1(PG8_SA(0, 1), a2, xo1[0], xo1[1], xo0[0], xo0[1]);
            PG8_WAIT_V(8); PG8_WAIT_L(0); PG8_BAR; PG8_MMA(0, 0, At, B0); PG8_MMA(0, 1, At, B1); PG8_BAR; PG8_SCHED;
            PG8_LDA(At, 1, 1); PG8_STAGE_B(PG8_SB(1, 0), b3); PG8_STAGE_B(PG8_SB(1, 1), b3 + hstepB); PG8_STAGE_A0(PG8_SA(1, 0), a3, xo0[0], xo0[1]);
            PG8_WAIT_V(8); PG8_WAIT_L(0); PG8_BAR; PG8_MMA(1, 0, At, B0); PG8_MMA(1, 1, At, B1); PG8_BAR; PG8_SCHED;
        }
        if (wr == 0) PG8_BAR;
        if constexpr (FP8) asm volatile("s_nop 15\n\ts_nop 15" ::: "memory");
        { const int l2 = fresh_tid() & 63; E(acc, cur, ui, wr, wc, l2 & 15, l2 >> 4, gstab); }
        if (!has_next) break;
#pragma unroll
        for (int a = 0; a < 2; ++a)
#pragma unroll
            for (int b = 0; b < 2; ++b)
#pragma unroll
                for (int m = 0; m < 4; ++m)
#pragma unroll
                    for (int n = 0; n < 2; ++n) acc[a][b][m][n] = (f32x4){0.f, 0.f, 0.f, 0.f};
        cur = nxt; cA = nA; cB = nB; ++ui;
        if constexpr (GATHER) {
#pragma unroll
            for (int i = 0; i < 2; ++i) { voffA0[i] = nvA0[i]; voffA1[i] = nvA1[i]; }
        }
        if (wr == 1) PG8_BAR;
    }
    PG8_WAIT_V(0);
    PG8_BAR;
#undef PG8_SA
#undef PG8_SB
#undef PG8_STAGE2
#undef PG8_STAGE_B
#undef PG8_STAGE_A0
#undef PG8_STAGE_A1
#undef PG8_LDA
#undef PG8_LDB
#undef PG8_MMA
#undef PG8_WAIT_V
#undef PG8_WAIT_L
#undef PG8_BAR
#undef PG8_SCHED
}
}
using pg8::Unit;

constexpr int XR = 4;
struct SchedPlain {
    const char* A; const char* Bt; int lda, K, nM, nN, G, c;
    DI bool next(int i, Unit& u) const {
        const int U = nM * nN, U8 = (U + 7) >> 3, o = i * (G >> 3) + (c >> 3), L = (c & 7) * U8 + o; if (o >= U8 || L >= U) return false;
        const int grp = L / (XR * nN), rem = L - grp * (XR * nN), fm = grp * XR, gsz = (nM - fm) < XR ? (nM - fm) : XR;
        u.pm = fm + rem % gsz; u.pn = rem / gsz; u.e = 0; return true;
    }
    DI int xcnt(int x) const { const int U = nM * nN, U8 = (U + 7) >> 3; const int n = U - x * U8; return n < 0 ? 0 : (n > U8 ? U8 : n); }
    DI const char* abase(const Unit& u) const { return A + (size_t)u.pm * 256 * lda * 2; }
    DI const char* bbase(const Unit& u) const { return Bt + (size_t)u.pn * 256 * K * 2; }
    DI unsigned arow_off(const Unit&, int) const { return 0u; }
    DI void a_ready(const Unit&) const {}
};

DI float ss_sum(const float* ss, int row, int nslot) {
    if (nslot == 1) return ss[row];
    const f32x4* q = (const f32x4*)(ss + (size_t)row * 16); const f32x4 a = q[0], b = q[1], c = q[2], d = q[3];
    return (((a[0] + a[1]) + (a[2] + a[3])) + ((b[0] + b[1]) + (b[2] + b[3]))) + (((c[0] + c[1]) + (c[2] + c[3])) + ((d[0] + d[1]) + (d[2] + d[3])));
}
struct EpiZ {
    static constexpr bool PERMX = false;
    bf16_t* Z;
    DI void operator()(const f32x4 (&acc)[2][2][4][2], const Unit& u, int ui, int wr, int wc, int fr, int fq, const LAS float* rst) const {
        const int row0 = u.pm * 256 + wr * 64 + fr, col0 = u.pn * 256 + wc * 32 + 8 * fq;
#pragma unroll
        for (int ai = 0; ai < 2; ++ai)
#pragma unroll
            for (int m = 0; m < 4; ++m) { const int row = row0 + ai * 128 + m * 16; const float rs = rst[ui * 256 + ai * 128 + wr * 64 + m * 16 + fr];
                bf16_t* rowp = Z + (size_t)row * ZC + col0;
#pragma unroll
                for (int bj = 0; bj < 2; ++bj) { const f32x4 v0 = acc[ai][bj][m][0] * rs, v1 = acc[ai][bj][m][1] * rs; u32x4 w;
                    w.x = cvtpk(v0[0], v0[1]); w.y = cvtpk(v0[2], v0[3]); w.z = cvtpk(v1[0], v1[1]); w.w = cvtpk(v1[2], v1[3]); *(u32x4*)(rowp + bj * 128) = w; } }
    }
};
struct EpiRes {
    static constexpr bool PERMX = false;
    bf16_t* hb; float* ss_out; int gs; unsigned char* h8; float ascale;
    DI void operator()(const f32x4 (&acc)[2][2][4][2], const Unit& u, int ui, int wr, int wc, int fr, int fq, const LAS float* gstab) const {
        const int row0 = u.pm * 256 + wr * 64 + fr, col0 = u.pn * 256 + wc * 32 + 8 * fq;
#pragma unroll
        for (int ai = 0; ai < 2; ++ai) {
        u32x4 rw[1][4][2];
#pragma unroll
            for (int m = 0; m < 4; ++m)
#pragma unroll
                for (int bj = 0; bj < 2; ++bj) rw[0][m][bj] = *(const u32x4*)(hb + (size_t)(row0 + ai * 128 + m * 16) * D + col0 + bj * 128);
        asm volatile("" ::: "memory");
#pragma unroll
            for (int m = 0; m < 4; ++m) { const int row = row0 + ai * 128 + m * 16; const size_t off = (size_t)row * D + col0;
                const float f = gs ? gstab[((ui & 3) * 256 + ai * 128 + wr * 64 + m * 16 + fr) * 4 + 3] : ascale; float sq = 0.f;
#pragma unroll
                for (int bj = 0; bj < 2; ++bj) { const u32x4 r = rw[0][m][bj];
                    const f32x4 r0 = {bflo(r.x), bfhi(r.x), bflo(r.y), bfhi(r.y)}, r1 = {bflo(r.z), bfhi(r.z), bflo(r.w), bfhi(r.w)};
                    const f32x4 v0 = r0 + acc[ai][bj][m][0] * f, v1 = r1 + acc[ai][bj][m][1] * f;
                    u32x4 w; w.x = cvtpk(v0[0], v0[1]); w.y = cvtpk(v0[2], v0[3]); w.z = cvtpk(v1[0], v1[1]); w.w = cvtpk(v1[2], v1[3]); *(u32x4*)(hb + off + bj * 128) = w;
                    if (h8) { u32x2 w8; w8.x = pk4_fp8(v0[0], v0[1], v0[2], v0[3]); w8.y = pk4_fp8(v1[0], v1[1], v1[2], v1[3]); *(u32x2*)(h8 + off + bj * 128) = w8; }
                    sq += (v0[0] * v0[0] + v0[1] * v0[1]) + (v0[2] * v0[2] + v0[3] * v0[3]) + (v1[0] * v1[0] + v1[1] * v1[1]) + (v1[2] * v1[2] + v1[3] * v1[3]); }
                sq += __shfl_xor(sq, 16); sq += __shfl_xor(sq, 32);
                if (fq == 0 && ss_out) ss_out[(size_t)row * 16 + u.pn * 4 + wc] = sq; }
        asm volatile("" ::: "memory"); }
    }
};


struct EpiGU {
    static constexpr bool PERMX = false;
    bf16_t* ACT; int ldact; const float* ss;
    DI void operator()(const f32x4 (&acc)[2][2][4][2], const Unit& u, int, int wr, int wc, int fr, int fq, const LAS float*) const {
        const int row0 = u.pm * 256 + wr * 64 + fr, col0 = u.pn * 128 + wc * 32 + 8 * fq;
#pragma unroll
        for (int ai = 0; ai < 2; ++ai)
#pragma unroll
            for (int m = 0; m < 4; ++m) { const int row = row0 + ai * 128 + m * 16; const float rs = rsqrtf(ss_sum(ss, row, 16) * (1.f / 1024.f) + EPS); float a[8];
#pragma unroll
                for (int n = 0; n < 2; ++n)
#pragma unroll
                    for (int e = 0; e < 4; ++e) { const float g = acc[ai][0][m][n][e] * rs, uu = acc[ai][1][m][n][e] * rs; a[4 * n + e] = g * uu * __builtin_amdgcn_rcpf(1.f + __expf(-g)); }
                u32x4 w; w.x = cvtpk(a[0], a[1]); w.y = cvtpk(a[2], a[3]); w.z = cvtpk(a[4], a[5]); w.w = cvtpk(a[6], a[7]);
                *(u32x4*)(ACT + (size_t)row * ldact + col0) = w; }
    }
};
struct EpiGU8 {
    static constexpr bool PERMX = true;
    unsigned char* ACT; int ldact; float wsc;
    DI void operator()(const f32x4 (&acc)[2][2][4][2], const Unit& u, int ui, int wr, int wc, int fr, int fq, const LAS float* rst) const {
        const int row0 = u.pm * 256 + wr * 64 + fr, col0 = u.pn * 128 + wc * 32 + 16 * (fq & 1), hi = fq >> 1;
#pragma unroll
        for (int ai = 0; ai < 2; ++ai)
#pragma unroll
            for (int mp = 0; mp < 2; ++mp) { const int m0 = 2 * mp, m1 = m0 + 1; const LAS float* rp = rst + ui * 256 + ai * 128 + wr * 64 + fr;
                const u32x2 wa = swiglu8_fp8(acc[ai][0][m0][0], acc[ai][0][m0][1], acc[ai][1][m0][0], acc[ai][1][m0][1], rp[m0 * 16] * wsc);
                const u32x2 wb = swiglu8_fp8(acc[ai][0][m1][0], acc[ai][0][m1][1], acc[ai][1][m1][0], acc[ai][1][m1][1], rp[m1 * 16] * wsc);
                const auto s0 = __builtin_amdgcn_permlane32_swap(wa.x, wb.x, false, false), s1 = __builtin_amdgcn_permlane32_swap(wa.y, wb.y, false, false);
                *(u32x4*)(ACT + (size_t)(row0 + ai * 128 + (m0 + hi) * 16) * ldact + col0) = (u32x4){s0[0], s1[0], s0[1], s1[1]}; asm volatile("" ::: "memory"); }
    }
};
struct SchedMoe {
    const char* A; const char* B0; size_t bstride; int lda, K, nT, nN, G, c; const LAS int* tab; const int* list; bool gather; unsigned rowbytes; int nh, skew;
    DI bool next(int i, Unit& u) const { int o; const int U = nT * nN, U8 = (U + 7) >> 3, B = G >> 3, j = c >> 3;
        if (nh == 0) o = i * B + j;
        else if (j >= nh) o = (i < skew) ? i * (B - nh) + (j - nh) : skew * (B - nh) + (i - skew) * B + j;
        else o = skew * (B - nh) + i * B + j;
        const int L = (c & 7) * U8 + o; if (o >= U8 || L >= U) return false;
        const int grp = L / (XR * nN), rem = L - grp * (XR * nN), fm = grp * XR, gsz = (nT - fm) < XR ? (nT - fm) : XR;
        u.pm = fm + rem % gsz; u.pn = rem / gsz; u.e = tab[u.pm * 4]; return true; }
    DI const char* abase(const Unit& u) const { return gather ? A : A + (size_t)u.pm * 256 * lda * 2; }
    DI const char* bbase(const Unit& u) const { return B0 + (size_t)u.e * bstride + (size_t)u.pn * 256 * K * 2; }
    DI unsigned arow_off(const Unit& u, int r) const { const int off = tab[u.pm * 4 + 1], n = tab[u.pm * 4 + 2]; const int idx = off + r; const int tok = idx < n ? list[u.e * 32768 + idx] : 0; return (unsigned)tok * rowbytes; }
    DI void a_ready(const Unit&) const {}
};
struct EpiMoeGU {
    static constexpr bool PERMX = true;
    unsigned char* ACT; const float* lrs; const LAS int* tab;
    DI void operator()(const f32x4 (&acc)[2][2][4][2], const Unit& u, int ui, int wr, int wc, int fr, int fq, const LAS float* rst) const {
        const int r0 = wr * 64 + fr, col0 = u.pn * 128 + wc * 32 + 16 * (fq & 1), hi = fq >> 1; const LAS float* rsp = rst + ui * 256 + r0;
#pragma unroll
        for (int ai = 0; ai < 2; ++ai)
#pragma unroll
            for (int mp = 0; mp < 2; ++mp) { const int m0 = 2 * mp, m1 = m0 + 1;
                const u32x2 wa = swiglu8_fp8(acc[ai][0][m0][0], acc[ai][0][m0][1], acc[ai][1][m0][0], acc[ai][1][m0][1], rsp[ai * 128 + m0 * 16] * (1.f / W8_SCALE));
                const u32x2 wb = swiglu8_fp8(acc[ai][0][m1][0], acc[ai][0][m1][1], acc[ai][1][m1][0], acc[ai][1][m1][1], rsp[ai * 128 + m1 * 16] * (1.f / W8_SCALE));
                const auto s0 = __builtin_amdgcn_permlane32_swap(wa.x, wb.x, false, false), s1 = __builtin_amdgcn_permlane32_swap(wa.y, wb.y, false, false);
                *(u32x4*)(ACT + (size_t)(u.pm * 256 + r0 + ai * 128 + (m0 + hi) * 16) * DFE + col0) = (u32x4){s0[0], s1[0], s0[1], s1[1]}; }
    }
};
struct EpiMoeDown {
    static constexpr bool PERMX = false;
    float* out; const int* list; const float* lgate; const LAS int* tab; bf16_t* hb; bool last;
    DI void operator()(const f32x4 (&acc)[2][2][4][2], const Unit& u, int, int wr, int wc, int fr, int fq, const LAS float*) const {
        const int off = tab[u.pm * 4 + 1], n = tab[u.pm * 4 + 2]; const int r0 = wr * 64 + fr, col0 = u.pn * 256 + wc * 32 + 8 * fq;
        int tok[2][4]; float gt[2][4];
#pragma unroll
        for (int ai = 0; ai < 2; ++ai)
#pragma unroll
            for (int m = 0; m < 4; ++m) { const int idx = off + r0 + ai * 128 + m * 16, ci = idx < n ? idx : n - 1;
                tok[ai][m] = list[u.e * 32768 + ci]; gt[ai][m] = lgate[u.e * 32768 + ci] * (1.f / (W8_SCALE * ACT8_SCALE)); }
        u32x4 rw[2][4][2];
#pragma unroll
        for (int ai = 0; ai < 2; ++ai)
#pragma unroll
            for (int m = 0; m < 4; ++m)
#pragma unroll
                for (int bj = 0; bj < 2; ++bj) rw[ai][m][bj] = *(const u32x4*)(hb + (size_t)tok[ai][m] * D + col0 + bj * 128);
        asm volatile("" ::: "memory");
#pragma unroll
        for (int ai = 0; ai < 2; ++ai)
#pragma unroll
            for (int m = 0; m < 4; ++m) if (off + r0 + ai * 128 + m * 16 < n) { const size_t ro = (size_t)tok[ai][m] * D + col0; const float g = gt[ai][m];
#pragma unroll
                for (int bj = 0; bj < 2; ++bj) { const u32x4 r = rw[ai][m][bj];
                    const f32x4 v0 = (f32x4){bflo(r.x), bfhi(r.x), bflo(r.y), bfhi(r.y)} + acc[ai][bj][m][0] * g, v1 = (f32x4){bflo(r.z), bfhi(r.z), bflo(r.w), bfhi(r.w)} + acc[ai][bj][m][1] * g;
                    if (last) { *(f32x4*)(out + ro + bj * 128) = v0; *(f32x4*)(out + ro + bj * 128 + 4) = v1; }
                    else { u32x4 w; w.x = cvtpk(v0[0], v0[1]); w.y = cvtpk(v0[2], v0[3]); w.z = cvtpk(v1[0], v1[1]); w.w = cvtpk(v1[2], v1[3]); *(u32x4*)(hb + ro + bj * 128) = w; } } }
    }
};
DI f32x4 skinny_acc(const bf16_t* A, int lda, const bf16_t* Bt, int K, int n0, int k0, int k1, int lane) {
    const int fr = lane & 15, g = lane >> 4; f32x4 acc = {0.f, 0.f, 0.f, 0.f};
    const bf16_t* ap = A + (size_t)fr * lda + 8 * g; const bf16_t* bp = Bt + (size_t)(n0 + fr) * K + 8 * g;
#pragma unroll 4
    for (int k = k0; k < k1; k += 32) { const bf16x8 a = *(const bf16x8*)(ap + k), b = *(const bf16x8*)(bp + k); acc = __builtin_amdgcn_mfma_f32_16x16x32_bf16(b, a, acc, 0, 0, 0); }
    return acc;
}

DI f32x4 skinny_block(LAS unsigned char* lds, const bf16_t* A, int lda, const bf16_t* Bt, int K, int n0, int kc, float scale, int tid) {
    const int lane = tid & 63, wave = tid >> 6;
    const f32x4 part = skinny_acc(A, lda, Bt, K, n0, wave * kc, wave * kc + kc, lane) * scale;
    LAS f32x4* red = (LAS f32x4*)lds; red[wave * 64 + lane] = part;
    __syncthreads();
    f32x4 tot = red[lane];
#pragma unroll
    for (int w = 1; w < 8; ++w) tot = tot + red[w * 64 + lane];
    __syncthreads();
    return tot;
}
DI void meta_rs(LAS float* rsm, const float* hm, int tid) {
    const int row = tid >> 5, l32 = tid & 31; const f32x4* q = (const f32x4*)(hm + (size_t)row * D) + l32; float sv = 0.f;
#pragma unroll
    for (int j = 0; j < 8; ++j) { const f32x4 v = q[32 * j]; sv += (v[0] * v[0] + v[1] * v[1]) + (v[2] * v[2] + v[3] * v[3]); }
    sv += __shfl_xor(sv, 1); sv += __shfl_xor(sv, 2); sv += __shfl_xor(sv, 4); sv += __shfl_xor(sv, 8); sv += __shfl_xor(sv, 16);
    if (l32 == 0) rsm[row] = rsqrtf(sv * (1.f / 1024.f) + EPS);
    __syncthreads();
}

template <class Sched> DI void fill_rs_table(const Sched& S, const float* ss, int nslot, LAS float* rst, int tid) {
    Unit u;
    for (int i = 0; i < 16 && S.next(i, u); ++i) if (tid < 256) rst[i * 256 + tid] = rsqrtf(ss_sum(ss, u.pm * 256 + tid, nslot) * (1.f / 1024.f) + EPS);
    __syncthreads();
}
DI void fill_moe_rs_table(const SchedMoe& S, const float* lrs, LAS float* rst, int tid) {
    Unit u;
    for (int i = 0; i < 16 && S.next(i, u); ++i) if (tid < 256) rst[i * 256 + tid] = lrs[u.e * 32768 + S.tab[u.pm * 4 + 1] + tid];
    __syncthreads();
}
struct Params {
    const float* x; const float* meta; const float* norm1_g; const float* norm2_g; const float* w_in; const float* w_out; const float* out_norm_g;
    const float* lru_conv_w; const float* lru_conv_b; const float* lru_wa; const float* lru_ba; const float* lru_wx; const float* lru_bx; const float* lru_lambda;
    const float* hg_lb_logits; const float* mla_gq; const float* mla_w_uq; const float* mla_gkv; const float* mla_w_ukv; const float* mla_gqn; const float* mla_gkn;
    const float* fox_gqn; const float* fox_gkn; const float* fox_bf; const float* ffn_w_gate; const float* ffn_w_up; const float* ffn_w_down;
    const float* moe_w_router; const float* moe_w_gate; const float* moe_w_up; const float* moe_w_down;
    float* out; unsigned char* ws;
};

struct Frame {
    LAS unsigned char* lds; int G, vcu;
};
#define TID_VARS const int tid = fresh_tid(); const int lane = tid & 63; const int wave = __builtin_amdgcn_readfirstlane(tid >> 6); (void)lane; (void)wave

DI void wt_item(const float* W, int ldw, int c0, int nv, const float* g, bf16_t* WT, int K, int n0, int k0, LAS float* scr, int lane) {
    { const int c4 = (lane & 7) * 4; f32x4 v[8];
#pragma unroll
      for (int i = 0; i < 8; ++i) { const int kk = 8 * i + (lane >> 3); const float* src = W + (size_t)(k0 + kk) * ldw + c0 + c4;
          if (c4 + 3 < nv) v[i] = *(const f32x4*)src; else { v[i] = (f32x4){0.f, 0.f, 0.f, 0.f}; if (c4 < nv) v[i][0] = src[0]; if (c4 + 1 < nv) v[i][1] = src[1]; if (c4 + 2 < nv) v[i][2] = src[2]; } }
#pragma unroll
      for (int i = 0; i < 8; ++i) { const int kk = 8 * i + (lane >> 3); const float gs = g ? g[k0 + kk] : 1.f; LAS float* d = scr + kk * 33 + c4; d[0] = v[i][0] * gs; d[1] = v[i][1] * gs; d[2] = v[i][2] * gs; d[3] = v[i][3] * gs; } }
    LDS_WAIT(); asm volatile("" ::: "memory");
    const int c = lane & 7;
#pragma unroll
    for (int j = 0; j < 4; ++j) { const int n = (lane >> 3) + 8 * j; const LAS float* s = scr + (8 * c) * 33 + n;
        u32x4 o; o.x = cvtpk(s[0 * 33], s[1 * 33]); o.y = cvtpk(s[2 * 33], s[3 * 33]); o.z = cvtpk(s[4 * 33], s[5 * 33]); o.w = cvtpk(s[6 * 33], s[7 * 33]);
        *(u32x4*)(WT + (size_t)(n0 + n) * K + k0 + 8 * c) = o; }
    LDS_WAIT(); asm volatile("" ::: "memory");
}
DI void wt_load8(const float* W, int ldw, int c0, int k0, int lane, f32x4 (&v)[8]) {
    const int c4 = (lane & 7) * 4;
#pragma unroll
    for (int i = 0; i < 8; ++i) { const int kk = 8 * i + (lane >> 3); v[i] = *(const f32x4*)(W + (size_t)(k0 + kk) * ldw + c0 + c4); }
}
DI void wt_finish8(const f32x4 (&v)[8], const float* g, float scale, unsigned char* WT, int K8, int n0, int k0, LAS float* scr, int lane) {
    { const int c4 = (lane & 7) * 4;
#pragma unroll
      for (int i = 0; i < 8; ++i) { const int kk = 8 * i + (lane >> 3); const float gs = g ? g[k0 + kk] * scale : scale; LAS float* d = scr + kk * 33 + c4; d[0] = v[i][0] * gs; d[1] = v[i][1] * gs; d[2] = v[i][2] * gs; d[3] = v[i][3] * gs; } }
    LDS_WAIT(); asm volatile("" ::: "memory");
    const int c = lane & 3;
#pragma unroll
    for (int j = 0; j < 2; ++j) { const int n = (lane >> 2) + 16 * j; const LAS float* sp = scr + (16 * c) * 33 + n; u32x4 o;
        o.x = pk4_fp8(sp[0 * 33], sp[1 * 33], sp[2 * 33], sp[3 * 33]); o.y = pk4_fp8(sp[4 * 33], sp[5 * 33], sp[6 * 33], sp[7 * 33]); o.z = pk4_fp8(sp[8 * 33], sp[9 * 33], sp[10 * 33], sp[11 * 33]); o.w = pk4_fp8(sp[12 * 33], sp[13 * 33], sp[14 * 33], sp[15 * 33]);
        *(u32x4*)(WT + (size_t)(n0 + n) * K8 + k0 + 16 * c) = o; }
    LDS_WAIT(); asm volatile("" ::: "memory");
}
DI void wt_item8(const float* W, int ldw, int c0, const float* g, float scale, unsigned char* WT, int K8, int n0, int k0, LAS float* scr, int lane) {
    f32x4 v[8]; wt_load8(W, ldw, c0, k0, lane, v); wt_finish8(v, g, scale, WT, K8, n0, k0, scr, lane);
}
DI void inmap(int nb, int& c0, int& nv) {
    nv = 32;
    if (nb < 48) c0 = 32 * nb;
    else if (nb < 54) c0 = 1536 + 32 * (nb - 48);
    else if (nb < 56) { c0 = 0; nv = 0; }
    else if (nb < 60) c0 = 1728 + 32 * (nb - 56);
    else if (nb == 60) c0 = 1856;
    else if (nb == 61) { c0 = 2656; nv = 4; }
    else if (nb < 64) { c0 = 0; nv = 0; }
    else if (nb < 72) c0 = 1888 + 32 * (nb - 64);
    else if (nb < 80) c0 = 2144 + 32 * (nb - 72);
    else c0 = 2400 + 32 * (nb - 80);
}
DI float row_to_bf16(const float* xrow, bf16_t* orow, int lane) {
    const f32x4* xr = (const f32x4*)xrow + lane; f32x4 v[4]; float s = 0.f;
#pragma unroll
    for (int j = 0; j < 4; ++j) { v[j] = xr[64 * j]; s += (v[j].x * v[j].x + v[j].y * v[j].y) + (v[j].z * v[j].z + v[j].w * v[j].w); }
    u32x2* o8 = (u32x2*)orow + lane;
#pragma unroll
    for (int j = 0; j < 4; ++j) { u32x2 w; w.x = cvtpk(v[j].x, v[j].y); w.y = cvtpk(v[j].z, v[j].w); o8[64 * j] = w; }
    return wave_sum(s);
}

constexpr int CV_I_IN = 88 * 16, CV_I_OUT = 32 * 16, CV_I_G = 88 * 16, CV_I_D = 32 * 44, CV_NITEMS = 2 * CV_I_IN + 2 * CV_I_OUT + 2 * CV_I_G + CV_I_D;
DI void convert_weights(const Params& p, LAS float* scr, int it0, int it1, int gw, int NGW, int lane) {
    bf16_t* Win = (bf16_t*)(p.ws + WS_WIN); bf16_t* Wout = (bf16_t*)(p.ws + WS_WOUT); bf16_t* Wgu = (bf16_t*)(p.ws + WS_WGU); bf16_t* Wd = (bf16_t*)(p.ws + WS_WD);
    constexpr int I_IN = CV_I_IN, I_OUT = CV_I_OUT, I_G = CV_I_G;
    for (int it = it0 + gw; it < it1; it += NGW) {
        int r = it;
        if (r < 2 * I_IN) { const int l = r / I_IN; r %= I_IN; const int nb = r / 16, kb = r % 16; int c0, nv; inmap(nb, c0, nv);
            wt_item(p.w_in + (size_t)l * D * 2660, 2660, c0, nv, p.norm1_g + l * D, Win + (size_t)l * ZC * D, D, 32 * nb, 64 * kb, scr, lane); continue; }
        r -= 2 * I_IN;
        if (r < 2 * I_OUT) { const int l = r / I_OUT; r %= I_OUT; const int nb = r / 16, kb = r % 16;
            wt_item(p.w_out + (size_t)l * D * D, D, 32 * nb, 32, p.out_norm_g + l * D, Wout + (size_t)l * D * D, D, 32 * nb, 64 * kb, scr, lane); continue; }
        r -= 2 * I_OUT;
        if (r < 2 * I_G) { const int up = r / I_G; r %= I_G; const int sb = r / 16, kb = r % 16;
            wt_item(up ? p.ffn_w_up : p.ffn_w_gate, DFF, 32 * sb, 32, p.norm2_g, Wgu, D, 256 * (sb >> 2) + 128 * up + 32 * (sb & 3), 64 * kb, scr, lane); continue; }
        r -= 2 * I_G;
        { const int sb = r / 44, kb = r % 44; wt_item(p.ffn_w_down, D, 32 * sb, 32, nullptr, Wd, DFF, 32 * sb, 64 * kb, scr, lane); }
    }
}
DI void p0_prologue(const Params& p, const Frame& F, float* ss0) {
    TID_VARS;
    LAS float* scr = (LAS float*)(F.lds + wave * 16384);
    const int gw = F.vcu * 8 + wave, NGW = F.G * 8;
    bf16_t* Win = (bf16_t*)(p.ws + WS_WIN); bf16_t* Wout = (bf16_t*)(p.ws + WS_WOUT); bf16_t* Wgu = (bf16_t*)(p.ws + WS_WGU); bf16_t* Wd = (bf16_t*)(p.ws + WS_WD);
    convert_weights(p, scr, 0, CV_I_IN, gw, NGW, lane);
    { bf16_t* LW = (bf16_t*)(p.ws + WS_WSM + SM_LRUW); const int gt = F.vcu * 512 + tid, NT = F.G * 512;
      for (int i = gt; i < 2 * 2 * 4 * 64 * 64; i += NT) { const int c = i & 63, d = (i >> 6) & 63, blk = (i >> 12) & 3, mat = (i >> 14) & 1, l = i >> 15;
          const float* src = mat ? p.lru_wx : p.lru_wa; LW[i] = f2bf(src[((size_t)(l * 4 + blk) * 64 + c) * 64 + d]); } }
    { const int gt = F.vcu * 512 + tid, NT = F.G * 512;
      bf16_t* WQ = (bf16_t*)(p.ws + WS_WSM + SM_WUQ); bf16_t* WKV = (bf16_t*)(p.ws + WS_WSM + SM_WUKV);
      for (int i = gt; i < 2 * 384 * 192; i += NT) { const int k = i % 192, n = (i / 192) % 384, l = i / (192 * 384); WQ[i] = f2bf(p.mla_w_uq[((size_t)l * 192 + k) * 384 + n] * p.mla_gq[l * 192 + k]); }
      for (int i = gt; i < 2 * 512 * 128; i += NT) { const int k = i % 128, n = (i / 128) % 512, l = i / (128 * 512); WKV[i] = f2bf(p.mla_w_ukv[((size_t)l * 128 + k) * 512 + n] * p.mla_gkv[l * 128 + k]); }
      float* ROPE = (float*)(p.ws + WS_HG + HG_ROPE);
      for (int i = gt; i < 8208 * 16; i += NT) { const int pos = i >> 4, fi = i & 15, a = fi >> 2, bq = fi & 3;
          const double base = bq == 0 ? 1.0 : bq == 1 ? 0.5623413251903491 : bq == 2 ? 0.31622776601683794 : 0.1778279410038923;
          const double sc = a == 0 ? 1.0 : a == 1 ? 0.1 : a == 2 ? 0.01 : 0.001;
          double rev = (double)pos * (base * sc) * 0.15915494309189535; rev -= __builtin_floor(rev);
          ROPE[2 * i] = __builtin_amdgcn_cosf((float)rev); ROPE[2 * i + 1] = __builtin_amdgcn_sinf((float)rev); } }
    bf16_t* bufA = (bf16_t*)(p.ws + WS_BUFA);
    for (int m0 = 4 * gw; m0 < NR; m0 += 4 * NGW) {
        f32x4 v[4][4];
#pragma unroll
        for (int r = 0; r < 4; ++r)
#pragma unroll
            for (int j = 0; j < 4; ++j) v[r][j] = ((const f32x4*)(p.x + (size_t)(m0 + r) * D) + lane)[64 * j];
#pragma unroll
        for (int r = 0; r < 4; ++r) { float sq = 0.f; u32x2* o8 = (u32x2*)(bufA + (size_t)(m0 + r) * D) + lane;
#pragma unroll
            for (int j = 0; j < 4; ++j) { sq += (v[r][j].x * v[r][j].x + v[r][j].y * v[r][j].y) + (v[r][j].z * v[r][j].z + v[r][j].w * v[r][j].w); u32x2 w; w.x = cvtpk(v[r][j].x, v[r][j].y); w.y = cvtpk(v[r][j].z, v[r][j].w); o8[64 * j] = w; }
            sq = wave_sum(sq); if (lane == 0) ss0[m0 + r] = sq; } }
    for (int m = gw; m < 256; m += NGW) {
        const int row = MB0 + m;
        if (m >= META_OFF && m < META_OFF + NMETA) { const float s = row_to_bf16(p.meta + (size_t)(m - META_OFF) * D, bufA + (size_t)row * D, lane); if (lane == 0) ss0[row] = s; }
        else { u32x4* o = (u32x4*)(bufA + (size_t)row * D) + lane; o[0] = zero4(); o[64] = zero4(); if (lane == 0) ss0[row] = 0.f; }
    }
}

template <int nrows> DI void lru_local_unit(const Params& p, const Frame& F, int l, int r0, int hrow, int aggidx) {
    const bf16_t* Z = (const bf16_t*)(p.ws + WS_Z);
    bf16_t* LA = (bf16_t*)(p.ws + WS_LRU + LRU_LA); bf16_t* LB = (bf16_t*)(p.ws + WS_LRU + LRU_BC);
    float* AGGA = (float*)(p.ws + WS_LRU + LRU_AGGA); float* AGGB = (float*)(p.ws + WS_LRU + LRU_AGGB);
    constexpr int UP = 264;
    LAS bf16_t* U = (LAS bf16_t*)F.lds;
    LAS bf16_t* TLA = (LAS bf16_t*)(F.lds + 64 * UP * 2);
    LAS bf16_t* TLB = (LAS bf16_t*)(F.lds + 64 * UP * 2 + 64 * 256 * 2);
    TID_VARS; const int w = wave;
    { const int c = tid & 255, half = tid >> 8; constexpr int nh = nrows >> 1; const int t0 = half * nh;
      const float cw0 = p.lru_conv_w[(l * 4 + 0) * 256 + c], cw1 = p.lru_conv_w[(l * 4 + 1) * 256 + c], cw2 = p.lru_conv_w[(l * 4 + 2) * 256 + c], cw3 = p.lru_conv_w[(l * 4 + 3) * 256 + c], cb = p.lru_conv_b[l * 256 + c];
      bf16_t xr[nh + 3];
#pragma unroll
      for (int i = 0; i < 3; ++i) xr[i] = Z[(size_t)((t0 == 0 ? hrow : r0 + t0 - 3) + i) * ZC + ZC_XA + c];
#pragma unroll
      for (int t = 0; t < nh; ++t) xr[3 + t] = Z[(size_t)(r0 + t0 + t) * ZC + ZC_XA + c];
#pragma unroll
      for (int t = 0; t < nh; ++t) { const float u = cb + cw0 * bf2f(xr[t]) + cw1 * bf2f(xr[t + 1]) + cw2 * bf2f(xr[t + 2]) + cw3 * bf2f(xr[t + 3]); U[(t0 + t) * UP + c] = f2bf(u); } }
    __syncthreads();
    { const int blk = w >> 1, fr = lane & 15, fq = lane >> 4;
      const bf16_t* LW = (const bf16_t*)(p.ws + WS_WSM + SM_LRUW) + (size_t)l * 2 * 4 * 4096;
      bf16x8 baA[2][2], bxA[2][2]; f32x4 bavA[2], bxvA[2], lamA[2];
#pragma unroll
      for (int cbk = 0; cbk < 2; ++cbk) { const int dbase = 16 * (2 * (w & 1) + cbk), ch4 = blk * 64 + dbase + 4 * fq;
#pragma unroll
          for (int ks = 0; ks < 2; ++ks) { baA[cbk][ks] = *(const bf16x8*)(LW + ((size_t)(0 * 4 + blk) * 64 + dbase + fr) * 64 + 32 * ks + 8 * fq); bxA[cbk][ks] = *(const bf16x8*)(LW + ((size_t)(1 * 4 + blk) * 64 + dbase + fr) * 64 + 32 * ks + 8 * fq); }
          bavA[cbk] = *(const f32x4*)(p.lru_ba + l * 256 + ch4); bxvA[cbk] = *(const f32x4*)(p.lru_bx + l * 256 + ch4); lamA[cbk] = *(const f32x4*)(p.lru_lambda + l * 256 + ch4); }
#pragma unroll
      for (int cbk = 0; cbk < 2; ++cbk) { const int dbase = 16 * (2 * (w & 1) + cbk), ch4 = blk * 64 + dbase + 4 * fq;
          const bf16x8 ba[2] = {baA[cbk][0], baA[cbk][1]}, bx[2] = {bxA[cbk][0], bxA[cbk][1]};
          const f32x4 bav = bavA[cbk], bxv = bxvA[cbk], lam = lamA[cbk];
          float sp[4];
#pragma unroll
          for (int j = 0; j < 4; ++j) sp[j] = log1pf(__expf(-lam[j]));
          for (int rb = 0; rb < (nrows >> 4); ++rb) {
              f32x4 ar = {0.f, 0.f, 0.f, 0.f}, ai = {0.f, 0.f, 0.f, 0.f};
#pragma unroll
              for (int ks = 0; ks < 2; ++ks) { const bf16x8 a = *(const LAS bf16x8*)(U + (16 * rb + fr) * UP + blk * 64 + 32 * ks + 8 * fq);
                  ar = __builtin_amdgcn_mfma_f32_16x16x32_bf16(ba[ks], a, ar, 0, 0, 0); ai = __builtin_amdgcn_mfma_f32_16x16x32_bf16(bx[ks], a, ai, 0, 0, 0); }
              const int t = 16 * rb + fr;
              const u32x2 uw = *(const LAS u32x2*)(U + t * UP + ch4); const float uv[4] = {bflo(uw.x), bfhi(uw.x), bflo(uw.y), bfhi(uw.y)};
              float la[4], bc[4];
#pragma unroll
              for (int j = 0; j < 4; ++j) { const float r = sigmoidf_(ar[j] + bav[j]), ig = sigmoidf_(ai[j] + bxv[j]);
                  la[j] = -8.f * r * sp[j]; const float x2 = 2.f * la[j];
                  const float om = (x2 > -0.1f) ? -x2 * (1.f + x2 * (0.5f + x2 * (1.f / 6.f + x2 * (1.f / 24.f + x2 * (1.f / 120.f))))) : 1.f - __expf(x2);
                  bc[j] = __builtin_amdgcn_sqrtf(om) * ig * uv[j]; }
              u32x2 wa, wb; wa.x = cvtpk(la[0], la[1]); wa.y = cvtpk(la[2], la[3]); wb.x = cvtpk(bc[0], bc[1]); wb.y = cvtpk(bc[2], bc[3]);
              *(LAS u32x2*)(TLA + t * 256 + ch4) = wa; *(LAS u32x2*)(TLB + t * 256 + ch4) = wb;
              *(u32x2*)(LA + (size_t)(r0 + t) * 256 + ch4) = wa; *(u32x2*)(LB + (size_t)(r0 + t) * 256 + ch4) = wb; } } }
    __syncthreads();
    { const int c = tid & 255, qd = tid >> 8; constexpr int RH = nrows >> 1; float h = 0.f, sl = 0.f;
#pragma unroll
      for (int t = 0; t < RH; ++t) { const float la = bf2f(TLA[(qd * RH + t) * 256 + c]), bc = bf2f(TLB[(qd * RH + t) * 256 + c]); h = __expf(la) * h + bc; sl += la; }
      LAS float* XA = (LAS float*)U;
      __syncthreads();
      XA[(qd * 256 + c) * 2] = sl; XA[(qd * 256 + c) * 2 + 1] = h;
      __syncthreads();
      if (tid < 256) { const float s0 = XA[c * 2], h0 = XA[c * 2 + 1], s1 = XA[(256 + c) * 2], h1 = XA[(256 + c) * 2 + 1];
          AGGA[(size_t)aggidx * 256 + c] = s0 + s1; AGGB[(size_t)aggidx * 256 + c] = __expf(s1) * h0 + h1; } }
    __syncthreads();
}
DI void lru_carry(const Params& p, int b, int c) {
    const float* AGGA = (const float*)(p.ws + WS_LRU + LRU_AGGA); const float* AGGB = (const float*)(p.ws + WS_LRU + LRU_AGGB); float* HIN = (float*)(p.ws + WS_LRU + LRU_HIN);
    float h = AGGB[(size_t)(NB * NSEG) * 256 + c];
    for (int hf = 0; hf < 4; ++hf) {
        float a[32], bb[32];
#pragma unroll
        for (int s = 0; s < 32; ++s) { const size_t i = (size_t)(b * NSEG + hf * 32 + s) * 256 + c; a[s] = AGGA[i]; bb[s] = AGGB[i]; }
#pragma unroll
        for (int s = 0; s < 32; ++s) { const float hin = h; h = __expf(a[s]) * h + bb[s]; a[s] = hin; }
#pragma unroll
        for (int s = 0; s < 32; ++s) { const size_t i = (size_t)(b * NSEG + hf * 32 + s) * 256 + c; HIN[i] = a[s]; }
    }
}
template <int nrows> DI void lru_fix_unit(const Params& p, const Frame& F, int l, int r0, int aggidx, bool meta, float* gss) {
    const bf16_t* Z = (const bf16_t*)(p.ws + WS_Z); const bf16_t* LA = (const bf16_t*)(p.ws + WS_LRU + LRU_LA); const bf16_t* LB = (const bf16_t*)(p.ws + WS_LRU + LRU_BC);
    const float* HIN = (const float*)(p.ws + WS_LRU + LRU_HIN); bf16_t* Y = (bf16_t*)(p.ws + WS_BUFB);
    LAS float* AG = (LAS float*)F.lds;
    LAS float* red = (LAS float*)(F.lds + 8192);
    TID_VARS; constexpr int RQ = nrows >> 2; const int c2 = tid & 127, rq = tid >> 7;
    unsigned la2[RQ], bc2[RQ], ga2[RQ];
#pragma unroll
    for (int t = 0; t < RQ; ++t) { const size_t row = (size_t)(r0 + rq * RQ + t); la2[t] = *(const unsigned*)(LA + row * 256 + 2 * c2); bc2[t] = *(const unsigned*)(LB + row * 256 + 2 * c2); ga2[t] = *(const unsigned*)(Z + row * ZC + ZC_GA + 2 * c2); }
    float hin0 = 0.f, hin1 = 0.f; if (!meta) { const f32x2 hv = *(const f32x2*)(HIN + (size_t)aggidx * 256 + 2 * c2); hin0 = hv.x; hin1 = hv.y; }
    float hl0[RQ], hl1[RQ], ac0[RQ], ac1[RQ]; float h0 = 0.f, h1 = 0.f, A0 = 1.f, A1 = 1.f;
#pragma unroll
    for (int t = 0; t < RQ; ++t) { const float a0 = __expf(bflo(la2[t])), a1 = __expf(bfhi(la2[t])); h0 = a0 * h0 + bflo(bc2[t]); h1 = a1 * h1 + bfhi(bc2[t]); A0 *= a0; A1 *= a1; hl0[t] = h0; hl1[t] = h1; ac0[t] = A0; ac1[t] = A1; }
    *(LAS f32x4*)(AG + (rq * 128 + c2) * 4) = (f32x4){A0, h0, A1, h1};
    __syncthreads();
    for (int q = 0; q < rq; ++q) { const f32x4 v = *(const LAS f32x4*)(AG + (q * 128 + c2) * 4); hin0 = v[0] * hin0 + v[1]; hin1 = v[2] * hin1 + v[3]; }
#pragma unroll
    for (int t = 0; t < RQ; ++t) { const size_t row = (size_t)(r0 + rq * RQ + t);
        const float y0 = (hl0[t] + ac0[t] * hin0) * gelu_tanh(bflo(ga2[t])), y1 = (hl1[t] + ac1[t] * hin1) * gelu_tanh(bfhi(ga2[t]));
        const unsigned w = cvtpk(y0, y1); *(unsigned*)(Y + row * D + Y_LRU + 2 * c2) = w;
        const float z0 = bflo(w), z1 = bfhi(w); const float sv = wave_sum(z0 * z0 + z1 * z1); if (lane == 0) red[(rq * RQ + t) * 2 + (wave & 1)] = sv; }
    __syncthreads();
    if (tid < nrows) *(f32x4*)(gss + (size_t)(r0 + tid) * 16) = (f32x4){red[tid * 2] + red[tid * 2 + 1], 0.f, 0.f, 0.f};
    __syncthreads();
}


constexpr int HG_WL = 11776;
DI void hg_local_wave(const Params& p, LAS unsigned char* wl, int l, int r0, int nrows, int h, int slot, int lane) {
    bf16_t* Z = (bf16_t*)(p.ws + WS_Z);
    float* UT = (float*)(p.ws + WS_HG + HG_UT) + (size_t)slot * 4096; float* DL = (float*)(p.ws + WS_HG + HG_DL) + (size_t)slot * 64;
    LAS bf16_t* QD = (LAS bf16_t*)wl; LAS bf16_t* KD = QD + 16 * 72; LAS bf16_t* KET = KD + 16 * 72; LAS bf16_t* VT = KET + 64 * 24; LAS bf16_t* ATT = VT + 64 * 24; LAS float* DEC = (LAS float*)(ATT + 16 * 24);
    const int fr = lane & 15, g = lane >> 4;
    float lbv = 0.f;
    if (l == 1) { const float l0 = p.hg_lb_logits[h * 64 + lane], l1 = p.hg_lb_logits[256 + h * 64 + lane]; lbv = sigmoidf_(l1 - l0); }
    f32x4 S[4][4];
#pragma unroll
    for (int a = 0; a < 4; ++a)
#pragma unroll
        for (int b = 0; b < 4; ++b) S[a][b] = (f32x4){0.f, 0.f, 0.f, 0.f};
    float Bseg = 0.f;
    const bf16x8 zero8 = {0, 0, 0, 0, 0, 0, 0, 0};
    for (int c = 0; c < (nrows >> 4); ++c) {
        const int rc = r0 + 16 * c;
        float bsum = 0.f; float kdv[16];
#pragma unroll
        for (int t = 0; t < 16; ++t) {
            const size_t zo = (size_t)(rc + t) * ZC + 64 * h + lane;
            const float fz = bf2f(Z[zo + ZC_HF]), q = bf2f(Z[zo + ZC_HQ]); const bf16_t vraw = Z[zo + ZC_HV];
            const float sg = sigmoidf_(fz); const float f = lbv + (1.f - lbv) * sg; const float k = (1.f - lbv) * (1.f - sg);
            bsum += __logf(f);
            const float eb = __expf(bsum), enb = __expf(-bsum);
            QD[t * 72 + lane] = f2bf(q * eb); kdv[t] = k * enb; KD[t * 72 + lane] = f2bf(kdv[t]); VT[lane * 24 + t] = vraw;
            Z[zo + ZC_HQ] = f2bf(q * __expf(Bseg + bsum));
        }
        const float eend = __expf(bsum);
#pragma unroll
        for (int t = 0; t < 16; ++t) KET[lane * 24 + t] = f2bf(kdv[t] * eend);
        DEC[lane] = eend; Bseg += bsum;
        LDS_WAIT();
        f32x4 at = {0.f, 0.f, 0.f, 0.f};
#pragma unroll
        for (int ks = 0; ks < 2; ++ks) { const bf16x8 a = *(const LAS bf16x8*)(KD + fr * 72 + 32 * ks + 8 * g), b = *(const LAS bf16x8*)(QD + fr * 72 + 32 * ks + 8 * g);
            at = __builtin_amdgcn_mfma_f32_16x16x32_bf16(a, b, at, 0, 0, 0); }
#pragma unroll
        for (int j = 0; j < 4; ++j) if (4 * g + j > fr) at[j] = 0.f;
        { u32x2 w; w.x = cvtpk(at[0], at[1]); w.y = cvtpk(at[2], at[3]); *(LAS u32x2*)(ATT + fr * 24 + 4 * g) = w; }
        LDS_WAIT();
        const bf16x8 aatt = (g < 2) ? *(const LAS bf16x8*)(ATT + fr * 24 + 8 * g) : zero8;
        bf16x8 bv[4], aket[4];
#pragma unroll
        for (int i = 0; i < 4; ++i) { bv[i] = (g < 2) ? *(const LAS bf16x8*)(VT + (fr + 16 * i) * 24 + 8 * g) : zero8; aket[i] = (g < 2) ? *(const LAS bf16x8*)(KET + (fr + 16 * i) * 24 + 8 * g) : zero8; }
        f32x4 o[4];
#pragma unroll
        for (int cb = 0; cb < 4; ++cb) o[cb] = __builtin_amdgcn_mfma_f32_16x16x32_bf16(bv[cb], aatt, (f32x4){0.f, 0.f, 0.f, 0.f}, 0, 0, 0);
#pragma unroll
        for (int ks = 0; ks < 2; ++ks) {
            const u32x2 q0 = *(const LAS u32x2*)(QD + fr * 72 + 32 * ks + 4 * g), q1 = *(const LAS u32x2*)(QD + fr * 72 + 32 * ks + 16 + 4 * g);
            const bf16x8 aq = __builtin_bit_cast(bf16x8, (u32x4){q0.x, q0.y, q1.x, q1.y});
#pragma unroll
            for (int cb = 0; cb < 4; ++cb) { const f32x4 s0 = S[2 * ks][cb], s1 = S[2 * ks + 1][cb];
                const bf16x8 bs = __builtin_bit_cast(bf16x8, (u32x4){cvtpk(s0[0], s0[1]), cvtpk(s0[2], s0[3]), cvtpk(s1[0], s1[1]), cvtpk(s1[2], s1[3])});
                o[cb] = __builtin_amdgcn_mfma_f32_16x16x32_bf16(bs, aq, o[cb], 0, 0, 0); }
        }
#pragma unroll
        for (int cb = 0; cb < 4; ++cb) { u32x2 w; w.x = cvtpk(o[cb][0], o[cb][1]); w.y = cvtpk(o[cb][2], o[cb][3]); *(u32x2*)(Z + (size_t)(rc + fr) * ZC + ZC_HF + 64 * h + 16 * cb + 4 * g) = w; }
#pragma unroll
        for (int rb = 0; rb < 4; ++rb) { const f32x4 d4 = *(const LAS f32x4*)(DEC + 16 * rb + 4 * g);
#pragma unroll
            for (int cb = 0; cb < 4; ++cb) { const f32x4 u = __builtin_amdgcn_mfma_f32_16x16x32_bf16(aket[rb], bv[cb], (f32x4){0.f, 0.f, 0.f, 0.f}, 0, 0, 0); S[rb][cb] = S[rb][cb] * d4 + u; } }
        LDS_WAIT();
    }
#pragma unroll
    for (int rb = 0; rb < 4; ++rb)
#pragma unroll
        for (int cb = 0; cb < 4; ++cb) *(f32x4*)(UT + (fr + 16 * cb) * 64 + 16 * rb + 4 * g) = S[rb][cb];
    DL[lane] = Bseg;
}
DI void hg_carry_block(const Params& p, LAS unsigned char* lds, int bh, int part, int tid) {
    float* UT = (float*)(p.ws + WS_HG + HG_UT); const float* DL = (const float*)(p.ws + WS_HG + HG_DL);
    LAS float* DEC = (LAS float*)lds;
    for (int i = tid; i < 128 * 64; i += 512) DEC[i] = __expf(DL[(size_t)bh * 128 * 64 + i]);
    const int e = part * 512 + tid, dk = e & 63;
    float s = UT[(size_t)(2048 + (bh & 3)) * 4096 + e];
    __syncthreads();
    for (int hf = 0; hf < 2; ++hf) {
        float u[64];
#pragma unroll
        for (int i = 0; i < 64; ++i) u[i] = UT[(size_t)(bh * 128 + hf * 64 + i) * 4096 + e];
#pragma unroll
        for (int i = 0; i < 64; ++i) { const float sin_ = s; s = DEC[(hf * 64 + i) * 64 + dk] * s + u[i]; u[i] = sin_; }
#pragma unroll
        for (int i = 0; i < 64; ++i) UT[(size_t)(bh * 128 + hf * 64 + i) * 4096 + e] = u[i];
    }
    __syncthreads();
}
DI void hg_fix_wave(const Params& p, int r0, int nrows, int h, int slot, bool meta, float* gss, int lane) {
    const bf16_t* Z = (const bf16_t*)(p.ws + WS_Z); bf16_t* Y = (bf16_t*)(p.ws + WS_BUFB);
    const float* SI = (const float*)(p.ws + WS_HG + HG_UT) + (size_t)slot * 4096;
    const int fr = lane & 15, g = lane >> 4;
    bf16x8 bS[2][4];
    if (!meta) {
#pragma unroll
        for (int ks = 0; ks < 2; ++ks)
#pragma unroll
            for (int cb = 0; cb < 4; ++cb) { const f32x4 s0 = *(const f32x4*)(SI + (fr + 16 * cb) * 64 + 32 * ks + 8 * g), s1 = *(const f32x4*)(SI + (fr + 16 * cb) * 64 + 32 * ks + 8 * g + 4);
                bS[ks][cb] = __builtin_bit_cast(bf16x8, (u32x4){cvtpk(s0[0], s0[1]), cvtpk(s0[2], s0[3]), cvtpk(s1[0], s1[1]), cvtpk(s1[2], s1[3])}); }
    }
    for (int rbk = 0; rbk < (nrows >> 4); ++rbk) {
        f32x4 o[4];
#pragma unroll
        for (int cb = 0; cb < 4; ++cb) o[cb] = (f32x4){0.f, 0.f, 0.f, 0.f};
        if (!meta) {
#pragma unroll
            for (int ks = 0; ks < 2; ++ks) { const bf16x8 a = *(const bf16x8*)(Z + (size_t)(r0 + 16 * rbk + fr) * ZC + ZC_HQ + 64 * h + 32 * ks + 8 * g);
#pragma unroll
                for (int cb = 0; cb < 4; ++cb) o[cb] = __builtin_amdgcn_mfma_f32_16x16x32_bf16(bS[ks][cb], a, o[cb], 0, 0, 0); }
        }
        const size_t row = (size_t)(r0 + 16 * rbk + fr); float sq = 0.f;
#pragma unroll
        for (int cb = 0; cb < 4; ++cb) { const int col4 = 64 * h + 16 * cb + 4 * g;
            const u32x2 ow = *(const u32x2*)(Z + row * ZC + ZC_HF + col4), gw = *(const u32x2*)(Z + row * ZC + ZC_HG + col4);
            const float ol[4] = {bflo(ow.x), bfhi(ow.x), bflo(ow.y), bfhi(ow.y)}, gg[4] = {bflo(gw.x), bfhi(gw.x), bflo(gw.y), bfhi(gw.y)}; float val[4];
#pragma unroll
            for (int j = 0; j < 4; ++j) val[j] = (o[cb][j] + ol[j]) * (gg[j] * sigmoidf_(gg[j]));
            u32x2 w; w.x = cvtpk(val[0], val[1]); w.y = cvtpk(val[2], val[3]); *(u32x2*)(Y + row * D + Y_HG + col4) = w;
            const float z0 = bflo(w.x), z1 = bfhi(w.x), z2 = bflo(w.y), z3 = bfhi(w.y); sq += (z0 * z0 + z1 * z1) + (z2 * z2 + z3 * z3); }
        sq += __shfl_xor(sq, 16); sq += __shfl_xor(sq, 32);
        if (g == 0) gss[row * 16 + 4 + h] = sq;
    }
}

constexpr float LOG2E = 1.4426950408889634f;
constexpr float QS_FOX = 0.125f * LOG2E, QS_MLA = 0.10206207261596575f * LOG2E;
DI int row_pos(int row) { return row < NR ? 16 + (row & (SEQ - 1)) : row - MROW0; }
DI float swap_other(float x, bool domax) { auto rr = __builtin_amdgcn_permlane32_swap(__float_as_uint(x), __float_as_uint(x), false, false); const float a = __uint_as_float(rr[0]), b = __uint_as_float(rr[1]); return domax ? fmaxf(a, b) : a + b; }

template <int nrows> DI void fox_prep_unit(const Params& p, const Frame& F, int l, int r0) {
    TID_VARS; bf16_t* Z = (bf16_t*)(p.ws + WS_Z); bf16_t* FVT = (bf16_t*)(p.ws + WS_ATT + AT_FVT); float* FLF = (float*)(p.ws + WS_LRU + LRU_FLF);
    LAS bf16_t* VTILE = (LAS bf16_t*)F.lds;
    const int d0 = (4 * lane) & 63;
    const f32x4 gq = *(const f32x4*)(p.fox_gqn + l * 64 + d0), gk = *(const f32x4*)(p.fox_gkn + l * 64 + d0);
    { constexpr int NT = nrows / 8; u32x2 qw[NT], kw[NT], vw[NT]; float fx[NT];
#pragma unroll
      for (int i = 0; i < NT; ++i) { const size_t row = (size_t)(r0 + wave + 8 * i); qw[i] = *(const u32x2*)(Z + row * ZC + ZC_FQ + 4 * lane); kw[i] = *(const u32x2*)(Z + row * ZC + ZC_FK + 4 * lane); vw[i] = *(const u32x2*)(Z + row * ZC + ZC_FV + 4 * lane);
          fx[i] = bf2f(Z[row * ZC + ZC_FF + (lane & 3)]); }
#pragma unroll
      for (int i = 0; i < NT; ++i) { const int t = wave + 8 * i; const size_t row = (size_t)(r0 + t);
        { const u32x2 w = qw[i]; const float a0 = bflo(w.x), a1 = bfhi(w.x), a2 = bflo(w.y), a3 = bfhi(w.y);
          float ss = (a0 * a0 + a1 * a1) + (a2 * a2 + a3 * a3); ss += __shfl_xor(ss, 1); ss += __shfl_xor(ss, 2); ss += __shfl_xor(ss, 4); ss += __shfl_xor(ss, 8);
          const float rs = rsqrtf(ss * (1.f / 64.f) + EPS) * QS_FOX; u32x2 o; o.x = cvtpk(a0 * rs * gq[0], a1 * rs * gq[1]); o.y = cvtpk(a2 * rs * gq[2], a3 * rs * gq[3]); *(u32x2*)(Z + row * ZC + ZC_FQ + 4 * lane) = o; }
        { const u32x2 w = kw[i]; const float a0 = bflo(w.x), a1 = bfhi(w.x), a2 = bflo(w.y), a3 = bfhi(w.y);
          float ss = (a0 * a0 + a1 * a1) + (a2 * a2 + a3 * a3); ss += __shfl_xor(ss, 1); ss += __shfl_xor(ss, 2); ss += __shfl_xor(ss, 4); ss += __shfl_xor(ss, 8);
          const float rs = rsqrtf(ss * (1.f / 64.f) + EPS); u32x2 o; o.x = cvtpk(a0 * rs * gk[0], a1 * rs * gk[1]); o.y = cvtpk(a2 * rs * gk[2], a3 * rs * gk[3]); *(u32x2*)(Z + row * ZC + ZC_FK + 4 * lane) = o; }
        *(LAS u32x2*)(VTILE + t * 264 + 4 * lane) = vw[i];
        if (lane < 4) { const float x = fx[i] + p.fox_bf[l * 4 + lane]; const float ls = fminf(x, 0.f) - log1pf(__expf(-fabsf(x))); FLF[(size_t)lane * TM + row] = ls * LOG2E; } } }
    __syncthreads();
    { const int hd = tid & 255, half = tid >> 8, ng = nrows >> 4;
      for (int gi = half; gi < ng; gi += 2) { unsigned short v[16];
#pragma unroll
          for (int ko = 0; ko < 16; ++ko) v[8 * ((ko >> 2) & 1) + (ko & 3) + 4 * (ko >> 3)] = VTILE[(16 * gi + ko) * 264 + hd];
          u32x4 w0, w1; w0.x = v[0] | ((unsigned)v[1] << 16); w0.y = v[2] | ((unsigned)v[3] << 16); w0.z = v[4] | ((unsigned)v[5] << 16); w0.w = v[6] | ((unsigned)v[7] << 16);
          w1.x = v[8] | ((unsigned)v[9] << 16); w1.y = v[10] | ((unsigned)v[11] << 16); w1.z = v[12] | ((unsigned)v[13] << 16); w1.w = v[14] | ((unsigned)v[15] << 16);
          u32x4* dst = (u32x4*)(FVT + (size_t)hd * TM + r0 + 16 * gi); dst[0] = w0; dst[1] = w1; } }
    __syncthreads();
}
DI void fox_cscan_block(const Params& p, LAS unsigned char* lds, int l, int b, int h, int tid) {
    const float* FLF = (const float*)(p.ws + WS_LRU + LRU_FLF) + (size_t)h * TM; float* FC = (float*)(p.ws + WS_LRU + LRU_FC) + (size_t)h * TM;
    LAS float* wt = (LAS float*)lds;
    const int lane = tid & 63, wave = tid >> 6;
    float cm = 0.f;
    for (int i = 0; i < 16; ++i) { cm += FLF[MROW0 + i]; if (b == 0 && tid == 0) FC[MROW0 + i] = cm; }
    const f32x4* src = (const f32x4*)(FLF + (size_t)b * SEQ + 16 * tid); f32x4 v[4];
#pragma unroll
    for (int j = 0; j < 4; ++j) v[j] = src[j];
    float run = 0.f;
#pragma unroll
    for (int j = 0; j < 4; ++j) { run += v[j].x; v[j].x = run; run += v[j].y; v[j].y = run; run += v[j].z; v[j].z = run; run += v[j].w; v[j].w = run; }
    float inc = run;
#pragma unroll
    for (int o = 1; o < 64; o <<= 1) { const float t = __shfl_up(inc, o); if (lane >= o) inc += t; }
    if (lane == 63) wt[wave] = inc;
    __syncthreads();
    float base = cm + (inc - run);
    for (int w = 0; w < wave; ++w) base += wt[w];
    f32x4* dst = (f32x4*)(FC + (size_t)b * SEQ + 16 * tid);
    LAS f32x4* cl = (LAS f32x4*)(lds + 256);
#pragma unroll
    for (int j = 0; j < 4; ++j) { const f32x4 cvv = v[j] + base; dst[j] = cvv; cl[4 * tid + j] = cvv; }
    __syncthreads();
    if (tid < 32) { const LAS float* c1 = (const LAS float*)cl; const int qb = tid; float gq = 0.f, gk = 0.f;
        for (int i = 0; i < 64; ++i) { gq = fmaxf(gq, fabsf(p.fox_gqn[l * 64 + i])); gk = fmaxf(gk, fabsf(p.fox_gkn[l * 64 + i])); }
        const float T = 150.f + 12.f * gq * gk;
        const float cq0 = c1[256 * qb];
        int lo = 0, hi = 4 * qb;
        while (lo < hi) { const int mid = (lo + hi) >> 1; if (cq0 - c1[64 * mid + 63] >= -T) hi = mid; else lo = mid + 1; }
        const bool meta_on = (cq0 - cm) >= -T;
        ((int*)(p.ws + WS_LRU + LRU_FJ0))[(h * NB + b) * 32 + qb] = meta_on ? 0 : ((1 + lo) & ~1); }
    __syncthreads();
}
DI void mla_prep_unit(const Params& p, const Frame& F, int l, int r0, int nrows, int part, int hp) {
    TID_VARS; const bf16_t* Z = (const bf16_t*)(p.ws + WS_Z);
    bf16_t* MQ = (bf16_t*)(p.ws + WS_ATT + AT_MQ); bf16_t* MK = (bf16_t*)(p.ws + WS_ATT + AT_MK); bf16_t* MVT = (bf16_t*)(p.ws + WS_ATT + AT_MVT);
    const float* ROPE = (const float*)(p.ws + WS_HG + HG_ROPE);
    const int KW = part ? 128 : 192, WP = KW + 8, NWR = part ? 256 : 192, CH = KW / 8;
    const bf16_t* Wg = part ? (const bf16_t*)(p.ws + WS_WSM + SM_WUKV) + (size_t)l * 512 * 128 + (size_t)256 * hp * 128 : (const bf16_t*)(p.ws + WS_WSM + SM_WUQ) + (size_t)l * 384 * 192 + (size_t)192 * hp * 192;
    LAS bf16_t* WL = (LAS bf16_t*)F.lds;
    LAS bf16_t* AT = WL + 192 * 200;
    LAS bf16_t* KR = AT + 128 * 200;
    LAS float* RS = (LAS float*)(KR + 128 * 40);
    const int zc0 = part ? ZC_CKV : ZC_CQ;
    { u32x4 wv[10], av[7];
#pragma unroll
      for (int i = 0; i < 10; ++i) { const int c = tid + 512 * i; wv[i] = (u32x4){0u, 0u, 0u, 0u}; if (c < NWR * CH) wv[i] = *(const u32x4*)(Wg + (size_t)(c / CH) * KW + 8 * (c % CH)); }
#pragma unroll
      for (int i = 0; i < 7; ++i) { const int c = tid + 512 * i; av[i] = (u32x4){0u, 0u, 0u, 0u}; if (c < nrows * CH) av[i] = *(const u32x4*)(Z + (size_t)(r0 + c / CH) * ZC + zc0 + 8 * (c % CH)); }
      u32x4 kv = {0u, 0u, 0u, 0u}; if (part && tid < nrows * 4) kv = *(const u32x4*)(Z + (size_t)(r0 + (tid >> 2)) * ZC + ZC_KR + 8 * (tid & 3));
#pragma unroll
      for (int i = 0; i < 10; ++i) { const int c = tid + 512 * i; if (c < NWR * CH) *(LAS u32x4*)(WL + (c / CH) * WP + 8 * (c % CH)) = wv[i]; }
#pragma unroll
      for (int i = 0; i < 7; ++i) { const int c = tid + 512 * i; if (c < nrows * CH) *(LAS u32x4*)(AT + (c / CH) * WP + 8 * (c % CH)) = av[i]; }
      if (part && tid < nrows * 4) *(LAS u32x4*)(KR + (tid >> 2) * 40 + 8 * (tid & 3)) = kv; }
    __syncthreads();
    { const int row = tid >> 2, qd = tid & 3, nq = KW / 4; float ss = 0.f;
      if (row < nrows) { for (int c = 0; c < nq; c += 8) { const u32x4 w = *(const LAS u32x4*)(AT + row * WP + qd * nq + c);
            ss += (bflo(w.x) * bflo(w.x) + bfhi(w.x) * bfhi(w.x)) + (bflo(w.y) * bflo(w.y) + bfhi(w.y) * bfhi(w.y)) + (bflo(w.z) * bflo(w.z) + bfhi(w.z) * bfhi(w.z)) + (bflo(w.w) * bflo(w.w) + bfhi(w.w) * bfhi(w.w)); } }
      ss += __shfl_xor(ss, 1); ss += __shfl_xor(ss, 2);
      if (qd == 0 && row < nrows) RS[row] = rsqrtf(ss / (float)KW + EPS); }
    __syncthreads();
    const int hh = wave & 1, rbp = wave >> 1, h = 2 * hp + hh, fr = lane & 15, g = lane >> 4; const int nrb = nrows >> 4;
    const int rb0 = 2 * rbp; const bool two = rb0 + 1 < nrb;
    if (rb0 < nrb) {
      if (part == 0) {
        f32x4 acc[2][6];
#pragma unroll
        for (int r = 0; r < 2; ++r)
#pragma unroll
            for (int i = 0; i < 6; ++i) acc[r][i] = (f32x4){0.f, 0.f, 0.f, 0.f};
#pragma unroll
        for (int ks = 0; ks < 6; ++ks) { const bf16x8 a0 = *(const LAS bf16x8*)(AT + (16 * rb0 + fr) * 200 + 32 * ks + 8 * g), a1 = *(const LAS bf16x8*)(AT + (16 * (two ? rb0 + 1 : rb0) + fr) * 200 + 32 * ks + 8 * g);
#pragma unroll
            for (int i = 0; i < 6; ++i) { const bf16x8 bw = *(const LAS bf16x8*)(WL + (96 * hh + 16 * i + fr) * 200 + 32 * ks + 8 * g);
                acc[0][i] = __builtin_amdgcn_mfma_f32_16x16x32_bf16(bw, a0, acc[0][i], 0, 0, 0); acc[1][i] = __builtin_amdgcn_mfma_f32_16x16x32_bf16(bw, a1, acc[1][i], 0, 0, 0); } }
        f32x4 gq[6];
#pragma unroll
        for (int i = 0; i < 6; ++i) gq[i] = *(const f32x4*)(p.mla_gqn + l * 96 + 16 * i + 4 * g);
#pragma unroll
        for (int r = 0; r < 2; ++r) { if (r == 1 && !two) break;
            const int t = 16 * (rb0 + r) + fr; const int pos = row_pos(r0 + t);
            const f32x4 rc0 = *(const f32x4*)(ROPE + ((size_t)pos * 16 + 4 * g) * 2), rc1 = *(const f32x4*)(ROPE + ((size_t)pos * 16 + 4 * g) * 2 + 4);
            const float cs[4] = {rc0[0], rc0[2], rc1[0], rc1[2]}, sn[4] = {rc0[1], rc0[3], rc1[1], rc1[3]};
            const float rq = RS[t]; float ss = 0.f;
#pragma unroll
            for (int i = 0; i < 6; ++i) { acc[r][i] = acc[r][i] * rq; ss += (acc[r][i][0] * acc[r][i][0] + acc[r][i][1] * acc[r][i][1]) + (acc[r][i][2] * acc[r][i][2] + acc[r][i][3] * acc[r][i][3]); }
            ss += __shfl_xor(ss, 16); ss += __shfl_xor(ss, 32);
            const float rn = rsqrtf(ss * (1.f / 96.f) + EPS);
#pragma unroll
            for (int i = 0; i < 6; ++i) acc[r][i] = acc[r][i] * gq[i] * rn;
#pragma unroll
            for (int j = 0; j < 4; ++j) { const float t1 = acc[r][4][j], t2 = acc[r][5][j]; acc[r][4][j] = t1 * cs[j] - t2 * sn[j]; acc[r][5][j] = t1 * sn[j] + t2 * cs[j]; }
            bf16_t* dst = MQ + (size_t)(r0 + t) * 384 + 96 * h + 4 * g;
#pragma unroll
            for (int i = 0; i < 6; ++i) { u32x2 w; w.x = cvtpk(acc[r][i][0] * QS_MLA, acc[r][i][1] * QS_MLA); w.y = cvtpk(acc[r][i][2] * QS_MLA, acc[r][i][3] * QS_MLA); *(u32x2*)(dst + 16 * i) = w; } }
      } else {
        f32x4 acc[2][4], accv[2][4];
#pragma unroll
        for (int r = 0; r < 2; ++r)
#pragma unroll
            for (int i = 0; i < 4; ++i) { acc[r][i] = (f32x4){0.f, 0.f, 0.f, 0.f}; accv[r][i] = (f32x4){0.f, 0.f, 0.f, 0.f}; }
#pragma unroll
        for (int ks = 0; ks < 4; ++ks) { const bf16x8 a0 = *(const LAS bf16x8*)(AT + (16 * rb0 + fr) * 136 + 32 * ks + 8 * g), a1 = *(const LAS bf16x8*)(AT + (16 * (two ? rb0 + 1 : rb0) + fr) * 136 + 32 * ks + 8 * g);
#pragma unroll
            for (int i = 0; i < 4; ++i) { const bf16x8 bw = *(const LAS bf16x8*)(WL + (128 * hh + 16 * i + fr) * 136 + 32 * ks + 8 * g), bv2 = *(const LAS bf16x8*)(WL + (128 * hh + 64 + 16 * i + fr) * 136 + 32 * ks + 8 * g);
                acc[0][i] = __builtin_amdgcn_mfma_f32_16x16x32_bf16(bw, a0, acc[0][i], 0, 0, 0); acc[1][i] = __builtin_amdgcn_mfma_f32_16x16x32_bf16(bw, a1, acc[1][i], 0, 0, 0);
                accv[0][i] = __builtin_amdgcn_mfma_f32_16x16x32_bf16(a0, bv2, accv[0][i], 0, 0, 0); accv[1][i] = __builtin_amdgcn_mfma_f32_16x16x32_bf16(a1, bv2, accv[1][i], 0, 0, 0); } }
        f32x4 gk[6];
#pragma unroll
        for (int i = 0; i < 6; ++i) gk[i] = *(const f32x4*)(p.mla_gkn + l * 96 + 16 * i + 4 * g);
#pragma unroll
        for (int r = 0; r < 2; ++r) { if (r == 1 && !two) break;
            const int rb = rb0 + r; const int t = 16 * rb + fr; const int pos = row_pos(r0 + t);
            const f32x4 rc0 = *(const f32x4*)(ROPE + ((size_t)pos * 16 + 4 * g) * 2), rc1 = *(const f32x4*)(ROPE + ((size_t)pos * 16 + 4 * g) * 2 + 4);
            const float cs[4] = {rc0[0], rc0[2], rc1[0], rc1[2]}, sn[4] = {rc0[1], rc0[3], rc1[1], rc1[3]};
            const float rk = RS[t]; float ss = 0.f;
#pragma unroll
            for (int i = 0; i < 4; ++i) { acc[r][i] = acc[r][i] * rk; ss += (acc[r][i][0] * acc[r][i][0] + acc[r][i][1] * acc[r][i][1]) + (acc[r][i][2] * acc[r][i][2] + acc[r][i][3] * acc[r][i][3]); }
            const u32x2 k1w = *(const LAS u32x2*)(KR + t * 40 + 4 * g), k2w = *(const LAS u32x2*)(KR + t * 40 + 16 + 4 * g);
            f32x4 k1 = {bflo(k1w.x), bfhi(k1w.x), bflo(k1w.y), bfhi(k1w.y)}, k2 = {bflo(k2w.x), bfhi(k2w.x), bflo(k2w.y), bfhi(k2w.y)};
            ss += (k1[0] * k1[0] + k1[1] * k1[1]) + (k1[2] * k1[2] + k1[3] * k1[3]) + (k2[0] * k2[0] + k2[1] * k2[1]) + (k2[2] * k2[2] + k2[3] * k2[3]);
            ss += __shfl_xor(ss, 16); ss += __shfl_xor(ss, 32);
            const float rn = rsqrtf(ss * (1.f / 96.f) + EPS);
#pragma unroll
            for (int i = 0; i < 4; ++i) acc[r][i] = acc[r][i] * gk[i] * rn;
            k1 = k1 * gk[4] * rn; k2 = k2 * gk[5] * rn;
            f32x4 o1, o2;
#pragma unroll
            for (int j = 0; j < 4; ++j) { o1[j] = k1[j] * cs[j] - k2[j] * sn[j]; o2[j] = k1[j] * sn[j] + k2[j] * cs[j]; }
            bf16_t* dst = MK + (size_t)(r0 + t) * 384 + 96 * h + 4 * g;
#pragma unroll
            for (int i = 0; i < 4; ++i) { u32x2 w; w.x = cvtpk(acc[r][i][0], acc[r][i][1]); w.y = cvtpk(acc[r][i][2], acc[r][i][3]); *(u32x2*)(dst + 16 * i) = w; }
            { u32x2 w; w.x = cvtpk(o1[0], o1[1]); w.y = cvtpk(o1[2], o1[3]); *(u32x2*)(dst + 64) = w; w.x = cvtpk(o2[0], o2[1]); w.y = cvtpk(o2[2], o2[3]); *(u32x2*)(dst + 80) = w; }
            const float r0k = RS[16 * rb + 4 * g], r1k = RS[16 * rb + 4 * g + 1], r2k = RS[16 * rb + 4 * g + 2], r3k = RS[16 * rb + 4 * g + 3];
#pragma unroll
            for (int i = 0; i < 4; ++i) { u32x2 w; w.x = cvtpk(accv[r][i][0] * r0k, accv[r][i][1] * r1k); w.y = cvtpk(accv[r][i][2] * r2k, accv[r][i][3] * r3k);
                *(u32x2*)(MVT + (size_t)(64 * h + 16 * i + fr) * TM + r0 + 16 * rb + 8 * (g & 1) + 4 * (g >> 1)) = w; } }
      }
    }
    __syncthreads();
}

DI int crow(int r, int hi) { return (r & 3) + 8 * (r >> 2) + 4 * hi; }
template <int DK, bool FOX>
DI void attn_unit(LAS unsigned char* lds, const bf16_t* Qp, int qpitch, const bf16_t* Kp, int kpitch, const bf16_t* VT, const float* C, bf16_t* Yp, float* gss, int grp, int hslot, int b, int qb, int jt0) {
    TID_VARS; const int r32 = lane & 31, hi = lane >> 5;
    constexpr int KC = DK / 8, KP = DK + 8, NKS = DK / 16;
    constexpr int KB_BYTES = 64 * KP * 2, VB_BYTES = 64 * 72 * 2, BUF_BYTES = KB_BYTES + VB_BYTES + 256;
    const bool meta = qb < 0;
    const int q0 = meta ? MB0 : b * SEQ + 256 * qb;
    const int NT = meta ? 1 : 1 + 4 * (qb + 1);
    const int qrow = q0 + 32 * wave + r32;
    const bool wave_on = !meta || wave < 2;
    bf16x8 qf[NKS];
#pragma unroll
    for (int ks = 0; ks < NKS; ++ks) qf[ks] = *(const GAS bf16x8*)(Qp + (size_t)qrow * qpitch + 16 * ks + 8 * hi);
    float cq = 0.f; if (FOX) cq = C[qrow];
    bf16x8 bqx = {0, 0, 0, 0, 0, 0, 0, 0};
    if (FOX) { const unsigned h1 = cvtpk(cq, 0.f) & 0xffffu; const float r1 = cq - __uint_as_float(h1 << 16);
        const unsigned h2 = cvtpk(r1, 0.f) & 0xffffu; const float r2 = r1 - __uint_as_float(h2 << 16); const unsigned h3 = cvtpk(r2, 0.f) & 0xffffu;
        u32x4 bw = {0x3f803f80u, 0x3f80u | (h1 << 16), h2 | (h3 << 16), 0u};
        if (hi) bw = (u32x4){0u, 0u, 0u, 0u};
        bqx = __builtin_bit_cast(bf16x8, bw); }
    f32x16 o0 = {0.f, 0.f, 0.f, 0.f, 0.f, 0.f, 0.f, 0.f, 0.f, 0.f, 0.f, 0.f, 0.f, 0.f, 0.f, 0.f}, o1 = o0;
    float m = 0.f, lsum = 0.f;
    u32x4 kreg0, kreg1 = {0u, 0u, 0u, 0u}, vreg, creg = {0u, 0u, 0u, 0u};
#define AT_LOAD(jt_) do { const int tr_ = ((jt_) == 0) ? MB0 : b * SEQ + 64 * ((jt_) - 1); \
        kreg0 = *(const GAS u32x4*)(Kp + (size_t)(tr_ + tid / KC) * kpitch + 8 * (tid % KC)); \
        if (DK == 96 && tid < 256) kreg1 = *(const GAS u32x4*)(Kp + (size_t)(tr_ + (512 + tid) / KC) * kpitch + 8 * ((512 + tid) % KC)); \
        vreg = *(const GAS u32x4*)(VT + (size_t)(tid >> 3) * TM + tr_ + 8 * (tid & 7)); \
        if (FOX && tid < 16) creg = *(const GAS u32x4*)(C + tr_ + 4 * tid); } while (0)
#define AT_STORE(buf_) do { LAS unsigned char* bb_ = lds + (buf_) * BUF_BYTES; \
        *(LAS u32x4*)(bb_ + ((tid / KC) * KP + 8 * (tid % KC)) * 2) = kreg0; \
        if (DK == 96 && tid < 256) *(LAS u32x4*)(bb_ + (((512 + tid) / KC) * KP + 8 * ((512 + tid) % KC)) * 2) = kreg1; \
        *(LAS u32x4*)(bb_ + KB_BYTES + ((tid >> 3) * 72 + 8 * (tid & 7)) * 2) = vreg; \
        if (FOX && tid < 16) *(LAS u32x4*)(bb_ + KB_BYTES + VB_BYTES + 16 * tid) = creg; } while (0)
#define AT_LOADX(K0, K1, V, CR, jt_) do { const int tr_ = ((jt_) == 0) ? MB0 : b * SEQ + 64 * ((jt_) - 1); \
        K0 = *(const GAS u32x4*)(Kp + (size_t)(tr_ + tid / KC) * kpitch + 8 * (tid % KC)); \
        if (DK == 96 && tid < 256) K1 = *(const GAS u32x4*)(Kp + (size_t)(tr_ + (512 + tid) / KC) * kpitch + 8 * ((512 + tid) % KC)); \
        V = *(const GAS u32x4*)(VT + (size_t)(tid >> 3) * TM + tr_ + 8 * (tid & 7)); \
        if (FOX && tid < 16) CR = *(const GAS u32x4*)(C + tr_ + 4 * tid); } while (0)
#define AT_STOREX(K0, K1, V, CR, buf_) do { LAS unsigned char* bb_ = lds + (buf_) * BUF_BYTES; \
        *(LAS u32x4*)(bb_ + ((tid / KC) * KP + 8 * (tid % KC)) * 2) = K0; \
        if (DK == 96 && tid < 256) *(LAS u32x4*)(bb_ + (((512 + tid) / KC) * KP + 8 * ((512 + tid) % KC)) * 2) = K1; \
        *(LAS u32x4*)(bb_ + KB_BYTES + ((tid >> 3) * 72 + 8 * (tid & 7)) * 2) = V; \
        if (FOX && tid < 16) *(LAS u32x4*)(bb_ + KB_BYTES + VB_BYTES + 16 * tid) = CR; } while (0)
#define AT_COMPUTE(jt) do { \
        bool vis = wave_on, elem = false; const int jr = jt - 1; const int qlo = 256 * qb + 32 * wave; \
        if (jt > 0) { if (FOX) { if (64 * jr > qlo + 31) vis = false; else elem = (64 * jr + 63 > qlo); } else { if (jr > (qlo >> 6)) vis = false; } } \
        if (vis) { \
            const LAS unsigned char* bb = lds + (jt & 1) * BUF_BYTES; \
 \
            f32x16 s0 = {0.f, 0.f, 0.f, 0.f, 0.f, 0.f, 0.f, 0.f, 0.f, 0.f, 0.f, 0.f, 0.f, 0.f, 0.f, 0.f}, s1 = s0; \
_Pragma("unroll") \
            for (int ks = 0; ks < NKS; ++ks) { const bf16x8 a0 = *(const LAS bf16x8*)(bb + (r32 * KP + 16 * ks + 8 * hi) * 2), a1 = *(const LAS bf16x8*)(bb + ((32 + r32) * KP + 16 * ks + 8 * hi) * 2); \
                s0 = __builtin_amdgcn_mfma_f32_32x32x16_bf16(a0, qf[ks], s0, 0, 0, 0); s1 = __builtin_amdgcn_mfma_f32_32x32x16_bf16(a1, qf[ks], s1, 0, 0, 0); } \
            if (FOX) { \
                const LAS float* cb = (const LAS float*)(bb + KB_BYTES + VB_BYTES); \
_Pragma("unroll") \
                for (int kb = 0; kb < 2; ++kb) { const float cv = -cb[32 * kb + r32]; \
                    const unsigned h1 = cvtpk(cv, 0.f) & 0xffffu; const float r1 = cv - __uint_as_float(h1 << 16); \
                    const unsigned h2 = cvtpk(r1, 0.f) & 0xffffu; const float r2 = r1 - __uint_as_float(h2 << 16); \
                    const unsigned h3 = cvtpk(r2, 0.f) & 0xffffu; \
                    u32x4 aw = {h1 | (h2 << 16), h3 | 0x3f800000u, 0x3f803f80u, 0u}; \
                    if (hi) aw = (u32x4){0u, 0u, 0u, 0u}; \
                    const bf16x8 ax = __builtin_bit_cast(bf16x8, aw); \
                    if (kb == 0) s0 = __builtin_amdgcn_mfma_f32_32x32x16_bf16(ax, bqx, s0, 0, 0, 0); else s1 = __builtin_amdgcn_mfma_f32_32x32x16_bf16(ax, bqx, s1, 0, 0, 0); } } \
            if (__any(m != 0.f)) { \
_Pragma("unroll") \
                for (int r = 0; r < 16; ++r) { s0[r] -= m; s1[r] -= m; } } \
            if (jt == 0 || elem) { \
_Pragma("unroll") \
                for (int r = 0; r < 16; ++r) { const int k0 = crow(r, hi), k1 = 32 + k0; bool ok0, ok1; \
                    if (jt == 0) { ok0 = false; ok1 = k1 >= 48; if (FOX && meta) ok1 = ok1 && (k1 <= 32 * wave + r32); } \
                    else { ok0 = (64 * jr + k0 <= qlo + r32); ok1 = (64 * jr + k1 <= qlo + r32); } \
                    s0[r] = ok0 ? s0[r] : -INFINITY; s1[r] = ok1 ? s1[r] : -INFINITY; } \
            } \
            float ta = __builtin_fmaxf(__builtin_fmaxf(s0[0], s0[1]), s1[0]), tb = __builtin_fmaxf(__builtin_fmaxf(s0[2], s0[3]), s1[1]); ta = __builtin_fmaxf(__builtin_fmaxf(ta, s1[2]), s1[3]); \
_Pragma("unroll") \
            for (int r = 4; r < 16; r += 4) { ta = __builtin_fmaxf(__builtin_fmaxf(ta, s0[r]), s0[r + 1]); tb = __builtin_fmaxf(__builtin_fmaxf(tb, s0[r + 2]), s0[r + 3]); ta = __builtin_fmaxf(__builtin_fmaxf(ta, s1[r]), s1[r + 1]); tb = __builtin_fmaxf(__builtin_fmaxf(tb, s1[r + 2]), s1[r + 3]); } \
            const float tmax = swap_other(__builtin_fmaxf(ta, tb), true); \
            if (__any(tmax > 8.f)) { \
                const float dl = tmax > 8.f ? tmax : 0.f; m += dl; const float al = __builtin_amdgcn_exp2f(-dl); lsum *= al; \
_Pragma("unroll") \
                for (int r = 0; r < 16; ++r) { s0[r] -= dl; s1[r] -= dl; o0[r] *= al; o1[r] *= al; } } \
            float ps0 = 0.f, ps1 = 0.f; \
_Pragma("unroll") \
            for (int r = 0; r < 16; ++r) { s0[r] = __builtin_amdgcn_exp2f(s0[r]); s1[r] = __builtin_amdgcn_exp2f(s1[r]); ps0 += s0[r]; ps1 += s1[r]; } \
            lsum += ps0 + ps1; \
            const LAS unsigned char* vb = bb + KB_BYTES; \
_Pragma("unroll") \
            for (int kb = 0; kb < 2; ++kb) \
_Pragma("unroll") \
                for (int hf = 0; hf < 2; ++hf) { u32x4 pw; \
                    if (kb == 0) { pw.x = cvtpk(s0[8 * hf + 0], s0[8 * hf + 1]); pw.y = cvtpk(s0[8 * hf + 2], s0[8 * hf + 3]); pw.z = cvtpk(s0[8 * hf + 4], s0[8 * hf + 5]); pw.w = cvtpk(s0[8 * hf + 6], s0[8 * hf + 7]); } \
                    else { pw.x = cvtpk(s1[8 * hf + 0], s1[8 * hf + 1]); pw.y = cvtpk(s1[8 * hf + 2], s1[8 * hf + 3]); pw.z = cvtpk(s1[8 * hf + 4], s1[8 * hf + 5]); pw.w = cvtpk(s1[8 * hf + 6], s1[8 * hf + 7]); } \
                    const bf16x8 pb = __builtin_bit_cast(bf16x8, pw); \
                    const bf16x8 v0 = *(const LAS bf16x8*)(vb + (r32 * 72 + 32 * kb + 16 * hf + 8 * hi) * 2), v1 = *(const LAS bf16x8*)(vb + ((32 + r32) * 72 + 32 * kb + 16 * hf + 8 * hi) * 2); \
                    o0 = __builtin_amdgcn_mfma_f32_32x32x16_bf16(v0, pb, o0, 0, 0, 0); o1 = __builtin_amdgcn_mfma_f32_32x32x16_bf16(v1, pb, o1, 0, 0, 0); } \
        } \
    } while (0)
    u32x4 kB0 = kreg0, kB1 = kreg1, vB = vreg, cB = creg;
    AT_LOADX(kreg0, kreg1, vreg, creg, jt0); AT_STOREX(kreg0, kreg1, vreg, creg, 0); if (jt0 + 1 < NT) AT_LOADX(kreg0, kreg1, vreg, creg, jt0 + 1);
    __syncthreads();
    for (int jt = jt0; jt < NT; jt += 2) {
        if (jt + 2 < NT) AT_LOADX(kB0, kB1, vB, cB, jt + 2);
        AT_COMPUTE(jt);
        if (jt + 1 < NT) AT_STOREX(kreg0, kreg1, vreg, creg, (jt + 1) & 1);
        __syncthreads();
        if (jt + 1 >= NT) break;
        if (jt + 3 < NT) AT_LOADX(kreg0, kreg1, vreg, creg, jt + 3);
        { const int j1 = jt + 1; AT_COMPUTE(j1); }
        if (jt + 2 < NT) AT_STOREX(kB0, kB1, vB, cB, (jt + 2) & 1);
        __syncthreads();
    }
#undef AT_LOADX
#undef AT_STOREX
#undef AT_COMPUTE
#undef AT_LOAD
#undef AT_STORE
    if (wave_on) {
        const float lt = swap_other(lsum, false); const float inv = lt > 0.f ? 1.f / lt : 0.f;
        const bool valid = !meta || (32 * wave + r32 >= META_OFF);
        float sq = 0.f; bf16_t* yrow = Yp + (size_t)qrow * D;
#pragma unroll
        for (int db = 0; db < 2; ++db)
#pragma unroll
            for (int i = 0; i < 4; ++i) { float y0, y1, y2, y3;
                if (db == 0) { y0 = o0[4 * i] * inv; y1 = o0[4 * i + 1] * inv; y2 = o0[4 * i + 2] * inv; y3 = o0[4 * i + 3] * inv; } else { y0 = o1[4 * i] * inv; y1 = o1[4 * i + 1] * inv; y2 = o1[4 * i + 2] * inv; y3 = o1[4 * i + 3] * inv; }
                u32x2 w; w.x = cvtpk(y0, y1); w.y = cvtpk(y2, y3);
                if (valid) *(u32x2*)(yrow + 32 * db + 8 * i + 4 * hi) = w;
                const float z0 = bflo(w.x), z1 = bfhi(w.x), z2 = bflo(w.y), z3 = bfhi(w.y); sq += (z0 * z0 + z1 * z1) + (z2 * z2 + z3 * z3); }
        sq = swap_other(sq, false);
        if (hi == 0 && valid) gss[(size_t)qrow * 16 + 4 * grp + hslot] = sq;
    }
}
DI void attn_dispatch(const Params& p, const Frame& F, int mixer, int b, int h, int qb, float* gss) {
    bf16_t* Y = (bf16_t*)(p.ws + WS_BUFB);
    if (mixer == 0) { const bf16_t* MQ = (const bf16_t*)(p.ws + WS_ATT + AT_MQ) + 96 * h; const bf16_t* MK = (const bf16_t*)(p.ws + WS_ATT + AT_MK) + 96 * h; const bf16_t* MVT = (const bf16_t*)(p.ws + WS_ATT + AT_MVT) + (size_t)64 * h * TM;
        attn_unit<96, false>(F.lds, MQ, 384, MK, 384, MVT, nullptr, Y + Y_MLA + 64 * h, gss, 2, h, b, qb, 0); }
    else { const bf16_t* Z = (const bf16_t*)(p.ws + WS_Z); const bf16_t* FVT = (const bf16_t*)(p.ws + WS_ATT + AT_FVT) + (size_t)64 * h * TM; const float* FC = (const float*)(p.ws + WS_LRU + LRU_FC) + (size_t)h * TM;
        const int jt0 = qb < 0 ? 0 : __builtin_amdgcn_readfirstlane(((const int*)(p.ws + WS_LRU + LRU_FJ0))[(h * NB + b) * 32 + qb]);
        attn_unit<64, true>(F.lds, Z + ZC_FQ + 64 * h, ZC, Z + ZC_FK + 64 * h, ZC, FVT, FC, Y + Y_FOX + 64 * h, gss, 3, h, b, qb, jt0); }
}

__global__ void __launch_bounds__(512, 2) hymba_fwd(Params p) {
    extern __shared__ __attribute__((aligned(16))) unsigned char lds_raw[];
    Frame F; F.lds = (LAS unsigned char*)lds_raw;
    F.G = gridDim.x; { const int bx = blockIdx.x; F.vcu = (F.G % 8 == 0) ? (bx % 8) * (F.G / 8) + bx / 8 : bx; }
    volatile LAS unsigned* MISC = (volatile LAS unsigned*)(F.lds + MISC_OFF);
    { const int t0 = threadIdx.x; if (t0 < 64) MISC[t0] = 0u;
      if ((t0 & 63) == 0) *(volatile LAS int*)(unsigned)(TIDTAB_LDS + 4 * (int)(__builtin_amdgcn_s_getreg((5 << 11) | 4) & 63u)) = t0 >> 6; }
    __syncthreads();
    unsigned* ctl = (unsigned*)(p.ws + WS_CTL);
    XcdBarrier bar = xcd_barrier_post(ctl + CW_BAR, MISC + 8);
    LAS float* gstab = (LAS float*)(F.lds + GST_OFF);
#define PHASE_PARAMS Params pp = p; Frame FF = F; int bid = blockIdx.x; { unsigned char* w_ = p.ws; asm volatile("" : "+s"(w_), "+s"(FF.vcu), "+s"(FF.G), "+s"(bid)); pp.ws = w_; } (void)pp; (void)bid
#define ssb ((float*)(pp.ws + WS_CTL) + CW_SS)
#define ss_in0 ((float*)(pp.ws + WS_WSM + 786432))
#define gssb ((float*)(pp.ws + WS_GSP))
#define ssp0 ((float*)(pp.ws + WS_SSP))
#define ssp1 ((float*)(pp.ws + WS_SSP) + (size_t)NR * 16)
#define hmeta2 ((float*)(pp.ws + WS_HMETA) + 16 * D)
#define bufA ((bf16_t*)(pp.ws + WS_BUFA))
#define bufB ((bf16_t*)(pp.ws + WS_BUFB))
#define Zb ((bf16_t*)(pp.ws + WS_Z))
#define hmeta ((float*)(pp.ws + WS_HMETA))

    { PHASE_PARAMS; p0_prologue(pp, FF, ss_in0); }
    xcd_barrier(bar);

    for (int l = 0; l < NLAYER; ++l) {
#define ss1 ((l == 0) ? ss_in0 : ssb + TM)
#define gss (gssb + (size_t)l * TM * 16)
        { PHASE_PARAMS; SchedPlain S{(const char*)bufA, (const char*)(pp.ws + WS_WIN + (size_t)l * ZC * D * 2), D, D, l == 0 ? 129 : 128, 11, FF.G, bid};
          { TID_VARS; fill_rs_table(S, l == 0 ? ss_in0 : ssp1, l == 0 ? 1 : 16, gstab, tid); }
          EpiZ E{Zb};
          pg8::gemm_phase<EpiZ, SchedPlain, false, false>(FF.lds, D, D, S, E, gstab);
          if (l == 0) { const int B = FF.G >> 3, U8 = (129 * 11 + 7) >> 3, last = ((U8 + B - 1) / B - 1) * B;
              int rank = 0, nidle = 0, mine = 0;
              for (int x = 0; x < 8; ++x) { int a = S.xcnt(x) - last; a = a < 0 ? 0 : (a > B ? B : a); if (x < (bid & 7)) rank += B - a; if (x == (bid & 7)) mine = a; nidle += B - a; }
              if ((bid >> 3) >= mine) { TID_VARS; convert_weights(pp, (LAS float*)(FF.lds + wave * 16384), CV_I_IN, CV_NITEMS, (rank + (bid >> 3) - mine) * 8 + wave, nidle * 8, lane); } }
          if (l == 1) { TID_VARS; const int fr = lane & 15, g = lane >> 4; LAS float* rsm = (LAS float*)(FF.lds + 8192);
              if (FF.vcu < ZC / 16) meta_rs(rsm, hmeta2, tid);
              for (int u = FF.vcu; u < ZC / 16; u += FF.G) { const f32x4 a = skinny_block(FF.lds, bufA + (size_t)MROW0 * D, D, (const bf16_t*)(pp.ws + WS_WIN + (size_t)ZC * D * 2), D, 16 * u, 128, 1.f, tid);
                  if (wave == 0) { const float rs = rsm[fr]; u32x2 w; w.x = cvtpk(a[0] * rs, a[1] * rs); w.y = cvtpk(a[2] * rs, a[3] * rs); *(u32x2*)(Zb + (size_t)(MROW0 + fr) * ZC + 16 * u + 4 * g) = w; } } }
        }
        xcd_barrier(bar);
        { PHASE_PARAMS; const int NU = NB * NSEG + 1;
          for (int u = bid; u < NU; u += FF.G) {
              if (u < NB * NSEG) { const int b = u / NSEG, s = u % NSEG; const int r0 = b * SEQ + 64 * s; lru_local_unit<64>(pp, FF, l, r0, s == 0 ? MB0 + 61 : r0 - 3, u); }
              else lru_local_unit<16>(pp, FF, l, MROW0, MB0 + 45, NB * NSEG);
          }
          for (int u = bid; u < 5 * 256; u += FF.G) { const int mx = u >> 8, r0 = 128 * (u & 255);
              if (mx < 4) mla_prep_unit(pp, FF, l, r0, 128, mx >> 1, mx & 1); else fox_prep_unit<128>(pp, FF, l, r0); }
          { const int mx = FF.G - 1 - bid; if (mx < 4) mla_prep_unit(pp, FF, l, MROW0, 16, mx >> 1, mx & 1); else if (mx == 4) fox_prep_unit<16>(pp, FF, l, MROW0); }
          { TID_VARS; const int gt = FF.vcu * 512 + tid, NTH = FF.G * 512;
            for (int i = gt; i < 2 * 256 * 6; i += NTH) { const int c = i % 6, hd = (i / 6) & 255, arr = i / (6 * 256);
                *(u32x4*)((bf16_t*)(pp.ws + WS_ATT + (arr ? AT_FVT : AT_MVT)) + (size_t)hd * TM + MB0 + 8 * c) = zero4(); } }
          { TID_VARS; const int NW = NB * 4 * NSEG + 4;
            for (int wu = (FF.vcu * 8 + wave); wu < NW; wu += FF.G * 8) {
                if (wu < NB * 4 * NSEG) { const int bh = wu / NSEG, sg = wu % NSEG; hg_local_wave(pp, FF.lds + wave * HG_WL, l, (bh >> 2) * SEQ + 64 * sg, 64, bh & 3, wu, lane); }
                else hg_local_wave(pp, FF.lds + wave * HG_WL, l, MROW0, 16, wu - NB * 4 * NSEG, wu, lane);
            } }
        }
        xcd_barrier(bar);
        { PHASE_PARAMS; TID_VARS; const int bx = FF.G - 1 - bid;
          if (bx < 2) { const int i = bx * 512 + tid; lru_carry(pp, i >> 8, i & 255); }
          for (int u = bid; u < 128; u += FF.G) hg_carry_block(pp, FF.lds, u >> 3, u & 7, tid);
          for (int u = bid - 128; u >= 0 && u < 16; u += FF.G) fox_cscan_block(pp, FF.lds, l, u >> 2, u & 3, tid); }
        xcd_barrier(bar);
        { PHASE_PARAMS;
          for (int u = bid; u < NB * NSEG + 1; u += FF.G) {
              if (u < NB * NSEG) { const int b = u / NSEG, sg = u % NSEG; lru_fix_unit<64>(pp, FF, l, b * SEQ + 64 * sg, u, false, gss); }
              else lru_fix_unit<16>(pp, FF, l, MROW0, NB * NSEG, true, gss);
          }
          { TID_VARS; const int NW = NB * 4 * NSEG + 4;
            for (int wu = (FF.vcu * 8 + wave); wu < NW; wu += FF.G * 8) {
                if (wu < NB * 4 * NSEG) { const int bh = wu / NSEG, sg = wu % NSEG; hg_fix_wave(pp, (bh >> 2) * SEQ + 64 * sg, 64, bh & 3, wu, false, gss, lane); }
                else hg_fix_wave(pp, MROW0, 16, wu - NB * 4 * NSEG, wu, true, gss, lane);
            } }
          __syncthreads();
          for (int u = FF.vcu; u < 1024; u += FF.G) { const int mx = u >> 9, i = u & 511, bh = (i & 255) >> 4, sidx = i & 15, qb = (i >> 8) ? 31 - sidx : sidx;
              attn_dispatch(pp, FF, mx, bh >> 2, bh & 3, qb, gss); }
          if (FF.vcu < 8) attn_dispatch(pp, FF, FF.vcu >> 2, 0, FF.vcu & 3, -1, gss);
        }
        xcd_barrier(bar);
        { PHASE_PARAMS; SchedPlain S{(const char*)bufB, (const char*)(pp.ws + WS_WOUT + (size_t)l * D * D * 2), D, D, 128, 4, FF.G, bid};
          { TID_VARS; Unit u; for (int i = 0; i < 4 && S.next(i, u); ++i) { if (tid < 256) { const int row = u.pm * 256 + tid; const f32x4* gq = (const f32x4*)(gss + (size_t)row * 16); float gsum[4];
#pragma unroll
                    for (int q = 0; q < 4; ++q) { const f32x4 v = gq[q]; gsum[q] = (v[0] + v[1]) + (v[2] + v[3]); }
                    const float r0 = rsqrtf(gsum[0] * (1.f / 256.f) + EPS), r1 = rsqrtf(gsum[1] * (1.f / 256.f) + EPS), r2 = rsqrtf(gsum[2] * (1.f / 256.f) + EPS), r3 = rsqrtf(gsum[3] * (1.f / 256.f) + EPS);
                    *(LAS f32x4*)(gstab + (i * 256 + tid) * 4) = (f32x4){r0 / r1, r1 / r2, r2 / r3, r3}; } }
            __syncthreads(); }
#ifdef FFN_GU_FP8
          EpiRes E{bufA, l == 0 ? ssp0 : nullptr, 1, (unsigned char*)(pp.ws + WS_H8), 1.f};
#else
          EpiRes E{bufA, l == 0 ? ssp0 : nullptr, 1, l == 0 ? nullptr : (unsigned char*)(pp.ws + WS_H8), 1.f};
#endif
          pg8::gemm_phase<EpiRes, SchedPlain, false, true>(FF.lds, D, D, S, E, gstab);
          if (l == 0) { TID_VARS; LAS float* scr = (LAS float*)(FF.lds + 16384 + wave * 8704); const int gw = FF.vcu * 8 + wave, NGW = FF.G * 8;
              constexpr int I_G = 88 * 16, I_D = 32 * 44;
#ifdef FFN_GU_FP8
              for (int it = gw; it < 2 * I_G + I_D; it += NGW) { int r = it;
#else
              for (int it = gw + 2 * I_G; it < 2 * I_G + I_D; it += NGW) { int r = it;
#endif
                  if (r < 2 * I_G) { const int up = r / I_G; r %= I_G; const int sb = r / 16, kb = r % 16;
                      wt_item8(up ? pp.ffn_w_up : pp.ffn_w_gate, DFF, 32 * sb, pp.norm2_g, W8_SCALE, (unsigned char*)(pp.ws + WS_FGU8), D, 256 * (sb >> 2) + 128 * up + 32 * (sb & 3), 64 * kb, scr, lane); }
                  else { r -= 2 * I_G; const int sb = r / 44, kb = r % 44; wt_item8(pp.ffn_w_down, D, 32 * sb, nullptr, W8_SCALE, (unsigned char*)(pp.ws + WS_FD8), DFF, 32 * sb, 64 * kb, scr, lane); } }
              __syncthreads(); }
          if (l == 0) { TID_VARS; const int fr = lane & 15, g = lane >> 4;
              for (int u = FF.vcu; u < 64; u += FF.G) { const size_t row = (size_t)(MROW0 + fr);
                  const f32x4 gv = *(const f32x4*)(gss + row * 16 + 4 * (wave >> 1)); const float sc = rsqrtf(((gv[0] + gv[1]) + (gv[2] + gv[3])) * (1.f / 256.f) + EPS);
                  const f32x4 o = skinny_block(FF.lds, bufB + (size_t)MROW0 * D, D, (const bf16_t*)(pp.ws + WS_WOUT), D, 16 * u, 128, sc, tid);
                  if (wave == 0) { const f32x4 hn = *(const f32x4*)(pp.meta + (size_t)fr * D + 16 * u + 4 * g) + o; *(f32x4*)(hmeta + (size_t)fr * D + 16 * u + 4 * g) = hn;
                      u32x2 w; w.x = cvtpk(hn[0], hn[1]); w.y = cvtpk(hn[2], hn[3]); *(u32x2*)(bufA + row * D + 16 * u + 4 * g) = w; } } }
        }
        xcd_barrier(bar);
        if (l == 0) {
#ifdef FFN_GU_FP8
            { PHASE_PARAMS; SchedPlain S{(const char*)(pp.ws + WS_H8), (const char*)(pp.ws + WS_FGU8), 512, 512, 128, 22, FF.G, bid};
              { TID_VARS; fill_rs_table(S, ssp0, 16, gstab, tid); }
              EpiGU8 E{(unsigned char*)Zb, DFF, 1.f / W8_SCALE};
              pg8::gemm_phase<EpiGU8, SchedPlain, false, false, true>(FF.lds, 512, 512, S, E, gstab);
#else
            { PHASE_PARAMS; SchedPlain S{(const char*)bufA, (const char*)(pp.ws + WS_WGU), D, D, 128, 22, FF.G, bid};
              { TID_VARS; fill_rs_table(S, ssp0, 16, gstab, tid); }
              EpiGU8 E{(unsigned char*)Zb, DFF, 1.f};
              pg8::gemm_phase<EpiGU8, SchedPlain, false, false, false>(FF.lds, D, D, S, E, gstab);
#endif
              { TID_VARS; const int fr = lane & 15, g = lane >> 4; LAS float* rsm = (LAS float*)(FF.lds + 8192);
                if (FF.vcu < DFF / 16) meta_rs(rsm, hmeta, tid);
                for (int u = FF.vcu; u < DFF / 16; u += FF.G) { const int c0 = 16 * u, tj = c0 >> 7, wi = c0 & 127;
                    const f32x4 ag = skinny_block(FF.lds, bufA + (size_t)MROW0 * D, D, (const bf16_t*)(pp.ws + WS_WGU), D, 256 * tj + wi, 128, 1.f, tid);
                    const f32x4 au = skinny_block(FF.lds, bufA + (size_t)MROW0 * D, D, (const bf16_t*)(pp.ws + WS_WGU), D, 256 * tj + 128 + wi, 128, 1.f, tid);
                    if (wave == 0) { const float rs = rsm[fr]; float a[4];
#pragma unroll
                        for (int j = 0; j < 4; ++j) { const float gg = ag[j] * rs, uu = au[j] * rs; a[j] = gg * uu * __builtin_amdgcn_rcpf(1.f + __expf(-gg)); }
                        u32x2 w; w.x = cvtpk(a[0], a[1]); w.y = cvtpk(a[2], a[3]); *(u32x2*)(Zb + (size_t)(MROW0 + fr) * DFF + c0 + 4 * g) = w; } } }
            }
            xcd_barrier(bar);
            { PHASE_PARAMS; SchedPlain S{(const char*)Zb, (const char*)(pp.ws + WS_FD8), DFF / 2, DFF / 2, 128, 4, FF.G, bid};
              EpiRes E{bufA, ssp1, 0, nullptr, 1.f / (W8_SCALE * ACT8_SCALE)};
              pg8::gemm_phase<EpiRes, SchedPlain, false, false, true>(FF.lds, DFF / 2, DFF / 2, S, E, gstab);
              { TID_VARS; const int fr = lane & 15, g = lane >> 4;
                for (int u = FF.vcu; u < 64; u += FF.G) {
                    const f32x4 o = skinny_block(FF.lds, Zb + (size_t)MROW0 * DFF, DFF, (const bf16_t*)(pp.ws + WS_WD), DFF, 16 * u, 352, 1.f, tid);
                    if (wave == 0) { const f32x4 hn = *(const f32x4*)(hmeta + (size_t)fr * D + 16 * u + 4 * g) + o; *(f32x4*)(hmeta2 + (size_t)fr * D + 16 * u + 4 * g) = hn;
                        u32x2 w; w.x = cvtpk(hn[0], hn[1]); w.y = cvtpk(hn[2], hn[3]); *(u32x2*)(bufA + (size_t)(MROW0 + fr) * D + 16 * u + 4 * g) = w; } } }
            }
            xcd_barrier(bar);
        }
    }
#if STAGE >= 2
#define mlist ((int*)(pp.ws + WS_CTL + CTL_LIST))
#define mlrs ((float*)(pp.ws + WS_CTL + CTL_LRS))
#define mlgate ((float*)(pp.ws + WS_CTL + CTL_LGATE))
#define mcnt ((unsigned*)(pp.ws + WS_CTL) + CW_MCNT)
    { PHASE_PARAMS; TID_VARS;
      LAS float* WR = (LAS float*)FF.lds;
      LAS int* ph = (LAS int*)(FF.lds + 32768);
      for (int i = tid; i < 1024 * 8; i += 512) WR[i] = pp.moe_w_router[i] * pp.norm2_g[D + (i >> 3)];
      for (int u = bid; u < NR / 128; u += FF.G) {
          if (tid < 64) ph[tid] = 0;
          __syncthreads();
          {
              const int t16 = lane & 15, kq = lane >> 4, tl = wave * 16 + t16, tok = u * 128 + tl;
              float ss = 0.f, lg[8];
#pragma unroll
              for (int e = 0; e < 8; ++e) lg[e] = 0.f;
              const bf16_t* hrow = bufA + (size_t)tok * D + 256 * kq;
#pragma unroll 4
              for (int c = 0; c < 32; ++c) { const u32x4 hw = *(const u32x4*)(hrow + 8 * c); const float hv[8] = {bflo(hw.x), bfhi(hw.x), bflo(hw.y), bfhi(hw.y), bflo(hw.z), bfhi(hw.z), bflo(hw.w), bfhi(hw.w)};
#pragma unroll
                  for (int q = 0; q < 8; ++q) { const float hx = hv[q]; ss += hx * hx; const int k = 256 * kq + 8 * c + q; const f32x4 w0 = *(const LAS f32x4*)(WR + k * 8), w1 = *(const LAS f32x4*)(WR + k * 8 + 4);
                      lg[0] += hx * w0[0]; lg[1] += hx * w0[1]; lg[2] += hx * w0[2]; lg[3] += hx * w0[3]; lg[4] += hx * w1[0]; lg[5] += hx * w1[1]; lg[6] += hx * w1[2]; lg[7] += hx * w1[3]; } }
              ss += __shfl_xor(ss, 16); ss += __shfl_xor(ss, 32);
#pragma unroll
              for (int e = 0; e < 8; ++e) { lg[e] += __shfl_xor(lg[e], 16); lg[e] += __shfl_xor(lg[e], 32); }
              if (kq == 0) { const float rs = rsqrtf(ss * (1.f / 1024.f) + EPS);
                  int e1 = 0; float v1 = lg[0];
#pragma unroll
                  for (int e = 1; e < 8; ++e) if (lg[e] > v1) { v1 = lg[e]; e1 = e; }
                  int e2 = -1; float v2 = -INFINITY;
#pragma unroll
                  for (int e = 0; e < 8; ++e) if (e != e1 && lg[e] > v2) { v2 = lg[e]; e2 = e; }
                  const float g1 = 1.f / (1.f + __expf((v2 - v1) * rs)), g2 = 1.f - g1;
                  const int lo = e1 < e2 ? e1 : e2, hi = e1 < e2 ? e2 : e1; const float glo = e1 < e2 ? g1 : g2, ghi = e1 < e2 ? g2 : g1;
                  __hip_atomic_fetch_add(&ph[lo * 8 + hi], 1, __ATOMIC_RELAXED, __HIP_MEMORY_SCOPE_WORKGROUP);
                  *(f32x4*)(pp.ws + WS_TOKREC + (size_t)tok * 16) = (f32x4){__int_as_float(lo | (hi << 8)), glo, ghi, rs}; } }
          __syncthreads();
          if (tid < 64) ((int*)(pp.ws + WS_PAIRH))[u * 64 + tid] = ph[tid];
          __syncthreads();
      }
      { LAS float* scr = (LAS float*)(FF.lds + 49152 + wave * 8704);
        const int gw = FF.vcu * 8 + wave, NGW = FF.G * 8; constexpr int I_GU = 112 * 16, I_DN = 32 * 56, I_E = 2 * I_GU + I_DN;
#define MOE_ITEM(it_, W_, ldw_, c0_, g_, WT_, K8_, n0_, k0_) const float* W_; const float* g_; unsigned char* WT_; int ldw_, c0_, K8_, n0_, k0_; \
        { const int e = (it_) / I_E; int r = (it_) % I_E; \
          if (r < 2 * I_GU) { const int up = r / I_GU; r %= I_GU; const int sb = r / 16, kb = r % 16; \
              W_ = (up ? pp.moe_w_up : pp.moe_w_gate) + (size_t)e * D * DFE; ldw_ = DFE; c0_ = 32 * sb; g_ = pp.norm2_g + D; WT_ = (unsigned char*)(pp.ws + WS_MGU) + (size_t)e * 7168 * D; K8_ = D; n0_ = 256 * (sb >> 2) + 128 * up + 32 * (sb & 3); k0_ = 64 * kb; } \
          else { r -= 2 * I_GU; const int sb = r / 56, kb = r % 56; \
              W_ = pp.moe_w_down + (size_t)e * DFE * D; ldw_ = D; c0_ = 32 * sb; g_ = nullptr; WT_ = (unsigned char*)(pp.ws + WS_MD) + (size_t)e * D * DFE; K8_ = DFE; n0_ = 32 * sb; k0_ = 64 * kb; } }
        for (int it = gw; it < NEXP * I_E; it += 2 * NGW) { const int it2 = it + NGW; const bool two = it2 < NEXP * I_E;
            MOE_ITEM(it, Wa, lda_, ca, ga, Ta, Ka, na, ka); MOE_ITEM((two ? it2 : it), Wb, ldb_, cb, gb, Tb, Kb, nb, kb2);
            f32x4 va[8], vb[8]; wt_load8(Wa, lda_, ca, ka, lane, va); wt_load8(Wb, ldb_, cb, kb2, lane, vb);
            wt_finish8(va, ga, W8_SCALE, Ta, Ka, na, ka, scr, lane); if (two) wt_finish8(vb, gb, W8_SCALE, Tb, Kb, nb, kb2, scr, lane); }
#undef MOE_ITEM
      }
    }
    xcd_barrier(bar);
    { PHASE_PARAMS; TID_VARS;
      LAS int* part = (LAS int*)FF.lds;
      LAS int* Tt = part + 512;
      LAS int* Qt = Tt + 64;
      LAS int* pfx = Qt + 64;
      LAS int* typ = pfx + 64;
      LAS int* lc = typ + 128;
      LAS int* pq = lc + 32;
      LAS int* tmpq = pq + 32;
      const int* PH = (const int*)(pp.ws + WS_PAIRH);
      { const int p = tid & 63, ch = tid >> 6; int a = 0;
        for (int i = 0; i < 32; ++i) a += PH[(ch * 32 + i) * 64 + p];
        part[ch * 64 + p] = a; }
      __syncthreads();
      if (tid < 64) { int a = 0; for (int ch = 0; ch < 8; ++ch) a += part[ch * 64 + tid]; Tt[tid] = a; Qt[tid] = 0; }
      __syncthreads();
      if (tid == 0) {
          for (int e = 0; e < 8; ++e) { int c = 0; for (int lo = 0; lo < 8; ++lo) c += Tt[lo * 8 + e]; pq[e] = c; }
          int qh = 0, qt = 0, carry = 0;
          for (int e = 7; e >= 1; --e) { const int r = pq[e] & 255, need = (256 - r) & 255;
              if (r == 0) continue;
              if (carry >= need) { int rem = need; carry -= need;
                  while (rem > 0) { const int sx = pq[8 + qh], n = rem < pq[16 + qh] ? rem : pq[16 + qh]; Qt[e * 8 + sx] += n; pq[16 + qh] -= n; rem -= n; if (pq[16 + qh] == 0) ++qh; } }
              else { pq[8 + qt] = e; pq[16 + qt] = r; ++qt; carry += r; } }
          for (; qh < qt; ++qh) if (pq[16 + qh] > 0) Qt[pq[8 + qh]] += pq[16 + qh];
          bool ok = true; for (int p = 0; p < 64; ++p) ok = ok && (Qt[p] <= Tt[p]);
          if (!ok) for (int p = 0; p < 64; ++p) Qt[p] = 0; }
      __syncthreads();
      for (int u = bid; u < NR / 128; u += FF.G) {
          if (tid < 16) lc[tid] = 0;
          { const int p = tid & 63, g = tid >> 6, c0 = u >> 5, i0 = c0 * 32 + 4 * g; int a = 0;
#pragma unroll
            for (int i = 0; i < 4; ++i) { const int v = PH[(i0 + i < NR / 128 ? i0 + i : 0) * 64 + p]; a += (i0 + i < u) ? v : 0; }
            tmpq[g * 64 + p] = a; }
          __syncthreads();
          if (tid < 64) { int a = 0; const int c0 = u >> 5; for (int ch = 0; ch < c0; ++ch) a += part[ch * 64 + tid]; for (int g = 0; g < 8; ++g) a += tmpq[g * 64 + tid]; pfx[tid] = a; }
          f32x4 rec = {0.f, 0.f, 0.f, 0.f}; int lo = 0, hi = 0;
          if (tid < 128) { rec = *(const f32x4*)(pp.ws + WS_TOKREC + (size_t)(u * 128 + tid) * 16); const int pk = __float_as_int(rec[0]); lo = pk & 255; hi = pk >> 8; typ[tid] = lo * 8 + hi; }
          __syncthreads();
          int p0 = 0, p1 = 0, e0 = 0, e1 = 0; float g0 = 0.f, g1 = 0.f;
          if (tid < 128) { const int ty = lo * 8 + hi; int rk = pfx[ty];
              for (int j = 0; j < tid; j += 4) { const i32x4 t4 = *(const LAS i32x4*)(typ + j); rk += ((t4[0] == ty) ? 1 : 0) + ((j + 1 < tid && t4[1] == ty) ? 1 : 0) + ((j + 2 < tid && t4[2] == ty) ? 1 : 0) + ((j + 3 < tid && t4[3] == ty) ? 1 : 0); }
              const bool sw = rk < Qt[ty]; e0 = sw ? hi : lo; e1 = sw ? lo : hi; g0 = sw ? rec[2] : rec[1]; g1 = sw ? rec[1] : rec[2];
              p0 = __hip_atomic_fetch_add(&lc[e0], 1, __ATOMIC_RELAXED, __HIP_MEMORY_SCOPE_WORKGROUP); p1 = __hip_atomic_fetch_add(&lc[8 + e1], 1, __ATOMIC_RELAXED, __HIP_MEMORY_SCOPE_WORKGROUP); }
          __syncthreads();
          if (tid < 16) lc[16 + tid] = (int)atomicAdd(mcnt + tid, (unsigned)lc[tid]);
          __syncthreads();
          if (tid < 128) { const int tok = u * 128 + tid; const float rs = rec[3];
              const int i0 = e0 * 32768 + lc[16 + e0] + p0, i1 = (8 + e1) * 32768 + lc[16 + 8 + e1] + p1;
              mlist[i0] = tok; mlrs[i0] = rs; mlgate[i0] = g0; mlist[i1] = tok; mlrs[i1] = rs; mlgate[i1] = g1; }
          __syncthreads();
      }
    }
    xcd_barrier(bar);
    LAS int* tab0 = (LAS int*)(F.lds + GST_OFF);
    { PHASE_PARAMS; TID_VARS; __syncthreads();
      if (tid < 2) { const int ps = tid; LAS int* tb = tab0 + ps * 640; int t = 0;
          for (int e = 0; e < 8; ++e) { const int n = (int)__hip_atomic_load(mcnt + ps * 8 + e, __ATOMIC_RELAXED, __HIP_MEMORY_SCOPE_AGENT); for (int o = 0; o < n; o += 256) { tb[t * 4] = e; tb[t * 4 + 1] = o; tb[t * 4 + 2] = n; tb[t * 4 + 3] = 0; ++t; } }
          tab0[1280 + ps] = t; }
      __syncthreads();
      const int nT0 = tab0[1280], nT1 = tab0[1281];
      for (int it = FF.vcu * 8 + wave; it < (nT0 + nT1) * 32; it += FF.G * 8) { const int u = it >> 5, r0 = (it & 31) * 8, ps = u < nT0 ? 0 : 1, t = ps ? u - nT0 : u; const LAS int* tb = tab0 + ps * 640;
          const int e = tb[t * 4], off = tb[t * 4 + 1], n = tb[t * 4 + 2]; const int* lst = mlist + (ps * 8 + e) * 32768;
          unsigned char* dst = (unsigned char*)(pp.ws + WS_MAS) + ((size_t)(ps * 136 + t) * 256 + r0) * 1024; const unsigned char* src = (const unsigned char*)(pp.ws + WS_H8);
          int tk[8]; u32x4 v[8];
#pragma unroll
          for (int i = 0; i < 8; ++i) { const int idx = off + r0 + i; tk[i] = lst[idx < n ? idx : n - 1]; }
#pragma unroll
          for (int i = 0; i < 8; ++i) v[i] = *(const u32x4*)(src + (size_t)tk[i] * 1024 + 16 * lane);
#pragma unroll
          for (int i = 0; i < 8; ++i) { if (off + r0 + i >= n) v[i] = (u32x4){0u, 0u, 0u, 0u}; *(u32x4*)(dst + (size_t)i * 1024 + 16 * lane) = v[i]; } }
    }
    xcd_barrier(bar);
    {
        LAS int* tabA = tab0; LAS int* tabB = tab0 + 640;
        const int nT0 = __builtin_amdgcn_readfirstlane(tab0[1280]), nT1 = __builtin_amdgcn_readfirstlane(tab0[1281]);
        { PHASE_PARAMS; SchedMoe S{(const char*)(pp.ws + WS_MAS), (const char*)(pp.ws + WS_MGU), (size_t)7168 * D, 512, 512, nT0, 28, FF.G, bid, tabA, mlist, false, 0u, 0, 0};
          EpiMoeGU E{(unsigned char*)(pp.ws + WS_MACT), mlrs, tabA};
          { TID_VARS; fill_moe_rs_table(S, mlrs, gstab + 2048, tid); }
          pg8::gemm_phase<EpiMoeGU, SchedMoe, false, false, true>(FF.lds, 512, 512, S, E, gstab + 2048); }
        xcd_barrier(bar);
        { PHASE_PARAMS;
          { SchedMoe S{(const char*)(pp.ws + WS_MACT), (const char*)(pp.ws + WS_MD), (size_t)D * DFE, DFE / 2, DFE / 2, nT0, 4, FF.G, bid, tabA, mlist, false, 0u, 0, 0};
            EpiMoeDown E{pp.out, mlist, mlgate, tabA, bufA, false};
            pg8::gemm_phase<EpiMoeDown, SchedMoe, false, false, true>(FF.lds, DFE / 2, DFE / 2, S, E, gstab); }
          { const int ud8 = (nT0 * 4 + 7) >> 3, udx = nT0 * 4 - (bid & 7) * ud8, udc = udx < ud8 ? udx : ud8;
            const int nheavy = udc > 2 * (FF.G >> 3) ? udc - 2 * (FF.G >> 3) : 0;
            SchedMoe S{(const char*)(pp.ws + WS_MAS) + (size_t)136 * 256 * 1024, (const char*)(pp.ws + WS_MGU), (size_t)7168 * D, 512, 512, nT1, 28, FF.G, bid, tabB, mlist + 8 * 32768, false, 0u, nheavy, 2};
            EpiMoeGU E{(unsigned char*)(pp.ws + WS_MACT1), mlrs + 8 * 32768, tabB};
            { TID_VARS; fill_moe_rs_table(S, mlrs + 8 * 32768, gstab + 2048, tid); }
            pg8::gemm_phase<EpiMoeGU, SchedMoe, false, false, true>(FF.lds, 512, 512, S, E, gstab + 2048); } }
        xcd_barrier(bar);
        { PHASE_PARAMS; SchedMoe S{(const char*)(pp.ws + WS_MACT1), (const char*)(pp.ws + WS_MD), (size_t)D * DFE, DFE / 2, DFE / 2, nT1, 4, FF.G, bid, tabB, mlist + 8 * 32768, false, 0u, 0, 0};
          EpiMoeDown E{pp.out, mlist + 8 * 32768, mlgate + 8 * 32768, tabB, bufA, true};
          pg8::gemm_phase<EpiMoeDown, SchedMoe, false, false, true>(FF.lds, DFE / 2, DFE / 2, S, E, gstab); }
    }
#endif
}

extern "C" void kernel_launch(void* const* d_in, const int* in_sizes, int n_in, void* d_out, int out_size, void* d_ws, size_t ws_size, hipStream_t stream) {
    static int grid = 0;
    if (grid == 0) {
        if (n_in != 31 || out_size != NR * D || ws_size < WS_END) { fprintf(stderr, "kernel_launch: unexpected sizes n_in %d out %d ws %zu\n", n_in, out_size, ws_size); grid = -1; return; }
        int dev = 0, cus = 0, per_cu = 0;
        if (hipGetDevice(&dev) != hipSuccess || hipDeviceGetAttribute(&cus, hipDeviceAttributeMultiprocessorCount, dev) != hipSuccess) { grid = -1; return; }
        if (hipFuncSetAttribute((const void*)hymba_fwd, hipFuncAttributeMaxDynamicSharedMemorySize, LDS_BYTES) != hipSuccess) { fprintf(stderr, "kernel_launch: hipFuncSetAttribute failed\n"); grid = -1; return; }
        if (hipOccupancyMaxActiveBlocksPerMultiprocessor(&per_cu, (const void*)hymba_fwd, 512, LDS_BYTES) != hipSuccess || per_cu < 1) { fprintf(stderr, "kernel_launch: occupancy query says %d\n", per_cu); (void)hipGetLastError(); per_cu = 1; }
        grid = cus;
    }
    if (grid < 0) return;
    (void)hipMemsetAsync((char*)d_ws + WS_CTL, 0, CTL_BYTES, stream);
    Params p{};
    const float** pp = (const float**)&p;
    for (int i = 0; i < 31; ++i) pp[i] = (const float*)d_in[i];
    p.out = (float*)d_out; p.ws = (unsigned char*)d_ws;
    hipLaunchKernelGGL(hymba_fwd, dim3(grid), dim3(512), LDS_BYTES, stream, p);
}
```

```cpp
#include <hip/hip_runtime.h>
#include <cstdint>
#include <cstdio>

#define LAS __attribute__((address_space(3)))
#define GAS __attribute__((address_space(1)))
#define DI __device__ __forceinline__
typedef unsigned short bf16_t;
typedef short bf16x8 __attribute__((ext_vector_type(8)));
typedef short s16x4 __attribute__((ext_vector_type(4)));
typedef float f32x2 __attribute__((ext_vector_type(2)));
typedef int i32x4 __attribute__((ext_vector_type(4)));
typedef float f32x4 __attribute__((ext_vector_type(4)));
typedef float f32x16 __attribute__((ext_vector_type(16)));
typedef unsigned u32x2 __attribute__((ext_vector_type(2)));
typedef unsigned u32x4 __attribute__((ext_vector_type(4)));
typedef __bf16 bf16x2_t __attribute__((ext_vector_type(2)));

#ifndef STAGE
#define STAGE 2
#endif
#if STAGE >= 2
#define NLAYER 2
#else
#define NLAYER 1
#endif

constexpr int NB = 4, SEQ = 8192, D = 1024, NR = NB * SEQ;
constexpr int MB0 = NR, META_OFF = 48, NMETA = 16;
constexpr int MROW0 = MB0 + META_OFF;
constexpr int TM = NR + 256;
constexpr int ZC = 2816;
constexpr float EPS = 1e-6f;
constexpr int ZC_XA = 0, ZC_GA = 256, ZC_HQ = 512, ZC_HF = 768, ZC_HV = 1024, ZC_HG = 1280, ZC_CQ = 1536, ZC_CKV = 1792, ZC_KR = 1920, ZC_FF = 1952, ZC_FQ = 2048, ZC_FK = 2304, ZC_FV = 2560;
constexpr int Y_LRU = 0, Y_HG = 256, Y_MLA = 512, Y_FOX = 768;
constexpr int DFF = 2816, DFE = 3584, NEXP = 8;
constexpr int NSEG = 128;

constexpr size_t MiB = 1u << 20;
constexpr size_t WS_CTL = 0, CTL_BYTES = 8 * MiB;
constexpr size_t WS_WIN = 8 * MiB;
constexpr size_t WS_WOUT = 19 * MiB;
constexpr size_t WS_WGU = 23 * MiB;
constexpr size_t WS_WD = 34 * MiB;
constexpr size_t WS_WSM = 40 * MiB;
constexpr size_t WS_BUFA = 41 * MiB;
constexpr size_t WS_BUFB = 106 * MiB;
constexpr size_t WS_Z = 171 * MiB;
constexpr size_t WS_ATT = 349 * MiB;
constexpr size_t WS_LRU = 430 * MiB;
constexpr size_t WS_HG = 465 * MiB;
constexpr size_t WS_SSP = 499 * MiB;
constexpr size_t WS_GSP = 503 * MiB;
constexpr size_t WS_END = 508 * MiB;
constexpr size_t SM_LRUW = 0;
constexpr size_t SM_WUQ = 131072;
constexpr size_t SM_WUKV = 131072 + 294912;
constexpr size_t SM_ROPE = 131072 + 294912 + 262144;
constexpr int CW_BAR = 4096;
constexpr int CW_SS = 16384;
constexpr int CW_GSS = CW_SS + 3 * TM;
constexpr int CW_ENDW = CW_GSS + 2 * TM * 4;
static_assert((size_t)CW_ENDW * 4 <= CTL_BYTES, "ctl");
constexpr size_t LRU_LA = 0, LRU_BC = (size_t)TM * 256 * 2, LRU_AGGA = 2 * (size_t)TM * 256 * 2, LRU_AGGB = LRU_AGGA + (size_t)(NB * NSEG + 1) * 256 * 4, LRU_HIN = LRU_AGGB + (size_t)(NB * NSEG + 1) * 256 * 4;
static_assert(LRU_HIN + (size_t)(NB * NSEG + 1) * 256 * 4 <= 35 * MiB, "lru");
constexpr int HG_SLOTS = NB * 4 * NSEG + 4;
constexpr size_t HG_UT = 0, HG_DL = (size_t)HG_SLOTS * 4096 * 4;
static_assert(HG_DL + (size_t)HG_SLOTS * 64 * 4 <= 34 * MiB, "hg");
constexpr size_t AT_MQ = 0, AT_MK = (size_t)TM * 384 * 2, AT_MVT = 2 * (size_t)TM * 384 * 2, AT_FVT = AT_MVT + (size_t)256 * TM * 2, AT_END = AT_FVT + (size_t)256 * TM * 2;
static_assert(AT_END <= 81 * MiB, "att");
constexpr size_t LRU_FC = ((LRU_HIN + (size_t)(NB * NSEG + 1) * 256 * 4 + 255) / 256) * 256, LRU_FLF = LRU_FC + (size_t)4 * TM * 4;
constexpr size_t LRU_FJ0 = LRU_FLF + (size_t)4 * TM * 4;
static_assert(LRU_HIN + (size_t)(NB * NSEG + 1) * 256 * 4 <= LRU_FC && LRU_FJ0 + 4 * 4 * 32 * 4 <= 35 * MiB, "lru2");
constexpr size_t HG_ROPE = 33 * MiB - 256 * 1024;
static_assert(HG_DL + (size_t)HG_SLOTS * 64 * 4 <= HG_ROPE && HG_ROPE + (size_t)8208 * 16 * 8 <= 34 * MiB, "hg2");

constexpr size_t WS_MGU = 106 * MiB;
constexpr size_t WS_MD = 162 * MiB;
constexpr size_t WS_MACT = 190 * MiB;
static_assert(WS_MACT + (size_t)136 * 256 * DFE <= WS_LRU, "moe act");
constexpr size_t WS_MAS = 309 * MiB;
static_assert(WS_MAS + (size_t)2 * 136 * 256 * 1024 <= WS_LRU, "moe sorted A");
constexpr size_t WS_H8 = 377 * MiB;
static_assert(WS_MAS + (size_t)2 * 136 * 256 * 1024 <= WS_H8 && WS_H8 + (size_t)NR * 1024 <= WS_LRU, "h8");
constexpr size_t WS_FGU8 = 409 * MiB, WS_FD8 = 415 * MiB;
static_assert(WS_FD8 + (size_t)D * DFF <= WS_LRU, "ffn fp8");
constexpr size_t WS_MACT1 = 377 * MiB;
static_assert(WS_MACT1 + (size_t)136 * 256 * DFE <= WS_SSP, "moe act1");
constexpr float W8_SCALE = 256.f, ACT8_SCALE = 16.f;
constexpr size_t WS_TOKREC = 497 * MiB, WS_PAIRH = 498 * MiB;
constexpr size_t CTL_LIST = 2 * MiB, CTL_LRS = 4 * MiB, CTL_LGATE = 6 * MiB;
constexpr int CW_MCNT = CW_ENDW + 64;
constexpr size_t WS_HMETA = WS_GSP + 4456448;
static_assert(2 * (size_t)TM * 16 * 4 <= 4456448 && WS_HMETA + 2 * 16 * 1024 * 4 <= WS_END && (size_t)(CW_MCNT + 16) * 4 <= CTL_LIST, "misc");

constexpr int RING_BYTES = 131072;
constexpr int GST_OFF = RING_BYTES, GST_BYTES = 24576;
constexpr int MISC_OFF = GST_OFF + GST_BYTES;
constexpr int LDS_BYTES = MISC_OFF + 512;

DI unsigned cvtpk(float lo, float hi) { f32x2 v = {lo, hi}; bf16x2_t b = __builtin_convertvector(v, bf16x2_t); return __builtin_bit_cast(unsigned, b); }
DI bf16_t f2bf(float f) { return (bf16_t)(cvtpk(f, 0.f) & 0xffffu); }
DI float bf2f(bf16_t h) { return __uint_as_float(((unsigned)h) << 16); }
DI float bflo(unsigned w) { return __uint_as_float(w << 16); }
DI float bfhi(unsigned w) { return __uint_as_float(w & 0xffff0000u); }
DI float clamp8(float x) { return __builtin_amdgcn_fmed3f(x, -440.f, 440.f); }
DI unsigned pk4_fp8(float a, float b, float c, float d) { unsigned w = __builtin_amdgcn_cvt_pk_fp8_f32(clamp8(a), clamp8(b), 0u, false); return __builtin_amdgcn_cvt_pk_fp8_f32(clamp8(c), clamp8(d), w, true); }
DI u32x2 swiglu8_fp8(const f32x4 g0, const f32x4 g1, const f32x4 u0, const f32x4 u1, float rs) {
    const float rsu = rs * ACT8_SCALE; f32x2 a[4];
#pragma unroll
    for (int q = 0; q < 4; ++q) { const f32x4 gv = q < 2 ? g0 : g1, uv = q < 2 ? u0 : u1; const int o = 2 * (q & 1);
        const f32x2 g = (f32x2){gv[o], gv[o + 1]} * rs, u = (f32x2){uv[o], uv[o + 1]} * rsu, t = g * -1.4426950408889634f;
        const f32x2 d = (f32x2){__builtin_amdgcn_exp2f(t.x), __builtin_amdgcn_exp2f(t.y)} + 1.f;
        a[q] = (g * u) * (f32x2){__builtin_amdgcn_rcpf(d.x), __builtin_amdgcn_rcpf(d.y)}; }
    u32x2 w; w.x = pk4_fp8(a[0].x, a[0].y, a[1].x, a[1].y); w.y = pk4_fp8(a[2].x, a[2].y, a[3].x, a[3].y); return w;
}
DI u32x4 zero4() { unsigned z = 0u; asm volatile("" : "+v"(z)); return (u32x4){z, z, z, z}; }
DI float wave_sum(float v) {
#pragma unroll
    for (int o = 1; o < 64; o <<= 1) v += __shfl_xor(v, o);
    return v;
}
constexpr int TIDTAB_LDS = 131072 + 24576 + 256;
DI int fresh_tid() {
    const int slot = (int)(__builtin_amdgcn_s_getreg((5 << 11) | 4) & 63u);
    const int w = __builtin_amdgcn_readfirstlane(*(volatile LAS int*)(unsigned)(TIDTAB_LDS + 4 * slot));
    int l0 = 0; asm volatile("v_mbcnt_lo_u32_b32 %0, -1, 0\n\tv_mbcnt_hi_u32_b32 %0, -1, %0" : "=v"(l0));
    return w * 64 + l0;
}
DI float sigmoidf_(float x) { return __builtin_amdgcn_rcpf(1.f + __expf(-x)); }
DI float gelu_tanh(float x) { const float u = 0.7978845608028654f * (x + 0.044715f * x * x * x); const float e = __expf(2.f * u); const float t = 1.f - 2.f * __builtin_amdgcn_rcpf(e + 1.f); return 0.5f * x * (1.f + t); }
#define LDS_WAIT() asm volatile("s_waitcnt lgkmcnt(0)" ::: "memory")
#define VM_WAIT() asm volatile("s_waitcnt vmcnt(0)" ::: "memory")

#define XB_TMO      128
#define XB_XCNT(j)  (256  + 64 * (j))
#define XB_XSUB(j)  (1280 + 64 * (j))
#define XB_XGEN(j)  (2304 + 64 * (j))
#define XB_TOP      3328
#define XB_TOPGEN   3392
#define XCD_BAR_WORDS 3456
#define XB_SPIN_CAP (1u << 22)
DI unsigned xb_ld(unsigned* p)              { return __hip_atomic_load(p, __ATOMIC_RELAXED, __HIP_MEMORY_SCOPE_AGENT); }
DI unsigned xb_add(unsigned* p, unsigned v) { return __hip_atomic_fetch_add(p, v, __ATOMIC_RELAXED, __HIP_MEMORY_SCOPE_AGENT); }
DI unsigned xb_xcc_id() { return (unsigned)__builtin_amdgcn_s_getreg((3 << 11) | 20) & 0xFu; }
#define XB_SPIN(cond, bar) do { unsigned _sp = 0; while (cond) { __builtin_amdgcn_s_sleep(1); \
    if ((++_sp & 255u) == 0u) { if (xb_ld(&(bar)[XB_TMO])) break; if (_sp > XB_SPIN_CAP) { atomicAdd(&(bar)[XB_TMO], 1u); break; } } } } while (0)
struct XcdBarrier { unsigned* bar; unsigned x; volatile LAS unsigned* st; };
DI XcdBarrier xcd_barrier_post(unsigned* bar, volatile LAS unsigned* st) {
    XcdBarrier b; b.bar = bar; b.x = xb_xcc_id(); b.st = st;
    if (fresh_tid() == 0) (void)xb_add(&bar[XB_XCNT(b.x)], 1u);
    return b;
}
DI void xcd_barrier_complete(unsigned* bar, unsigned x, unsigned& nloc, unsigned& nx) {
    const unsigned G = gridDim.x * gridDim.y * gridDim.z;
    unsigned sum, cnt, mine, sp = 0u;
    for (;;) {
        sum = 0u; cnt = 0u; mine = 0u;
#pragma unroll
        for (unsigned j = 0; j < 16; ++j) { const unsigned c = xb_ld(&bar[XB_XCNT(j)]); sum += c; cnt += (c > 0u) ? 1u : 0u; mine = (j == x) ? c : mine; }
        if (sum == G) break;
        __builtin_amdgcn_s_sleep(1);
        if ((++sp & 255u) == 0u) { if (xb_ld(&bar[XB_TMO])) break; if (sp > XB_SPIN_CAP) { atomicAdd(&bar[XB_TMO], 1u); break; } }
    }
    nloc = mine > 0u ? mine : 1u; nx = cnt > 0u ? cnt : 1u;
}
DI void xcd_barrier(const XcdBarrier& b) {
    asm volatile("s_waitcnt vmcnt(0)" ::: "memory");
    __syncthreads();
    if (fresh_tid() == 0) {
        unsigned* bar = b.bar; unsigned bx_ = b.x; asm volatile("" : "+s"(bx_), "+s"(bar));
        __builtin_amdgcn_s_waitcnt(0);
        unsigned nloc = b.st[0], nx = b.st[1];
        if (nloc == 0u) { xcd_barrier_complete(bar, bx_, nloc, nx); b.st[0] = nloc; b.st[1] = nx; }
        const unsigned old = xb_add(&bar[XB_XSUB(bx_)], 1u);
        const unsigned gen = old / nloc;
        if (old + 1u == (gen + 1u) * nloc) {
            __builtin_amdgcn_fence(__ATOMIC_RELEASE, "agent");
            asm volatile("s_waitcnt vmcnt(0)" ::: "memory");
            const unsigned og = xb_add(&bar[XB_TOP], 1u);
            const unsigned tg = og / nx;
            if (og + 1u == (tg + 1u) * nx) xb_add(&bar[XB_TOPGEN], 1u);
            else XB_SPIN(xb_ld(&bar[XB_TOPGEN]) == tg, bar);
            __builtin_amdgcn_fence(__ATOMIC_ACQUIRE, "agent");
            xb_add(&bar[XB_XGEN(bx_)], 1u);
            asm volatile("s_waitcnt vmcnt(0)" ::: "memory");
        } else {
            XB_SPIN(xb_ld(&bar[XB_XGEN(bx_)]) == gen, bar);
            __builtin_amdgcn_fence(__ATOMIC_ACQUIRE, "agent");
            asm volatile("s_waitcnt vmcnt(0)" ::: "memory");
        }
    }
    __syncthreads();
}

namespace pg8 {
typedef int v8i_t __attribute__((ext_vector_type(8))); typedef int v4i_t __attribute__((ext_vector_type(4)));
DI void mfma8(f32x4& c, v8i_t b, v8i_t a) { asm volatile("v_mfma_f32_16x16x128_f8f6f4 %0, %1, %2, %0" : "+v"(c) : "v"(b), "v"(a)); }
DI v8i_t cat8(bf16x8 a, bf16x8 b) { const v4i_t x = __builtin_bit_cast(v4i_t, a), y = __builtin_bit_cast(v4i_t, b); return __builtin_shufflevector(x, y, 0, 1, 2, 3, 4, 5, 6, 7); }
constexpr int BM = 256, BK = 64, HALF = 128, HTB = HALF * BK * 2, STAGE_BYTES = 8 * HTB;
__host__ __device__ __forceinline__ int lds_byte(int r, int c) { const int st = (r >> 4) * 2 + (c >> 5), rr = r & 15, cc = c & 31, ob = rr * 64 + cc * 2; return st * 1024 + (ob ^ (((ob >> 9) & 1) << 5)); }
__host__ __device__ __forceinline__ void stage_rc(int b, int& R, int& C) { const int st = b / 1024, sb = b % 1024, swz = sb ^ (((sb >> 9) & 1) << 5); R = (st >> 1) * 16 + swz / 64; C = (st & 1) * 32 + (swz % 64) / 2; }
__host__ __device__ __forceinline__ int perm32(int rho) { const int n = rho >> 4, i = rho & 15; return 8 * (i >> 2) + 4 * n + (i & 3); }
__host__ __device__ __forceinline__ int perm32x(int rho) { const int n = rho >> 4, i = rho & 15, q = i >> 2, gq = ((q & 1) << 1) | (q >> 1); return 8 * gq + 4 * n + (i & 3); }
struct Unit { int pm, pn, e; };

template <class Epi, class Sched, bool GATHER, bool GS, bool FP8 = false>
DI void gemm_phase(LAS unsigned char* lds, const int lda, const int K, const Sched& S, const Epi& E, const LAS float* gstab) {
    const int tid = fresh_tid(), wid = __builtin_amdgcn_readfirstlane(tid >> 6), lane = tid & 63, wr = wid >> 2, wc = wid & 3, fr = lane & 15, fq = lane >> 4;
    const int nt = K / BK;
    unsigned voffA0[2], voffA1[2], voffB[2], nvA0[2], nvA1[2]; int RA[2], CA[2];
#pragma unroll
    for (int i = 0; i < 2; ++i) { int R, C; stage_rc(tid * 16 + i * 8192, R, C); const int Rb = (R & ~31) + (Epi::PERMX ? perm32x(R & 31) : perm32(R & 31));
        RA[i] = R; CA[i] = C * 2; voffA0[i] = (unsigned)(R * lda + C) * 2u; voffA1[i] = (unsigned)((R + HALF) * lda + C) * 2u; voffB[i] = (unsigned)(Rb * K + C) * 2u; nvA0[i] = voffA0[i]; nvA1[i] = voffA1[i]; }
    const size_t kstep = (size_t)(BK * 2);
    const size_t hstepB = (size_t)HALF * K * 2;
    const size_t hstepA = (size_t)HALF * lda * 2;
    const size_t q64A = (size_t)64 * lda * 2, q64B = (size_t)64 * K * 2;
    const unsigned ldsw = (unsigned)wid * 1024u;
    const int aoff = lds_byte(wr * 64 + fr, fq * 8), boff = lds_byte(wc * 32 + fr, fq * 8);
#define PG8_SA(b, h) (((b) * 2 + (h)) * HTB)
#define PG8_SB(b, h) ((4 + (b) * 2 + (h)) * HTB)
#define PG8_STAGE2(bufoff, gbase, o0, o1) do { \
        __builtin_amdgcn_global_load_lds((const unsigned*)((const char*)(gbase) + (o0)), (LAS unsigned*)(lds + (bufoff) + ldsw), 16, 0, 0); \
        __builtin_amdgcn_global_load_lds((const unsigned*)((const char*)(gbase) + (o1)), (LAS unsigned*)(lds + (bufoff) + ldsw + 8192), 16, 0, 0); } while (0)
#define PG8_STAGE_B(bufoff, gbase) do { \
        __builtin_amdgcn_global_load_lds((const unsigned*)((const char*)(gbase) + voffB[0]), (LAS unsigned*)(lds + (bufoff) + ldsw), 16, 0, 0); \
        __builtin_amdgcn_global_load_lds((const unsigned*)((const char*)(gbase) + q64B + voffB[0]), (LAS unsigned*)(lds + (bufoff) + ldsw + 8192), 16, 0, 0); } while (0)
#define PG8_STAGE_A0(bufoff, gbase, o0, o1) do { if constexpr (GATHER) PG8_STAGE2(bufoff, gbase, o0, o1); else { \
        __builtin_amdgcn_global_load_lds((const unsigned*)((const char*)(gbase) + (o0)), (LAS unsigned*)(lds + (bufoff) + ldsw), 16, 0, 0); \
        __builtin_amdgcn_global_load_lds((const unsigned*)((const char*)(gbase) + q64A + (o0)), (LAS unsigned*)(lds + (bufoff) + ldsw + 8192), 16, 0, 0); } } while (0)
#define PG8_STAGE_A1(bufoff, gbase, o0, o1, p0, p1) do { if constexpr (GATHER) PG8_STAGE2(bufoff, gbase, o0, o1); else PG8_STAGE_A0(bufoff, (gbase) + hstepA, p0, p1); } while (0)
#define PG8_LDA(dst, b, h) do { _Pragma("unroll") for (int m = 0; m < 4; ++m) _Pragma("unroll") for (int k = 0; k < 2; ++k) dst[m][k] = *(const LAS bf16x8*)(lds + PG8_SA(b, h) + aoff + m * 2048 + k * 1024); } while (0)
#define PG8_LDB(dst, b, h) do { _Pragma("unroll") for (int n = 0; n < 2; ++n) _Pragma("unroll") for (int k = 0; k < 2; ++k) dst[n][k] = *(const LAS bf16x8*)(lds + PG8_SB(b, h) + boff + n * 2048 + k * 1024); } while (0)
#define PG8_MMA(ai, bj, At, Bt) do { __builtin_amdgcn_s_setprio(1); _Pragma("unroll") for (int m = 0; m < 4; ++m) _Pragma("unroll") for (int n = 0; n < 2; ++n) { \
        if constexpr (FP8) { mfma8(acc[ai][bj][m][n], cat8(Bt[n][0], Bt[n][1]), cat8(At[m][0], At[m][1])); } \
        else { _Pragma("unroll") for (int k = 0; k < 2; ++k) acc[ai][bj][m][n] = __builtin_amdgcn_mfma_f32_16x16x32_bf16(Bt[n][k], At[m][k], acc[ai][bj][m][n], 0, 0, 0); } } if constexpr (FP8) asm volatile("s_nop 7\n\ts_nop 7" ::: "memory"); __builtin_amdgcn_s_setprio(0); } while (0)
#define PG8_WAIT_V(n) asm volatile("s_waitcnt vmcnt(" #n ")" ::: "memory")
#define PG8_WAIT_L(n) asm volatile("s_waitcnt lgkmcnt(" #n ")" ::: "memory")
#define PG8_BAR __builtin_amdgcn_s_barrier()
#define PG8_SCHED __builtin_amdgcn_sched_barrier(0)
    Unit cur, nxt; int ui = 0;
    if (!S.next(0, cur)) return;
    f32x4 acc[2][2][4][2];
#pragma unroll
    for (int a = 0; a < 2; ++a)
#pragma unroll
        for (int b = 0; b < 2; ++b)
#pragma unroll
            for (int m = 0; m < 4; ++m)
#pragma unroll
                for (int n = 0; n < 2; ++n) acc[a][b][m][n] = (f32x4){0.f, 0.f, 0.f, 0.f};
    bf16x8 At[4][2], B0[2][2], B1[2][2];
    const char* cA = S.abase(cur); const char* cB = S.bbase(cur);
    if constexpr (GATHER) {
#pragma unroll
        for (int i = 0; i < 2; ++i) { voffA0[i] = S.arow_off(cur, RA[i]) + (unsigned)CA[i]; voffA1[i] = S.arow_off(cur, RA[i] + HALF) + (unsigned)CA[i]; nvA0[i] = voffA0[i]; nvA1[i] = voffA1[i]; }
    }
    PG8_STAGE_B(PG8_SB(0, 0), cB); PG8_STAGE_B(PG8_SB(0, 1), cB + hstepB); PG8_STAGE_A0(PG8_SA(0, 0), cA, voffA0[0], voffA0[1]); PG8_STAGE_A1(PG8_SA(0, 1), cA, voffA1[0], voffA1[1], voffA0[0], voffA0[1]);
    if (wr == 1) PG8_BAR;
    PG8_WAIT_V(2); PG8_BAR;
    PG8_STAGE_B(PG8_SB(1, 0), cB + kstep); PG8_STAGE_A0(PG8_SA(1, 0), cA + kstep, voffA0[0], voffA0[1]); PG8_STAGE_B(PG8_SB(1, 1), cB + hstepB + kstep);
    PG8_WAIT_V(6); PG8_BAR;
    for (;;) {
        const bool has_next = S.next(ui + 1, nxt);
        const char* nA = has_next ? S.abase(nxt) : cA; const char* nB = has_next ? S.bbase(nxt) : cB;
        for (int t = 0; t < nt; t += 2) {
            const bool last = (t == nt - 2);
            const char* a1 = cA + (size_t)(t + 1) * kstep;
            const char* a2 = last ? nA : cA + (size_t)(t + 2) * kstep; const char* b2 = last ? nB : cB + (size_t)(t + 2) * kstep;
            const char* a3 = a2 + kstep; const char* b3 = b2 + kstep;
            if constexpr (GATHER) {
                if (t == nt - 4) {
                    if (has_next) { const int tid2 = fresh_tid();
#pragma unroll
                        for (int i = 0; i < 2; ++i) { int R2, C2; stage_rc(tid2 * 16 + i * 8192, R2, C2); nvA0[i] = S.arow_off(nxt, R2) + (unsigned)(C2 * 2); nvA1[i] = S.arow_off(nxt, R2 + HALF) + (unsigned)(C2 * 2); }
                    } else {
#pragma unroll
                        for (int i = 0; i < 2; ++i) { nvA0[i] = voffA0[i]; nvA1[i] = voffA1[i]; }
                    }
                }
            }
            unsigned xo0[2], xo1[2];
#pragma unroll
            for (int i = 0; i < 2; ++i) { xo0[i] = (GATHER && last) ? nvA0[i] : voffA0[i]; xo1[i] = (GATHER && last) ? nvA1[i] : voffA1[i]; }
            if constexpr (GS) {
                PG8_SCHED;
                if (t != 0 && (t & 3) == 0) {
                    const int g = (t >> 2) - 1; const int fr2 = fresh_tid() & 15;
#pragma unroll
                    for (int ai = 0; ai < 2; ++ai)
#pragma unroll
                        for (int m = 0; m < 4; ++m) { const float f = gstab[((ui & 3) * 256 + ai * HALF + wr * 64 + m * 16 + fr2) * 4 + g];
#pragma unroll
                            for (int bj = 0; bj < 2; ++bj)
#pragma unroll
                                for (int n = 0; n < 2; ++n) acc[ai][bj][m][n] *= f; }
                }
                PG8_SCHED;
            }
            PG8_LDB(B0, 0, 0); PG8_LDB(B1, 0, 1); PG8_SCHED; PG8_LDA(At, 0, 0); PG8_STAGE_A1(PG8_SA(1, 1), a1, voffA1[0], voffA1[1], voffA0[0], voffA0[1]);
            PG8_WAIT_V(8); PG8_WAIT_L(0); PG8_BAR; PG8_MMA(0, 0, At, B0); PG8_MMA(0, 1, At, B1); PG8_BAR; PG8_SCHED;
            PG8_LDA(At, 0, 1); PG8_STAGE_B(PG8_SB(0, 0), b2); PG8_STAGE_B(PG8_SB(0, 1), b2 + hstepB); PG8_STAGE_A0(PG8_SA(0, 0), a2, xo0[0], xo0[1]);
            PG8_WAIT_V(8); PG8_WAIT_L(0); PG8_BAR; PG8_MMA(1, 0, At, B0); PG8_MMA(1, 1, At, B1); PG8_BAR; PG8_SCHED;
            PG8_LDB(B0, 1, 0); PG8_LDB(B1, 1, 1); PG8_SCHED; PG8_LDA(At, 1, 0); PG8_STAGE_A1(PG8_SA(0, 1), a2, xo1[0], xo1[1], xo0[0], xo0[1]);
            PG8_WAIT_V(8); PG8_WAIT_L(0); PG8_BAR; PG8_MMA(0, 0, At, B0); PG8_MMA(0, 1, At, B1); PG8_BAR; PG8_SCHED;
            PG8_LDA(At, 1, 1); PG8_STAGE_B(PG8_SB(1, 0), b3); PG8_STAGE_B(PG8_SB(1, 1), b3 + hstepB); PG8_STAGE_A0(PG8_SA(1, 0), a3, xo0[0], xo0[1]);
            PG8_WAIT_V(8); PG8_WAIT_L(0); PG8_BAR; PG8_MMA(1, 0, At, B0); PG8_MMA(1, 1, At, B1); PG8_BAR; PG8_SCHED;
        }
        if (wr == 0) PG8_BAR;
        if constexpr (FP8) asm volatile("s_nop 15\n\ts_nop 15" ::: "memory");
        { const int l2 = fresh_tid() & 63; E(acc, cur, ui, wr, wc, l2 & 15, l2 >> 4, gstab); }
        if (!has_next) break;
#pragma unroll
        for (int a = 0; a < 2; ++a)
#pragma unroll
            for (int b = 0; b < 2; ++b)
#pragma unroll
                for (int m = 0; m < 4; ++m)
#pragma unroll
                    for (int n = 0; n < 2; ++n) acc[a][b][m][n] = (f32x4){0.f, 0.f, 0.f, 0.f};
        cur = nxt; cA = nA; cB = nB; ++ui;
        if constexpr (GATHER) {
#pragma unroll
            for (int i = 0; i < 2; ++i) { voffA0[i] = nvA0[i]; voffA1[i] = nvA1[i]; }
        }
        if (wr == 1) PG8_BAR;
    }
    PG8_WAIT_V(0);
    PG8_BAR;
#undef PG8_SA
#undef PG8_SB
#undef PG8_STAGE2
#undef PG8_STAGE_B
#undef PG8_STAGE_A0
#undef PG8_STAGE_A1
#undef PG8_LDA
#undef PG8_LDB
#undef PG8_MMA
#undef PG8_WAIT_V
#undef PG8_WAIT_L
#undef PG8_BAR
#undef PG8_SCHED
}
}
using pg8::Unit;

constexpr int XR = 4;
struct SchedPlain {
    const char* A; const char* Bt; int lda, K, nM, nN, G, c;
    DI bool next(int i, Unit& u) const {
        const int U = nM * nN, U8 = (U + 7) >> 3, o = i * (G >> 3) + (c >> 3), L = (c & 7) * U8 + o; if (o >= U8 || L >= U) return false;
        const int grp = L / (XR * nN), rem = L - grp * (XR * nN), fm = grp * XR, gsz = (nM - fm) < XR ? (nM - fm) : XR;
        u.pm = fm + rem % gsz; u.pn = rem / gsz; u.e = 0; return true;
    }
    DI int xcnt(int x) const { const int U = nM * nN, U8 = (U + 7) >> 3; const int n = U - x * U8; return n < 0 ? 0 : (n > U8 ? U8 : n); }
    DI const char* abase(const Unit& u) const { return A + (size_t)u.pm * 256 * lda * 2; }
    DI const char* bbase(const Unit& u) const { return Bt + (size_t)u.pn * 256 * K * 2; }
    DI unsigned arow_off(const Unit&, int) const { return 0u; }
    DI void a_ready(const Unit&) const {}
};

DI float ss_sum(const float* ss, int row, int nslot) {
    if (nslot == 1) return ss[row];
    const f32x4* q = (const f32x4*)(ss + (size_t)row * 16); const f32x4 a = q[0], b = q[1], c = q[2], d = q[3];
    return (((a[0] + a[1]) + (a[2] + a[3])) + ((b[0] + b[1]) + (b[2] + b[3]))) + (((c[0] + c[1]) + (c[2] + c[3])) + ((d[0] + d[1]) + (d[2] + d[3])));
}
struct EpiZ {
    static constexpr bool PERMX = false;
    bf16_t* Z;
    DI void operator()(const f32x4 (&acc)[2][2][4][2], const Unit& u, int ui, int wr, int wc, int fr, int fq, const LAS float* rst) const {
        const int row0 = u.pm * 256 + wr * 64 + fr, col0 = u.pn * 256 + wc * 32 + 8 * fq;
#pragma unroll
        for (int ai = 0; ai < 2; ++ai)
#pragma unroll
            for (int m = 0; m < 4; ++m) { const int row = row0 + ai * 128 + m * 16; const float rs = rst[ui * 256 + ai * 128 + wr * 64 + m * 16 + fr];
                bf16_t* rowp = Z + (size_t)row * ZC + col0;
#pragma unroll
                for (int bj = 0; bj < 2; ++bj) { const f32x4 v0 = acc[ai][bj][m][0] * rs, v1 = acc[ai][bj][m][1] * rs; u32x4 w;
                    w.x = cvtpk(v0[0], v0[1]); w.y = cvtpk(v0[2], v0[3]); w.z = cvtpk(v1[0], v1[1]); w.w = cvtpk(v1[2], v1[3]); *(u32x4*)(rowp + bj * 128) = w; } }
    }
};
struct EpiRes {
    static constexpr bool PERMX = false;
    bf16_t* hb; float* ss_out; int gs; unsigned char* h8; float ascale;
    DI void operator()(const f32x4 (&acc)[2][2][4][2], const Unit& u, int ui, int wr, int wc, int fr, int fq, const LAS float* gstab) const {
        const int row0 = u.pm * 256 + wr * 64 + fr, col0 = u.pn * 256 + wc * 32 + 8 * fq;
#pragma unroll
        for (int ai = 0; ai < 2; ++ai) {
        u32x4 rw[1][4][2];
#pragma unroll
            for (int m = 0; m < 4; ++m)
#pragma unroll
                for (int bj = 0; bj < 2; ++bj) rw[0][m][bj] = *(const u32x4*)(hb + (size_t)(row0 + ai * 128 + m * 16) * D + col0 + bj * 128);
        asm volatile("" ::: "memory");
#pragma unroll
            for (int m = 0; m < 4; ++m) { const int row = row0 + ai * 128 + m * 16; const size_t off = (size_t)row * D + col0;
                const float f = gs ? gstab[((ui & 3) * 256 + ai * 128 + wr * 64 + m * 16 + fr) * 4 + 3] : ascale; float sq = 0.f;
#pragma unroll
                for (int bj = 0; bj < 2; ++bj) { const u32x4 r = rw[0][m][bj];
                    const f32x4 r0 = {bflo(r.x), bfhi(r.x), bflo(r.y), bfhi(r.y)}, r1 = {bflo(r.z), bfhi(r.z), bflo(r.w), bfhi(r.w)};
                    const f32x4 v0 = r0 + acc[ai][bj][m][0] * f, v1 = r1 + acc[ai][bj][m][1] * f;
                    u32x4 w; w.x = cvtpk(v0[0], v0[1]); w.y = cvtpk(v0[2], v0[3]); w.z = cvtpk(v1[0], v1[1]); w.w = cvtpk(v1[2], v1[3]); *(u32x4*)(hb + off + bj * 128) = w;
                    if (h8) { u32x2 w8; w8.x = pk4_fp8(v0[0], v0[1], v0[2], v0[3]); w8.y = pk4_fp8(v1[0], v1[1], v1[2], v1[3]); *(u32x2*)(h8 + off + bj * 128) = w8; }
                    sq += (v0[0] * v0[0] + v0[1] * v0[1]) + (v0[2] * v0[2] + v0[3] * v0[3]) + (v1[0] * v1[0] + v1[1] * v1[1]) + (v1[2] * v1[2] + v1[3] * v1[3]); }
                sq += __shfl_xor(sq, 16); sq += __shfl_xor(sq, 32);
                if (fq == 0 && ss_out) ss_out[(size_t)row * 16 + u.pn * 4 + wc] = sq; }
        asm volatile("" ::: "memory"); }
    }
};


struct EpiGU {
    static constexpr bool PERMX = false;
    bf16_t* ACT; int ldact; const float* ss;
    DI void operator()(const f32x4 (&acc)[2][2][4][2], const Unit& u, int, int wr, int wc, int fr, int fq, const LAS float*) const {
        const int row0 = u.pm * 256 + wr * 64 + fr, col0 = u.pn * 128 + wc * 32 + 8 * fq;
#pragma unroll
        for (int ai = 0; ai < 2; ++ai)
#pragma unroll
            for (int m = 0; m < 4; ++m) { const int row = row0 + ai * 128 + m * 16; const float rs = rsqrtf(ss_sum(ss, row, 16) * (1.f / 1024.f) + EPS); float a[8];
#pragma unroll
                for (int n = 0; n < 2; ++n)
#pragma unroll
                    for (int e = 0; e < 4; ++e) { const float g = acc[ai][0][m][n][e] * rs, uu = acc[ai][1][m][n][e] * rs; a[4 * n + e] = g * uu * __builtin_amdgcn_rcpf(1.f + __expf(-g)); }
                u32x4 w; w.x = cvtpk(a[0], a[1]); w.y = cvtpk(a[2], a[3]); w.z = cvtpk(a[4], a[5]); w.w = cvtpk(a[6], a[7]);
                *(u32x4*)(ACT + (size_t)row * ldact + col0) = w; }
    }
};
struct EpiGU8 {
    static constexpr bool PERMX = true;
    unsigned char* ACT; int ldact; float wsc;
    DI void operator()(const f32x4 (&acc)[2][2][4][2], const Unit& u, int ui, int wr, int wc, int fr, int fq, const LAS float* rst) const {
        const int row0 = u.pm * 256 + wr * 64 + fr, col0 = u.pn * 128 + wc * 32 + 16 * (fq & 1), hi = fq >> 1;
#pragma unroll
        for (int ai = 0; ai < 2; ++ai)
#pragma unroll
            for (int mp = 0; mp < 2; ++mp) { const int m0 = 2 * mp, m1 = m0 + 1; const LAS float* rp = rst + ui * 256 + ai * 128 + wr * 64 + fr;
                const u32x2 wa = swiglu8_fp8(acc[ai][0][m0][0], acc[ai][0][m0][1], acc[ai][1][m0][0], acc[ai][1][m0][1], rp[m0 * 16] * wsc);
                const u32x2 wb = swiglu8_fp8(acc[ai][0][m1][0], acc[ai][0][m1][1], acc[ai][1][m1][0], acc[ai][1][m1][1], rp[m1 * 16] * wsc);
                const auto s0 = __builtin_amdgcn_permlane32_swap(wa.x, wb.x, false, false), s1 = __builtin_amdgcn_permlane32_swap(wa.y, wb.y, false, false);
                *(u32x4*)(ACT + (size_t)(row0 + ai * 128 + (m0 + hi) * 16) * ldact + col0) = (u32x4){s0[0], s1[0], s0[1], s1[1]}; asm volatile("" ::: "memory"); }
    }
};
struct SchedMoe {
    const char* A; const char* B0; size_t bstride; int lda, K, nT, nN, G, c; const LAS int* tab; const int* list; bool gather; unsigned rowbytes; int nh, skew;
    DI bool next(int i, Unit& u) const { int o; const int U = nT * nN, U8 = (U + 7) >> 3, B = G >> 3, j = c >> 3;
        if (nh == 0) o = i * B + j;
        else if (j >= nh) o = (i < skew) ? i * (B - nh) + (j - nh) : skew * (B - nh) + (i - skew) * B + j;
        else o = skew * (B - nh) + i * B + j;
        const int L = (c & 7) * U8 + o; if (o >= U8 || L >= U) return false;
        const int grp = L / (XR * nN), rem = L - grp * (XR * nN), fm = grp * XR, gsz = (nT - fm) < XR ? (nT - fm) : XR;
        u.pm = fm + rem % gsz; u.pn = rem / gsz; u.e = tab[u.pm * 4]; return true; }
    DI const char* abase(const Unit& u) const { return gather ? A : A + (size_t)u.pm * 256 * lda * 2; }
    DI const char* bbase(const Unit& u) const { return B0 + (size_t)u.e * bstride + (size_t)u.pn * 256 * K * 2; }
    DI unsigned arow_off(const Unit& u, int r) const { const int off = tab[u.pm * 4 + 1], n = tab[u.pm * 4 + 2]; const int idx = off + r; const int tok = idx < n ? list[u.e * 32768 + idx] : 0; return (unsigned)tok * rowbytes; }
    DI void a_ready(const Unit&) const {}
};
struct EpiMoeGU {
    static constexpr bool PERMX = true;
    unsigned char* ACT; const float* lrs; const LAS int* tab;
    DI void operator()(const f32x4 (&acc)[2][2][4][2], const Unit& u, int ui, int wr, int wc, int fr, int fq, const LAS float* rst) const {
        const int r0 = wr * 64 + fr, col0 = u.pn * 128 + wc * 32 + 16 * (fq & 1), hi = fq >> 1; const LAS float* rsp = rst + ui * 256 + r0;
#pragma unroll
        for (int ai = 0; ai < 2; ++ai)
#pragma unroll
            for (int mp = 0; mp < 2; ++mp) { const int m0 = 2 * mp, m1 = m0 + 1;
                const u32x2 wa = swiglu8_fp8(acc[ai][0][m0][0], acc[ai][0][m0][1], acc[ai][1][m0][0], acc[ai][1][m0][1], rsp[ai * 128 + m0 * 16] * (1.f / W8_SCALE));
                const u32x2 wb = swiglu8_fp8(acc[ai][0][m1][0], acc[ai][0][m1][1], acc[ai][1][m1][0], acc[ai][1][m1][1], rsp[ai * 128 + m1 * 16] * (1.f / W8_SCALE));
                const auto s0 = __builtin_amdgcn_permlane32_swap(wa.x, wb.x, false, false), s1 = __builtin_amdgcn_permlane32_swap(wa.y, wb.y, false, false);
                *(u32x4*)(ACT + (size_t)(u.pm * 256 + r0 + ai * 128 + (m0 + hi) * 16) * DFE + col0) = (u32x4){s0[0], s1[0], s0[1], s1[1]}; }
    }
};
struct EpiMoeDown {
    static constexpr bool PERMX = false;
    float* out; const int* list; const float* lgate; const LAS int* tab; bf16_t* hb; bool last;
    DI void operator()(const f32x4 (&acc)[2][2][4][2], const Unit& u, int, int wr, int wc, int fr, int fq, const LAS float*) const {
        const int off = tab[u.pm * 4 + 1], n = tab[u.pm * 4 + 2]; const int r0 = wr * 64 + fr, col0 = u.pn * 256 + wc * 32 + 8 * fq;
        int tok[2][4]; float gt[2][4];
#pragma unroll
        for (int ai = 0; ai < 2; ++ai)
#pragma unroll
            for (int m = 0; m < 4; ++m) { const int idx = off + r0 + ai * 128 + m * 16, ci = idx < n ? idx : n - 1;
                tok[ai][m] = list[u.e * 32768 + ci]; gt[ai][m] = lgate[u.e * 32768 + ci] * (1.f / (W8_SCALE * ACT8_SCALE)); }
        u32x4 rw[2][4][2];
#pragma unroll
        for (int ai = 0; ai < 2; ++ai)
#pragma unroll
            for (int m = 0; m < 4; ++m)
#pragma unroll
                for (int bj = 0; bj < 2; ++bj) rw[ai][m][bj] = *(const u32x4*)(hb + (size_t)tok[ai][m] * D + col0 + bj * 128);
        asm volatile("" ::: "memory");
#pragma unroll
        for (int ai = 0; ai < 2; ++ai)
#pragma unroll
            for (int m = 0; m < 4; ++m) if (off + r0 + ai * 128 + m * 16 < n) { const size_t ro = (size_t)tok[ai][m] * D + col0; const float g = gt[ai][m];
#pragma unroll
                for (int bj = 0; bj < 2; ++bj) { const u32x4 r = rw[ai][m][bj];
                    const f32x4 v0 = (f32x4){bflo(r.x), bfhi(r.x), bflo(r.y), bfhi(r.y)} + acc[ai][bj][m][0] * g, v1 = (f32x4){bflo(r.z), bfhi(r.z), bflo(r.w), bfhi(r.w)} + acc[ai][bj][m][1] * g;
                    if (last) { *(f32x4*)(out + ro + bj * 128) = v0; *(f32x4*)(out + ro + bj * 128 + 4) = v1; }
                    else { u32x4 w; w.x = cvtpk(v0[0], v0[1]); w.y = cvtpk(v0[2], v0[3]); w.z = cvtpk(v1[0], v1[1]); w.w = cvtpk(v1[2], v1[3]); *(u32x4*)(hb + ro + bj * 128) = w; } } }
    }
};
DI f32x4 skinny_acc(const bf16_t* A, int lda, const bf16_t* Bt, int K, int n0, int k0, int k1, int lane) {
    const int fr = lane & 15, g = lane >> 4; f32x4 acc = {0.f, 0.f, 0.f, 0.f};
    const bf16_t* ap = A + (size_t)fr * lda + 8 * g; const bf16_t* bp = Bt + (size_t)(n0 + fr) * K + 8 * g;
#pragma unroll 4
    for (int k = k0; k < k1; k += 32) { const bf16x8 a = *(const bf16x8*)(ap + k), b = *(const bf16x8*)(bp + k); acc = __builtin_amdgcn_mfma_f32_16x16x32_bf16(b, a, acc, 0, 0, 0); }
    return acc;
}

DI f32x4 skinny_block(LAS unsigned char* lds, const bf16_t* A, int lda, const bf16_t* Bt, int K, int n0, int kc, float scale, int tid) {
    const int lane = tid & 63, wave = tid >> 6;
    const f32x4 part = skinny_acc(A, lda, Bt, K, n0, wave * kc, wave * kc + kc, lane) * scale;
    LAS f32x4* red = (LAS f32x4*)lds; red[wave * 64 + lane] = part;
    __syncthreads();
    f32x4 tot = red[lane];
#pragma unroll
    for (int w = 1; w < 8; ++w) tot = tot + red[w * 64 + lane];
    __syncthreads();
    return tot;
}
DI void meta_rs(LAS float* rsm, const float* hm, int tid) {
    const int row = tid >> 5, l32 = tid & 31; const f32x4* q = (const f32x4*)(hm + (size_t)row * D) + l32; float sv = 0.f;
#pragma unroll
    for (int j = 0; j < 8; ++j) { const f32x4 v = q[32 * j]; sv += (v[0] * v[0] + v[1] * v[1]) + (v[2] * v[2] + v[3] * v[3]); }
    sv += __shfl_xor(sv, 1); sv += __shfl_xor(sv, 2); sv += __shfl_xor(sv, 4); sv += __shfl_xor(sv, 8); sv += __shfl_xor(sv, 16);
    if (l32 == 0) rsm[row] = rsqrtf(sv * (1.f / 1024.f) + EPS);
    __syncthreads();
}

template <class Sched> DI void fill_rs_table(const Sched& S, const float* ss, int nslot, LAS float* rst, int tid) {
    Unit u;
    for (int i = 0; i < 16 && S.next(i, u); ++i) if (tid < 256) rst[i * 256 + tid] = rsqrtf(ss_sum(ss, u.pm * 256 + tid, nslot) * (1.f / 1024.f) + EPS);
    __syncthreads();
}
DI void fill_moe_rs_table(const SchedMoe& S, const float* lrs, LAS float* rst, int tid) {
    Unit u;
    for (int i = 0; i < 16 && S.next(i, u); ++i) if (tid < 256) rst[i * 256 + tid] = lrs[u.e * 32768 + S.tab[u.pm * 4 + 1] + tid];
    __syncthreads();
}
struct Params {
    const float* x; const float* meta; const float* norm1_g; const float* norm2_g; const float* w_in; const float* w_out; const float* out_norm_g;
    const float* lru_conv_w; const float* lru_conv_b; const float* lru_wa; const float* lru_ba; const float* lru_wx; const float* lru_bx; const float* lru_lambda;
    const float* hg_lb_logits; const float* mla_gq; const float* mla_w_uq; const float* mla_gkv; const float* mla_w_ukv; const float* mla_gqn; const float* mla_gkn;
    const float* fox_gqn; const float* fox_gkn; const float* fox_bf; const float* ffn_w_gate; const float* ffn_w_up; const float* ffn_w_down;
    const float* moe_w_router; const float* moe_w_gate; const float* moe_w_up; const float* moe_w_down;
    float* out; unsigned char* ws;
};

struct Frame {
    LAS unsigned char* lds; int G, vcu;
};
#define TID_VARS const int tid = fresh_tid(); const int lane = tid & 63; const int wave = __builtin_amdgcn_readfirstlane(tid >> 6); (void)lane; (void)wave

DI void wt_item(const float* W, int ldw, int c0, int nv, const float* g, bf16_t* WT, int K, int n0, int k0, LAS float* scr, int lane) {
    { const int c4 = (lane & 7) * 4; f32x4 v[8];
#pragma unroll
      for (int i = 0; i < 8; ++i) { const int kk = 8 * i + (lane >> 3); const float* src = W + (size_t)(k0 + kk) * ldw + c0 + c4;
          if (c4 + 3 < nv) v[i] = *(const f32x4*)src; else { v[i] = (f32x4){0.f, 0.f, 0.f, 0.f}; if (c4 < nv) v[i][0] = src[0]; if (c4 + 1 < nv) v[i][1] = src[1]; if (c4 + 2 < nv) v[i][2] = src[2]; } }
#pragma unroll
      for (int i = 0; i < 8; ++i) { const int kk = 8 * i + (lane >> 3); const float gs = g ? g[k0 + kk] : 1.f; LAS float* d = scr + kk * 33 + c4; d[0] = v[i][0] * gs; d[1] = v[i][1] * gs; d[2] = v[i][2] * gs; d[3] = v[i][3] * gs; } }
    LDS_WAIT(); asm volatile("" ::: "memory");
    const int c = lane & 7;
#pragma unroll
    for (int j = 0; j < 4; ++j) { const int n = (lane >> 3) + 8 * j; const LAS float* s = scr + (8 * c) * 33 + n;
        u32x4 o; o.x = cvtpk(s[0 * 33], s[1 * 33]); o.y = cvtpk(s[2 * 33], s[3 * 33]); o.z = cvtpk(s[4 * 33], s[5 * 33]); o.w = cvtpk(s[6 * 33], s[7 * 33]);
        *(u32x4*)(WT + (size_t)(n0 + n) * K + k0 + 8 * c) = o; }
    LDS_WAIT(); asm volatile("" ::: "memory");
}
DI void wt_load8(const float* W, int ldw, int c0, int k0, int lane, f32x4 (&v)[8]) {
    const int c4 = (lane & 7) * 4;
#pragma unroll
    for (int i = 0; i < 8; ++i) { const int kk = 8 * i + (lane >> 3); v[i] = *(const f32x4*)(W + (size_t)(k0 + kk) * ldw + c0 + c4); }
}
DI void wt_finish8(const f32x4 (&v)[8], const float* g, float scale, unsigned char* WT, int K8, int n0, int k0, LAS float* scr, int lane) {
    { const int c4 = (lane & 7) * 4;
#pragma unroll
      for (int i = 0; i < 8; ++i) { const int kk = 8 * i + (lane >> 3); const float gs = g ? g[k0 + kk] * scale : scale; LAS float* d = scr + kk * 33 + c4; d[0] = v[i][0] * gs; d[1] = v[i][1] * gs; d[2] = v[i][2] * gs; d[3] = v[i][3] * gs; } }
    LDS_WAIT(); asm volatile("" ::: "memory");
    const int c = lane & 3;
#pragma unroll
    for (int j = 0; j < 2; ++j) { const int n = (lane >> 2) + 16 * j; const LAS float* sp = scr + (16 * c) * 33 + n; u32x4 o;
        o.x = pk4_fp8(sp[0 * 33], sp[1 * 33], sp[2 * 33], sp[3 * 33]); o.y = pk4_fp8(sp[4 * 33], sp[5 * 33], sp[6 * 33], sp[7 * 33]); o.z = pk4_fp8(sp[8 * 33], sp[9 * 33], sp[10 * 33], sp[11 * 33]); o.w = pk4_fp8(sp[12 * 33], sp[13 * 33], sp[14 * 33], sp[15 * 33]);
        *(u32x4*)(WT + (size_t)(n0 + n) * K8 + k0 + 16 * c) = o; }
    LDS_WAIT(); asm volatile("" ::: "memory");
}
DI void wt_item8(const float* W, int ldw, int c0, const float* g, float scale, unsigned char* WT, int K8, int n0, int k0, LAS float* scr, int lane) {
    f32x4 v[8]; wt_load8(W, ldw, c0, k0, lane, v); wt_finish8(v, g, scale, WT, K8, n0, k0, scr, lane);
}
DI void inmap(int nb, int& c0, int& nv) {
    nv = 32;
    if (nb < 48) c0 = 32 * nb;
    else if (nb < 54) c0 = 1536 + 32 * (nb - 48);
    else if (nb < 56) { c0 = 0; nv = 0; }
    else if (nb < 60) c0 = 1728 + 32 * (nb - 56);
    else if (nb == 60) c0 = 1856;
    else if (nb == 61) { c0 = 2656; nv = 4; }
    else if (nb < 64) { c0 = 0; nv = 0; }
    else if (nb < 72) c0 = 1888 + 32 * (nb - 64);
    else if (nb < 80) c0 = 2144 + 32 * (nb - 72);
    else c0 = 2400 + 32 * (nb - 80);
}
DI float row_to_bf16(const float* xrow, bf16_t* orow, int lane) {
    const f32x4* xr = (const f32x4*)xrow + lane; f32x4 v[4]; float s = 0.f;
#pragma unroll
    for (int j = 0; j < 4; ++j) { v[j] = xr[64 * j]; s += (v[j].x * v[j].x + v[j].y * v[j].y) + (v[j].z * v[j].z + v[j].w * v[j].w); }
    u32x2* o8 = (u32x2*)orow + lane;
#pragma unroll
    for (int j = 0; j < 4; ++j) { u32x2 w; w.x = cvtpk(v[j].x, v[j].y); w.y = cvtpk(v[j].z, v[j].w); o8[64 * j] = w; }
    return wave_sum(s);
}

constexpr int CV_I_IN = 88 * 16, CV_I_OUT = 32 * 16, CV_I_G = 88 * 16, CV_I_D = 32 * 44, CV_NITEMS = 2 * CV_I_IN + 2 * CV_I_OUT + 2 * CV_I_G + CV_I_D;
DI void convert_weights(const Params& p, LAS float* scr, int it0, int it1, int gw, int NGW, int lane) {
    bf16_t* Win = (bf16_t*)(p.ws + WS_WIN); bf16_t* Wout = (bf16_t*)(p.ws + WS_WOUT); bf16_t* Wgu = (bf16_t*)(p.ws + WS_WGU); bf16_t* Wd = (bf16_t*)(p.ws + WS_WD);
    constexpr int I_IN = CV_I_IN, I_OUT = CV_I_OUT, I_G = CV_I_G;
    for (int it = it0 + gw; it < it1; it += NGW) {
        int r = it;
        if (r < 2 * I_IN) { const int l = r / I_IN; r %= I_IN; const int nb = r / 16, kb = r % 16; int c0, nv; inmap(nb, c0, nv);
            wt_item(p.w_in + (size_t)l * D * 2660, 2660, c0, nv, p.norm1_g + l * D, Win + (size_t)l * ZC * D, D, 32 * nb, 64 * kb, scr, lane); continue; }
        r -= 2 * I_IN;
        if (r < 2 * I_OUT) { const int l = r / I_OUT; r %= I_OUT; const int nb = r / 16, kb = r % 16;
            wt_item(p.w_out + (size_t)l * D * D, D, 32 * nb, 32, p.out_norm_g + l * D, Wout + (size_t)l * D * D, D, 32 * nb, 64 * kb, scr, lane); continue; }
        r -= 2 * I_OUT;
        if (r < 2 * I_G) { const int up = r / I_G; r %= I_G; const int sb = r / 16, kb = r % 16;
            wt_item(up ? p.ffn_w_up : p.ffn_w_gate, DFF, 32 * sb, 32, p.norm2_g, Wgu, D, 256 * (sb >> 2) + 128 * up + 32 * (sb & 3), 64 * kb, scr, lane); continue; }
        r -= 2 * I_G;
        { const int sb = r / 44, kb = r % 44; wt_item(p.ffn_w_down, D, 32 * sb, 32, nullptr, Wd, DFF, 32 * sb, 64 * kb, scr, lane); }
    }
}
DI void p0_prologue(const Params& p, const Frame& F, float* ss0) {
    TID_VARS;
    LAS float* scr = (LAS float*)(F.lds + wave * 16384);
    const int gw = F.vcu * 8 + wave, NGW = F.G * 8;
    bf16_t* Win = (bf16_t*)(p.ws + WS_WIN); bf16_t* Wout = (bf16_t*)(p.ws + WS_WOUT); bf16_t* Wgu = (bf16_t*)(p.ws + WS_WGU); bf16_t* Wd = (bf16_t*)(p.ws + WS_WD);
    convert_weights(p, scr, 0, CV_I_IN, gw, NGW, lane);
    { bf16_t* LW = (bf16_t*)(p.ws + WS_WSM + SM_LRUW); const int gt = F.vcu * 512 + tid, NT = F.G * 512;
      for (int i = gt; i < 2 * 2 * 4 * 64 * 64; i += NT) { const int c = i & 63, d = (i >> 6) & 63, blk = (i >> 12) & 3, mat = (i >> 14) & 1, l = i >> 15;
          const float* src = mat ? p.lru_wx : p.lru_wa; LW[i] = f2bf(src[((size_t)(l * 4 + blk) * 64 + c) * 64 + d]); } }
    { const int gt = F.vcu * 512 + tid, NT = F.G * 512;
      bf16_t* WQ = (bf16_t*)(p.ws + WS_WSM + SM_WUQ); bf16_t* WKV = (bf16_t*)(p.ws + WS_WSM + SM_WUKV);
      for (int i = gt; i < 2 * 384 * 192; i += NT) { const int k = i % 192, n = (i / 192) % 384, l = i / (192 * 384); WQ[i] = f2bf(p.mla_w_uq[((size_t)l * 192 + k) * 384 + n] * p.mla_gq[l * 192 + k]); }
      for (int i = gt; i < 2 * 512 * 128; i += NT) { const int k = i % 128, n = (i / 128) % 512, l = i / (128 * 512); WKV[i] = f2bf(p.mla_w_ukv[((size_t)l * 128 + k) * 512 + n] * p.mla_gkv[l * 128 + k]); }
      float* ROPE = (float*)(p.ws + WS_HG + HG_ROPE);
      for (int i = gt; i < 8208 * 16; i += NT) { const int pos = i >> 4, fi = i & 15, a = fi >> 2, bq = fi & 3;
          const double base = bq == 0 ? 1.0 : bq == 1 ? 0.5623413251903491 : bq == 2 ? 0.31622776601683794 : 0.1778279410038923;
          const double sc = a == 0 ? 1.0 : a == 1 ? 0.1 : a == 2 ? 0.01 : 0.001;
          double rev = (double)pos * (base * sc) * 0.15915494309189535; rev -= __builtin_floor(rev);
          ROPE[2 * i] = __builtin_amdgcn_cosf((float)rev); ROPE[2 * i + 1] = __builtin_amdgcn_sinf((float)rev); } }
    bf16_t* bufA = (bf16_t*)(p.ws + WS_BUFA);
    for (int m0 = 4 * gw; m0 < NR; m0 += 4 * NGW) {
        f32x4 v[4][4];
#pragma unroll
        for (int r = 0; r < 4; ++r)
#pragma unroll
            for (int j = 0; j < 4; ++j) v[r][j] = ((const f32x4*)(p.x + (size_t)(m0 + r) * D) + lane)[64 * j];
#pragma unroll
        for (int r = 0; r < 4; ++r) { float sq = 0.f; u32x2* o8 = (u32x2*)(bufA + (size_t)(m0 + r) * D) + lane;
#pragma unroll
            for (int j = 0; j < 4; ++j) { sq += (v[r][j].x * v[r][j].x + v[r][j].y * v[r][j].y) + (v[r][j].z * v[r][j].z + v[r][j].w * v[r][j].w); u32x2 w; w.x = cvtpk(v[r][j].x, v[r][j].y); w.y = cvtpk(v[r][j].z, v[r][j].w); o8[64 * j] = w; }
            sq = wave_sum(sq); if (lane == 0) ss0[m0 + r] = sq; } }
    for (int m = gw; m < 256; m += NGW) {
        const int row = MB0 + m;
        if (m >= META_OFF && m < META_OFF + NMETA) { const float s = row_to_bf16(p.meta + (size_t)(m - META_OFF) * D, bufA + (size_t)row * D, lane); if (lane == 0) ss0[row] = s; }
        else { u32x4* o = (u32x4*)(bufA + (size_t)row * D) + lane; o[0] = zero4(); o[64] = zero4(); if (lane == 0) ss0[row] = 0.f; }
    }
}

template <int nrows> DI void lru_local_unit(const Params& p, const Frame& F, int l, int r0, int hrow, int aggidx) {
    const bf16_t* Z = (const bf16_t*)(p.ws + WS_Z);
    bf16_t* LA = (bf16_t*)(p.ws + WS_LRU + LRU_LA); bf16_t* LB = (bf16_t*)(p.ws + WS_LRU + LRU_BC);
    float* AGGA = (float*)(p.ws + WS_LRU + LRU_AGGA); float* AGGB = (float*)(p.ws + WS_LRU + LRU_AGGB);
    constexpr int UP = 264;
    LAS bf16_t* U = (LAS bf16_t*)F.lds;
    LAS bf16_t* TLA = (LAS bf16_t*)(F.lds + 64 * UP * 2);
    LAS bf16_t* TLB = (LAS bf16_t*)(F.lds + 64 * UP * 2 + 64 * 256 * 2);
    TID_VARS; const int w = wave;
    { const int c = tid & 255, half = tid >> 8; constexpr int nh = nrows >> 1; const int t0 = half * nh;
      const float cw0 = p.lru_conv_w[(l * 4 + 0) * 256 + c], cw1 = p.lru_conv_w[(l * 4 + 1) * 256 + c], cw2 = p.lru_conv_w[(l * 4 + 2) * 256 + c], cw3 = p.lru_conv_w[(l * 4 + 3) * 256 + c], cb = p.lru_conv_b[l * 256 + c];
      bf16_t xr[nh + 3];
#pragma unroll
      for (int i = 0; i < 3; ++i) xr[i] = Z[(size_t)((t0 == 0 ? hrow : r0 + t0 - 3) + i) * ZC + ZC_XA + c];
#pragma unroll
      for (int t = 0; t < nh; ++t) xr[3 + t] = Z[(size_t)(r0 + t0 + t) * ZC + ZC_XA + c];
#pragma unroll
      for (int t = 0; t < nh; ++t) { const float u = cb + cw0 * bf2f(xr[t]) + cw1 * bf2f(xr[t + 1]) + cw2 * bf2f(xr[t + 2]) + cw3 * bf2f(xr[t + 3]); U[(t0 + t) * UP + c] = f2bf(u); } }
    __syncthreads();
    { const int blk = w >> 1, fr = lane & 15, fq = lane >> 4;
      const bf16_t* LW = (const bf16_t*)(p.ws + WS_WSM + SM_LRUW) + (size_t)l * 2 * 4 * 4096;
      bf16x8 baA[2][2], bxA[2][2]; f32x4 bavA[2], bxvA[2], lamA[2];
#pragma unroll
      for (int cbk = 0; cbk < 2; ++cbk) { const int dbase = 16 * (2 * (w & 1) + cbk), ch4 = blk * 64 + dbase + 4 * fq;
#pragma unroll
          for (int ks = 0; ks < 2; ++ks) { baA[cbk][ks] = *(const bf16x8*)(LW + ((size_t)(0 * 4 + blk) * 64 + dbase + fr) * 64 + 32 * ks + 8 * fq); bxA[cbk][ks] = *(const bf16x8*)(LW + ((size_t)(1 * 4 + blk) * 64 + dbase + fr) * 64 + 32 * ks + 8 * fq); }
          bavA[cbk] = *(const f32x4*)(p.lru_ba + l * 256 + ch4); bxvA[cbk] = *(const f32x4*)(p.lru_bx + l * 256 + ch4); lamA[cbk] = *(const f32x4*)(p.lru_lambda + l * 256 + ch4); }
#pragma unroll
      for (int cbk = 0; cbk < 2; ++cbk) { const int dbase = 16 * (2 * (w & 1) + cbk), ch4 = blk * 64 + dbase + 4 * fq;
          const bf16x8 ba[2] = {baA[cbk][0], baA[cbk][1]}, bx[2] = {bxA[cbk][0], bxA[cbk][1]};
          const f32x4 bav = bavA[cbk], bxv = bxvA[cbk], lam = lamA[cbk];
          float sp[4];
#pragma unroll
          for (int j = 0; j < 4; ++j) sp[j] = log1pf(__expf(-lam[j]));
          for (int rb = 0; rb < (nrows >> 4); ++rb) {
              f32x4 ar = {0.f, 0.f, 0.f, 0.f}, ai = {0.f, 0.f, 0.f, 0.f};
#pragma unroll
              for (int ks = 0; ks < 2; ++ks) { const bf16x8 a = *(const LAS bf16x8*)(U + (16 * rb + fr) * UP + blk * 64 + 32 * ks + 8 * fq);
                  ar = __builtin_amdgcn_mfma_f32_16x16x32_bf16(ba[ks], a, ar, 0, 0, 0); ai = __builtin_amdgcn_mfma_f32_16x16x32_bf16(bx[ks], a, ai, 0, 0, 0); }
              const int t = 16 * rb + fr;
              const u32x2 uw = *(const LAS u32x2*)(U + t * UP + ch4); const float uv[4] = {bflo(uw.x), bfhi(uw.x), bflo(uw.y), bfhi(uw.y)};
              float la[4], bc[4];
#pragma unroll
              for (int j = 0; j < 4; ++j) { const float r = sigmoidf_(ar[j] + bav[j]), ig = sigmoidf_(ai[j] + bxv[j]);
                  la[j] = -8.f * r * sp[j]; const float x2 = 2.f * la[j];
                  const float om = (x2 > -0.1f) ? -x2 * (1.f + x2 * (0.5f + x2 * (1.f / 6.f + x2 * (1.f / 24.f + x2 * (1.f / 120.f))))) : 1.f - __expf(x2);
                  bc[j] = __builtin_amdgcn_sqrtf(om) * ig * uv[j]; }
              u32x2 wa, wb; wa.x = cvtpk(la[0], la[1]); wa.y = cvtpk(la[2], la[3]); wb.x = cvtpk(bc[0], bc[1]); wb.y = cvtpk(bc[2], bc[3]);
              *(LAS u32x2*)(TLA + t * 256 + ch4) = wa; *(LAS u32x2*)(TLB + t * 256 + ch4) = wb;
              *(u32x2*)(LA + (size_t)(r0 + t) * 256 + ch4) = wa; *(u32x2*)(LB + (size_t)(r0 + t) * 256 + ch4) = wb; } } }
    __syncthreads();
    { const int c = tid & 255, qd = tid >> 8; constexpr int RH = nrows >> 1; float h = 0.f, sl = 0.f;
#pragma unroll
      for (int t = 0; t < RH; ++t) { const float la = bf2f(TLA[(qd * RH + t) * 256 + c]), bc = bf2f(TLB[(qd * RH + t) * 256 + c]); h = __expf(la) * h + bc; sl += la; }
      LAS float* XA = (LAS float*)U;
      __syncthreads();
      XA[(qd * 256 + c) * 2] = sl; XA[(qd * 256 + c) * 2 + 1] = h;
      __syncthreads();
      if (tid < 256) { const float s0 = XA[c * 2], h0 = XA[c * 2 + 1], s1 = XA[(256 + c) * 2], h1 = XA[(256 + c) * 2 + 1];
          AGGA[(size_t)aggidx * 256 + c] = s0 + s1; AGGB[(size_t)aggidx * 256 + c] = __expf(s1) * h0 + h1; } }
    __syncthreads();
}
DI void lru_carry(const Params& p, int b, int c) {
    const float* AGGA = (const float*)(p.ws + WS_LRU + LRU_AGGA); const float* AGGB = (const float*)(p.ws + WS_LRU + LRU_AGGB); float* HIN = (float*)(p.ws + WS_LRU + LRU_HIN);
    float h = AGGB[(size_t)(NB * NSEG) * 256 + c];
    for (int hf = 0; hf < 4; ++hf) {
        float a[32], bb[32];
#pragma unroll
        for (int s = 0; s < 32; ++s) { const size_t i = (size_t)(b * NSEG + hf * 32 + s) * 256 + c; a[s] = AGGA[i]; bb[s] = AGGB[i]; }
#pragma unroll
        for (int s = 0; s < 32; ++s) { const float hin = h; h = __expf(a[s]) * h + bb[s]; a[s] = hin; }
#pragma unroll
        for (int s = 0; s < 32; ++s) { const size_t i = (size_t)(b * NSEG + hf * 32 + s) * 256 + c; HIN[i] = a[s]; }
    }
}
template <int nrows> DI void lru_fix_unit(const Params& p, const Frame& F, int l, int r0, int aggidx, bool meta, float* gss) {
    const bf16_t* Z = (const bf16_t*)(p.ws + WS_Z); const bf16_t* LA = (const bf16_t*)(p.ws + WS_LRU + LRU_LA); const bf16_t* LB = (const bf16_t*)(p.ws + WS_LRU + LRU_BC);
    const float* HIN = (const float*)(p.ws + WS_LRU + LRU_HIN); bf16_t* Y = (bf16_t*)(p.ws + WS_BUFB);
    LAS float* AG = (LAS float*)F.lds;
    LAS float* red = (LAS float*)(F.lds + 8192);
    TID_VARS; constexpr int RQ = nrows >> 2; const int c2 = tid & 127, rq = tid >> 7;
    unsigned la2[RQ], bc2[RQ], ga2[RQ];
#pragma unroll
    for (int t = 0; t < RQ; ++t) { const size_t row = (size_t)(r0 + rq * RQ + t); la2[t] = *(const unsigned*)(LA + row * 256 + 2 * c2); bc2[t] = *(const unsigned*)(LB + row * 256 + 2 * c2); ga2[t] = *(const unsigned*)(Z + row * ZC + ZC_GA + 2 * c2); }
    float hin0 = 0.f, hin1 = 0.f; if (!meta) { const f32x2 hv = *(const f32x2*)(HIN + (size_t)aggidx * 256 + 2 * c2); hin0 = hv.x; hin1 = hv.y; }
    float hl0[RQ], hl1[RQ], ac0[RQ], ac1[RQ]; float h0 = 0.f, h1 = 0.f, A0 = 1.f, A1 = 1.f;
#pragma unroll
    for (int t = 0; t < RQ; ++t) { const float a0 = __expf(bflo(la2[t])), a1 = __expf(bfhi(la2[t])); h0 = a0 * h0 + bflo(bc2[t]); h1 = a1 * h1 + bfhi(bc2[t]); A0 *= a0; A1 *= a1; hl0[t] = h0; hl1[t] = h1; ac0[t] = A0; ac1[t] = A1; }
    *(LAS f32x4*)(AG + (rq * 128 + c2) * 4) = (f32x4){A0, h0, A1, h1};
    __syncthreads();
    for (int q = 0; q < rq; ++q) { const f32x4 v = *(const LAS f32x4*)(AG + (q * 128 + c2) * 4); hin0 = v[0] * hin0 + v[1]; hin1 = v[2] * hin1 + v[3]; }
#pragma unroll
    for (int t = 0; t < RQ; ++t) { const size_t row = (size_t)(r0 + rq * RQ + t);
        const float y0 = (hl0[t] + ac0[t] * hin0) * gelu_tanh(bflo(ga2[t])), y1 = (hl1[t] + ac1[t] * hin1) * gelu_tanh(bfhi(ga2[t]));
        const unsigned w = cvtpk(y0, y1); *(unsigned*)(Y + row * D + Y_LRU + 2 * c2) = w;
        const float z0 = bflo(w), z1 = bfhi(w); const float sv = wave_sum(z0 * z0 + z1 * z1); if (lane == 0) red[(rq * RQ + t) * 2 + (wave & 1)] = sv; }
    __syncthreads();
    if (tid < nrows) *(f32x4*)(gss + (size_t)(r0 + tid) * 16) = (f32x4){red[tid * 2] + red[tid * 2 + 1], 0.f, 0.f, 0.f};
    __syncthreads();
}


constexpr int HG_WL = 11776;
DI void hg_local_wave(const Params& p, LAS unsigned char* wl, int l, int r0, int nrows, int h, int slot, int lane) {
    bf16_t* Z = (bf16_t*)(p.ws + WS_Z);
    float* UT = (float*)(p.ws + WS_HG + HG_UT) + (size_t)slot * 4096; float* DL = (float*)(p.ws + WS_HG + HG_DL) + (size_t)slot * 64;
    LAS bf16_t* QD = (LAS bf16_t*)wl; LAS bf16_t* KD = QD + 16 * 72; LAS bf16_t* KET = KD + 16 * 72; LAS bf16_t* VT = KET + 64 * 24; LAS bf16_t* ATT = VT + 64 * 24; LAS float* DEC = (LAS float*)(ATT + 16 * 24);
    const int fr = lane & 15, g = lane >> 4;
    float lbv = 0.f;
    if (l == 1) { const float l0 = p.hg_lb_logits[h * 64 + lane], l1 = p.hg_lb_logits[256 + h * 64 + lane]; lbv = sigmoidf_(l1 - l0); }
    f32x4 S[4][4];
#pragma unroll
    for (int a = 0; a < 4; ++a)
#pragma unroll
        for (int b = 0; b < 4; ++b) S[a][b] = (f32x4){0.f, 0.f, 0.f, 0.f};
    float Bseg = 0.f;
    const bf16x8 zero8 = {0, 0, 0, 0, 0, 0, 0, 0};
    for (int c = 0; c < (nrows >> 4); ++c) {
        const int rc = r0 + 16 * c;
        float bsum = 0.f; float kdv[16];
#pragma unroll
        for (int t = 0; t < 16; ++t) {
            const size_t zo = (size_t)(rc + t) * ZC + 64 * h + lane;
            const float fz = bf2f(Z[zo + ZC_HF]), q = bf2f(Z[zo + ZC_HQ]); const bf16_t vraw = Z[zo + ZC_HV];
            const float sg = sigmoidf_(fz); const float f = lbv + (1.f - lbv) * sg; const float k = (1.f - lbv) * (1.f - sg);
            bsum += __logf(f);
            const float eb = __expf(bsum), enb = __expf(-bsum);
            QD[t * 72 + lane] = f2bf(q * eb); kdv[t] = k * enb; KD[t * 72 + lane] = f2bf(kdv[t]); VT[lane * 24 + t] = vraw;
            Z[zo + ZC_HQ] = f2bf(q * __expf(Bseg + bsum));
        }
        const float eend = __expf(bsum);
#pragma unroll
        for (int t = 0; t < 16; ++t) KET[lane * 24 + t] = f2bf(kdv[t] * eend);
        DEC[lane] = eend; Bseg += bsum;
        LDS_WAIT();
        f32x4 at = {0.f, 0.f, 0.f, 0.f};
#pragma unroll
        for (int ks = 0; ks < 2; ++ks) { const bf16x8 a = *(const LAS bf16x8*)(KD + fr * 72 + 32 * ks + 8 * g), b = *(const LAS bf16x8*)(QD + fr * 72 + 32 * ks + 8 * g);
            at = __builtin_amdgcn_mfma_f32_16x16x32_bf16(a, b, at, 0, 0, 0); }
#pragma unroll
        for (int j = 0; j < 4; ++j) if (4 * g + j > fr) at[j] = 0.f;
        { u32x2 w; w.x = cvtpk(at[0], at[1]); w.y = cvtpk(at[2], at[3]); *(LAS u32x2*)(ATT + fr * 24 + 4 * g) = w; }
        LDS_WAIT();
        const bf16x8 aatt = (g < 2) ? *(const LAS bf16x8*)(ATT + fr * 24 + 8 * g) : zero8;
        bf16x8 bv[4], aket[4];
#pragma unroll
        for (int i = 0; i < 4; ++i) { bv[i] = (g < 2) ? *(const LAS bf16x8*)(VT + (fr + 16 * i) * 24 + 8 * g) : zero8; aket[i] = (g < 2) ? *(const LAS bf16x8*)(KET + (fr + 16 * i) * 24 + 8 * g) : zero8; }
        f32x4 o[4];
#pragma unroll
        for (int cb = 0; cb < 4; ++cb) o[cb] = __builtin_amdgcn_mfma_f32_16x16x32_bf16(bv[cb], aatt, (f32x4){0.f, 0.f, 0.f, 0.f}, 0, 0, 0);
#pragma unroll
        for (int ks = 0; ks < 2; ++ks) {
            const u32x2 q0 = *(const LAS u32x2*)(QD + fr * 72 + 32 * ks + 4 * g), q1 = *(const LAS u32x2*)(QD + fr * 72 + 32 * ks + 16 + 4 * g);
            const bf16x8 aq = __builtin_bit_cast(bf16x8, (u32x4){q0.x, q0.y, q1.x, q1.y});
#pragma unroll
            for (int cb = 0; cb < 4; ++cb) { const f32x4 s0 = S[2 * ks][cb], s1 = S[2 * ks + 1][cb];
                const bf16x8 bs = __builtin_bit_cast(bf16x8, (u32x4){cvtpk(s0[0], s0[1]), cvtpk(s0[2], s0[3]), cvtpk(s1[0], s1[1]), cvtpk(s1[2], s1[3])});
                o[cb] = __builtin_amdgcn_mfma_f32_16x16x32_bf16(bs, aq, o[cb], 0, 0, 0); }
        }
#pragma unroll
        for (int cb = 0; cb < 4; ++cb) { u32x2 w; w.x = cvtpk(o[cb][0], o[cb][1]); w.y = cvtpk(o[cb][2], o[cb][3]); *(u32x2*)(Z + (size_t)(rc + fr) * ZC + ZC_HF + 64 * h + 16 * cb + 4 * g) = w; }
#pragma unroll
        for (int rb = 0; rb < 4; ++rb) { const f32x4 d4 = *(const LAS f32x4*)(DEC + 16 * rb + 4 * g);
#pragma unroll
            for (int cb = 0; cb < 4; ++cb) { const f32x4 u = __builtin_amdgcn_mfma_f32_16x16x32_bf16(aket[rb], bv[cb], (f32x4){0.f, 0.f, 0.f, 0.f}, 0, 0, 0); S[rb][cb] = S[rb][cb] * d4 + u; } }
        LDS_WAIT();
    }
#pragma unroll
    for (int rb = 0; rb < 4; ++rb)
#pragma unroll
        for (int cb = 0; cb < 4; ++cb) *(f32x4*)(UT + (fr + 16 * cb) * 64 + 16 * rb + 4 * g) = S[rb][cb];
    DL[lane] = Bseg;
}
DI void hg_carry_block(const Params& p, LAS unsigned char* lds, int bh, int part, int tid) {
    float* UT = (float*)(p.ws + WS_HG + HG_UT); const float* DL = (const float*)(p.ws + WS_HG + HG_DL);
    LAS float* DEC = (LAS float*)lds;
    for (int i = tid; i < 128 * 64; i += 512) DEC[i] = __expf(DL[(size_t)bh * 128 * 64 + i]);
    const int e = part * 512 + tid, dk = e & 63;
    float s = UT[(size_t)(2048 + (bh & 3)) * 4096 + e];
    __syncthreads();
    for (int hf = 0; hf < 2; ++hf) {
        float u[64];
#pragma unroll
        for (int i = 0; i < 64; ++i) u[i] = UT[(size_t)(bh * 128 + hf * 64 + i) * 4096 + e];
#pragma unroll
        for (int i = 0; i < 64; ++i) { const float sin_ = s; s = DEC[(hf * 64 + i) * 64 + dk] * s + u[i]; u[i] = sin_; }
#pragma unroll
        for (int i = 0; i < 64; ++i) UT[(size_t)(bh * 128 + hf * 64 + i) * 4096 + e] = u[i];
    }
    __syncthreads();
}
DI void hg_fix_wave(const Params& p, int r0, int nrows, int h, int slot, bool meta, float* gss, int lane) {
    const bf16_t* Z = (const bf16_t*)(p.ws + WS_Z); bf16_t* Y = (bf16_t*)(p.ws + WS_BUFB);
    const float* SI = (const float*)(p.ws + WS_HG + HG_UT) + (size_t)slot * 4096;
    const int fr = lane & 15, g = lane >> 4;
    bf16x8 bS[2][4];
    if (!meta) {
#pragma unroll
        for (int ks = 0; ks < 2; ++ks)
#pragma unroll
            for (int cb = 0; cb < 4; ++cb) { const f32x4 s0 = *(const f32x4*)(SI + (fr + 16 * cb) * 64 + 32 * ks + 8 * g), s1 = *(const f32x4*)(SI + (fr + 16 * cb) * 64 + 32 * ks + 8 * g + 4);
                bS[ks][cb] = __builtin_bit_cast(bf16x8, (u32x4){cvtpk(s0[0], s0[1]), cvtpk(s0[2], s0[3]), cvtpk(s1[0], s1[1]), cvtpk(s1[2], s1[3])}); }
    }
    for (int rbk = 0; rbk < (nrows >> 4); ++rbk) {
        f32x4 o[4];
#pragma unroll
        for (int cb = 0; cb < 4; ++cb) o[cb] = (f32x4){0.f, 0.f, 0.f, 0.f};
        if (!meta) {
#pragma unroll
            for (int ks = 0; ks < 2; ++ks) { const bf16x8 a = *(const bf16x8*)(Z + (size_t)(r0 + 16 * rbk + fr) * ZC + ZC_HQ + 64 * h + 32 * ks + 8 * g);
#pragma unroll
                for (int cb = 0; cb < 4; ++cb) o[cb] = __builtin_amdgcn_mfma_f32_16x16x32_bf16(bS[ks][cb], a, o[cb], 0, 0, 0); }
        }
        const size_t row = (size_t)(r0 + 16 * rbk + fr); float sq = 0.f;
#pragma unroll
        for (int cb = 0; cb < 4; ++cb) { const int col4 = 64 * h + 16 * cb + 4 * g;
            const u32x2 ow = *(const u32x2*)(Z + row * ZC + ZC_HF + col4), gw = *(const u32x2*)(Z + row * ZC + ZC_HG + col4);
            const float ol[4] = {bflo(ow.x), bfhi(ow.x), bflo(ow.y), bfhi(ow.y)}, gg[4] = {bflo(gw.x), bfhi(gw.x), bflo(gw.y), bfhi(gw.y)}; float val[4];
#pragma unroll
            for (int j = 0; j < 4; ++j) val[j] = (o[cb][j] + ol[j]) * (gg[j] * sigmoidf_(gg[j]));
            u32x2 w; w.x = cvtpk(val[0], val[1]); w.y = cvtpk(val[2], val[3]); *(u32x2*)(Y + row * D + Y_HG + col4) = w;
            const float z0 = bflo(w.x), z1 = bfhi(w.x), z2 = bflo(w.y), z3 = bfhi(w.y); sq += (z0 * z0 + z1 * z1) + (z2 * z2 + z3 * z3); }
        sq += __shfl_xor(sq, 16); sq += __shfl_xor(sq, 32);
        if (g == 0) gss[row * 16 + 4 + h] = sq;
    }
}

constexpr float LOG2E = 1.4426950408889634f;
constexpr float QS_FOX = 0.125f * LOG2E, QS_MLA = 0.10206207261596575f * LOG2E;
DI int row_pos(int row) { return row < NR ? 16 + (row & (SEQ - 1)) : row - MROW0; }
DI float swap_other(float x, bool domax) { auto rr = __builtin_amdgcn_permlane32_swap(__float_as_uint(x), __float_as_uint(x), false, false); const float a = __uint_as_float(rr[0]), b = __uint_as_float(rr[1]); return domax ? fmaxf(a, b) : a + b; }

template <int nrows> DI void fox_prep_unit(const Params& p, const Frame& F, int l, int r0) {
    TID_VARS; bf16_t* Z = (bf16_t*)(p.ws + WS_Z); bf16_t* FVT = (bf16_t*)(p.ws + WS_ATT + AT_FVT); float* FLF = (float*)(p.ws + WS_LRU + LRU_FLF);
    LAS bf16_t* VTILE = (LAS bf16_t*)F.lds;
    const int d0 = (4 * lane) & 63;
    const f32x4 gq = *(const f32x4*)(p.fox_gqn + l * 64 + d0), gk = *(const f32x4*)(p.fox_gkn + l * 64 + d0);
    { constexpr int NT = nrows / 8; u32x2 qw[NT], kw[NT], vw[NT]; float fx[NT];
#pragma unroll
      for (int i = 0; i < NT; ++i) { const size_t row = (size_t)(r0 + wave + 8 * i); qw[i] = *(const u32x2*)(Z + row * ZC + ZC_FQ + 4 * lane); kw[i] = *(const u32x2*)(Z + row * ZC + ZC_FK + 4 * lane); vw[i] = *(const u32x2*)(Z + row * ZC + ZC_FV + 4 * lane);
          fx[i] = bf2f(Z[row * ZC + ZC_FF + (lane & 3)]); }
#pragma unroll
      for (int i = 0; i < NT; ++i) { const int t = wave + 8 * i; const size_t row = (size_t)(r0 + t);
        { const u32x2 w = qw[i]; const float a0 = bflo(w.x), a1 = bfhi(w.x), a2 = bflo(w.y), a3 = bfhi(w.y);
          float ss = (a0 * a0 + a1 * a1) + (a2 * a2 + a3 * a3); ss += __shfl_xor(ss, 1); ss += __shfl_xor(ss, 2); ss += __shfl_xor(ss, 4); ss += __shfl_xor(ss, 8);
          const float rs = rsqrtf(ss * (1.f / 64.f) + EPS) * QS_FOX; u32x2 o; o.x = cvtpk(a0 * rs * gq[0], a1 * rs * gq[1]); o.y = cvtpk(a2 * rs * gq[2], a3 * rs * gq[3]); *(u32x2*)(Z + row * ZC + ZC_FQ + 4 * lane) = o; }
        { const u32x2 w = kw[i]; const float a0 = bflo(w.x), a1 = bfhi(w.x), a2 = bflo(w.y), a3 = bfhi(w.y);
          float ss = (a0 * a0 + a1 * a1) + (a2 * a2 + a3 * a3); ss += __shfl_xor(ss, 1); ss += __shfl_xor(ss, 2); ss += __shfl_xor(ss, 4); ss += __shfl_xor(ss, 8);
          const float rs = rsqrtf(ss * (1.f / 64.f) + EPS); u32x2 o; o.x = cvtpk(a0 * rs * gk[0], a1 * rs * gk[1]); o.y = cvtpk(a2 * rs * gk[2], a3 * rs * gk[3]); *(u32x2*)(Z + row * ZC + ZC_FK + 4 * lane) = o; }
        *(LAS u32x2*)(VTILE + t * 264 + 4 * lane) = vw[i];
        if (lane < 4) { const float x = fx[i] + p.fox_bf[l * 4 + lane]; const float ls = fminf(x, 0.f) - log1pf(__expf(-fabsf(x))); FLF[(size_t)lane * TM + row] = ls * LOG2E; } } }
    __syncthreads();
    { const int hd = tid & 255, half = tid >> 8, ng = nrows >> 4;
      for (int gi = half; gi < ng; gi += 2) { unsigned short v[16];
#pragma unroll
          for (int ko = 0; ko < 16; ++ko) v[8 * ((ko >> 2) & 1) + (ko & 3) + 4 * (ko >> 3)] = VTILE[(16 * gi + ko) * 264 + hd];
          u32x4 w0, w1; w0.x = v[0] | ((unsigned)v[1] << 16); w0.y = v[2] | ((unsigned)v[3] << 16); w0.z = v[4] | ((unsigned)v[5] << 16); w0.w = v[6] | ((unsigned)v[7] << 16);
          w1.x = v[8] | ((unsigned)v[9] << 16); w1.y = v[10] | ((unsigned)v[11] << 16); w1.z = v[12] | ((unsigned)v[13] << 16); w1.w = v[14] | ((unsigned)v[15] << 16);
          u32x4* dst = (u32x4*)(FVT + (size_t)hd * TM + r0 + 16 * gi); dst[0] = w0; dst[1] = w1; } }
    __syncthreads();
}
DI void fox_cscan_block(const Params& p, LAS unsigned char* lds, int l, int b, int h, int tid) {
    const float* FLF = (const float*)(p.ws + WS_LRU + LRU_FLF) + (size_t)h * TM; float* FC = (float*)(p.ws + WS_LRU + LRU_FC) + (size_t)h * TM;
    LAS float* wt = (LAS float*)lds;
    const int lane = tid & 63, wave = tid >> 6;
    float cm = 0.f;
    for (int i = 0; i < 16; ++i) { cm += FLF[MROW0 + i]; if (b == 0 && tid == 0) FC[MROW0 + i] = cm; }
    const f32x4* src = (const f32x4*)(FLF + (size_t)b * SEQ + 16 * tid); f32x4 v[4];
#pragma unroll
    for (int j = 0; j < 4; ++j) v[j] = src[j];
    float run = 0.f;
#pragma unroll
    for (int j = 0; j < 4; ++j) { run += v[j].x; v[j].x = run; run += v[j].y; v[j].y = run; run += v[j].z; v[j].z = run; run += v[j].w; v[j].w = run; }
    float inc = run;
#pragma unroll
    for (int o = 1; o < 64; o <<= 1) { const float t = __shfl_up(inc, o); if (lane >= o) inc += t; }
    if (lane == 63) wt[wave] = inc;
    __syncthreads();
    float base = cm + (inc - run);
    for (int w = 0; w < wave; ++w) base += wt[w];
    f32x4* dst = (f32x4*)(FC + (size_t)b * SEQ + 16 * tid);
    LAS f32x4* cl = (LAS f32x4*)(lds + 256);
#pragma unroll
    for (int j = 0; j < 4; ++j) { const f32x4 cvv = v[j] + base; dst[j] = cvv; cl[4 * tid + j] = cvv; }
    __syncthreads();
    if (tid < 32) { const LAS float* c1 = (const LAS float*)cl; const int qb = tid; float gq = 0.f, gk = 0.f;
        for (int i = 0; i < 64; ++i) { gq = fmaxf(gq, fabsf(p.fox_gqn[l * 64 + i])); gk = fmaxf(gk, fabsf(p.fox_gkn[l * 64 + i])); }
        const float T = 150.f + 12.f * gq * gk;
        const float cq0 = c1[256 * qb];
        int lo = 0, hi = 4 * qb;
        while (lo < hi) { const int mid = (lo + hi) >> 1; if (cq0 - c1[64 * mid + 63] >= -T) hi = mid; else lo = mid + 1; }
        const bool meta_on = (cq0 - cm) >= -T;
        ((int*)(p.ws + WS_LRU + LRU_FJ0))[(h * NB + b) * 32 + qb] = meta_on ? 0 : ((1 + lo) & ~1); }
    __syncthreads();
}
DI void mla_prep_unit(const Params& p, const Frame& F, int l, int r0, int nrows, int part, int hp) {
    TID_VARS; const bf16_t* Z = (const bf16_t*)(p.ws + WS_Z);
    bf16_t* MQ = (bf16_t*)(p.ws + WS_ATT + AT_MQ); bf16_t* MK = (bf16_t*)(p.ws + WS_ATT + AT_MK); bf16_t* MVT = (bf16_t*)(p.ws + WS_ATT + AT_MVT);
    const float* ROPE = (const float*)(p.ws + WS_HG + HG_ROPE);
    const int KW = part ? 128 : 192, WP = KW + 8, NWR = part ? 256 : 192, CH = KW / 8;
    const bf16_t* Wg = part ? (const bf16_t*)(p.ws + WS_WSM + SM_WUKV) + (size_t)l * 512 * 128 + (size_t)256 * hp * 128 : (const bf16_t*)(p.ws + WS_WSM + SM_WUQ) + (size_t)l * 384 * 192 + (size_t)192 * hp * 192;
    LAS bf16_t* WL = (LAS bf16_t*)F.lds;
    LAS bf16_t* AT = WL + 192 * 200;
    LAS bf16_t* KR = AT + 128 * 200;
    LAS float* RS = (LAS float*)(KR + 128 * 40);
    const int zc0 = part ? ZC_CKV : ZC_CQ;
    { u32x4 wv[10], av[7];
#pragma unroll
      for (int i = 0; i < 10; ++i) { const int c = tid + 512 * i; wv[i] = (u32x4){0u, 0u, 0u, 0u}; if (c < NWR * CH) wv[i] = *(const u32x4*)(Wg + (size_t)(c / CH) * KW + 8 * (c % CH)); }
#pragma unroll
      for (int i = 0; i < 7; ++i) { const int c = tid + 512 * i; av[i] = (u32x4){0u, 0u, 0u, 0u}; if (c < nrows * CH) av[i] = *(const u32x4*)(Z + (size_t)(r0 + c / CH) * ZC + zc0 + 8 * (c % CH)); }
      u32x4 kv = {0u, 0u, 0u, 0u}; if (part && tid < nrows * 4) kv = *(const u32x4*)(Z + (size_t)(r0 + (tid >> 2)) * ZC + ZC_KR + 8 * (tid & 3));
#pragma unroll
      for (int i = 0; i < 10; ++i) { const int c = tid + 512 * i; if (c < NWR * CH) *(LAS u32x4*)(WL + (c / CH) * WP + 8 * (c % CH)) = wv[i]; }
#pragma unroll
      for (int i = 0; i < 7; ++i) { const int c = tid + 512 * i; if (c < nrows * CH) *(LAS u32x4*)(AT + (c / CH) * WP + 8 * (c % CH)) = av[i]; }
      if (part && tid < nrows * 4) *(LAS u32x4*)(KR + (tid >> 2) * 40 + 8 * (tid & 3)) = kv; }
    __syncthreads();
    { const int row = tid >> 2, qd = tid & 3, nq = KW / 4; float ss = 0.f;
      if (row < nrows) { for (int c = 0; c < nq; c += 8) { const u32x4 w = *(const LAS u32x4*)(AT + row * WP + qd * nq + c);
            ss += (bflo(w.x) * bflo(w.x) + bfhi(w.x) * bfhi(w.x)) + (bflo(w.y) * bflo(w.y) + bfhi(w.y) * bfhi(w.y)) + (bflo(w.z) * bflo(w.z) + bfhi(w.z) * bfhi(w.z)) + (bflo(w.w) * bflo(w.w) + bfhi(w.w) * bfhi(w.w)); } }
      ss += __shfl_xor(ss, 1); ss += __shfl_xor(ss, 2);
      if (qd == 0 && row < nrows) RS[row] = rsqrtf(ss / (float)KW + EPS); }
    __syncthreads();
    const int hh = wave & 1, rbp = wave >> 1, h = 2 * hp + hh, fr = lane & 15, g = lane >> 4; const int nrb = nrows >> 4;
    const int rb0 = 2 * rbp; const bool two = rb0 + 1 < nrb;
    if (rb0 < nrb) {
      if (part == 0) {
        f32x4 acc[2][6];
#pragma unroll
        for (int r = 0; r < 2; ++r)
#pragma unroll
            for (int i = 0; i < 6; ++i) acc[r][i] = (f32x4){0.f, 0.f, 0.f, 0.f};
#pragma unroll
        for (int ks = 0; ks < 6; ++ks) { const bf16x8 a0 = *(const LAS bf16x8*)(AT + (16 * rb0 + fr) * 200 + 32 * ks + 8 * g), a1 = *(const LAS bf16x8*)(AT + (16 * (two ? rb0 + 1 : rb0) + fr) * 200 + 32 * ks + 8 * g);
#pragma unroll
            for (int i = 0; i < 6; ++i) { const bf16x8 bw = *(const LAS bf16x8*)(WL + (96 * hh + 16 * i + fr) * 200 + 32 * ks + 8 * g);
                acc[0][i] = __builtin_amdgcn_mfma_f32_16x16x32_bf16(bw, a0, acc[0][i], 0, 0, 0); acc[1][i] = __builtin_amdgcn_mfma_f32_16x16x32_bf16(bw, a1, acc[1][i], 0, 0, 0); } }
        f32x4 gq[6];
#pragma unroll
        for (int i = 0; i < 6; ++i) gq[i] = *(const f32x4*)(p.mla_gqn + l * 96 + 16 * i + 4 * g);
#pragma unroll
        for (int r = 0; r < 2; ++r) { if (r == 1 && !two) break;
            const int t = 16 * (rb0 + r) + fr; const int pos = row_pos(r0 + t);
            const f32x4 rc0 = *(const f32x4*)(ROPE + ((size_t)pos * 16 + 4 * g) * 2), rc1 = *(const f32x4*)(ROPE + ((size_t)pos * 16 + 4 * g) * 2 + 4);
            const float cs[4] = {rc0[0], rc0[2], rc1[0], rc1[2]}, sn[4] = {rc0[1], rc0[3], rc1[1], rc1[3]};
            const float rq = RS[t]; float ss = 0.f;
#pragma unroll
            for (int i = 0; i < 6; ++i) { acc[r][i] = acc[r][i] * rq; ss += (acc[r][i][0] * acc[r][i][0] + acc[r][i][1] * acc[r][i][1]) + (acc[r][i][2] * acc[r][i][2] + acc[r][i][3] * acc[r][i][3]); }
            ss += __shfl_xor(ss, 16); ss += __shfl_xor(ss, 32);
            const float rn = rsqrtf(ss * (1.f / 96.f) + EPS);
#pragma unroll
            for (int i = 0; i < 6; ++i) acc[r][i] = acc[r][i] * gq[i] * rn;
#pragma unroll
            for (int j = 0; j < 4; ++j) { const float t1 = acc[r][4][j], t2 = acc[r][5][j]; acc[r][4][j] = t1 * cs[j] - t2 * sn[j]; acc[r][5][j] = t1 * sn[j] + t2 * cs[j]; }
            bf16_t* dst = MQ + (size_t)(r0 + t) * 384 + 96 * h + 4 * g;
#pragma unroll
            for (int i = 0; i < 6; ++i) { u32x2 w; w.x = cvtpk(acc[r][i][0] * QS_MLA, acc[r][i][1] * QS_MLA); w.y = cvtpk(acc[r][i][2] * QS_MLA, acc[r][i][3] * QS_MLA); *(u32x2*)(dst + 16 * i) = w; } }
      } else {
        f32x4 acc[2][4], accv[2][4];
#pragma unroll
        for (int r = 0; r < 2; ++r)
#pragma unroll
            for (int i = 0; i < 4; ++i) { acc[r][i] = (f32x4){0.f, 0.f, 0.f, 0.f}; accv[r][i] = (f32x4){0.f, 0.f, 0.f, 0.f}; }
#pragma unroll
        for (int ks = 0; ks < 4; ++ks) { const bf16x8 a0 = *(const LAS bf16x8*)(AT + (16 * rb0 + fr) * 136 + 32 * ks + 8 * g), a1 = *(const LAS bf16x8*)(AT + (16 * (two ? rb0 + 1 : rb0) + fr) * 136 + 32 * ks + 8 * g);
#pragma unroll
            for (int i = 0; i < 4; ++i) { const bf16x8 bw = *(const LAS bf16x8*)(WL + (128 * hh + 16 * i + fr) * 136 + 32 * ks + 8 * g), bv2 = *(const LAS bf16x8*)(WL + (128 * hh + 64 + 16 * i + fr) * 136 + 32 * ks + 8 * g);
                acc[0][i] = __builtin_amdgcn_mfma_f32_16x16x32_bf16(bw, a0, acc[0][i], 0, 0, 0); acc[1][i] = __builtin_amdgcn_mfma_f32_16x16x32_bf16(bw, a1, acc[1][i], 0, 0, 0);
                accv[0][i] = __builtin_amdgcn_mfma_f32_16x16x32_bf16(a0, bv2, accv[0][i], 0, 0, 0); accv[1][i] = __builtin_amdgcn_mfma_f32_16x16x32_bf16(a1, bv2, accv[1][i], 0, 0, 0); } }
        f32x4 gk[6];
#pragma unroll
        for (int i = 0; i < 6; ++i) gk[i] = *(const f32x4*)(p.mla_gkn + l * 96 + 16 * i + 4 * g);
#pragma unroll
        for (int r = 0; r < 2; ++r) { if (r == 1 && !two) break;
            const int rb = rb0 + r; const int t = 16 * rb + fr; const int pos = row_pos(r0 + t);
            const f32x4 rc0 = *(const f32x4*)(ROPE + ((size_t)pos * 16 + 4 * g) * 2), rc1 = *(const f32x4*)(ROPE + ((size_t)pos * 16 + 4 * g) * 2 + 4);
            const float cs[4] = {rc0[0], rc0[2], rc1[0], rc1[2]}, sn[4] = {rc0[1], rc0[3], rc1[1], rc1[3]};
            const float rk = RS[t]; float ss = 0.f;
#pragma unroll
            for (int i = 0; i < 4; ++i) { acc[r][i] = acc[r][i] * rk; ss += (acc[r][i][0] * acc[r][i][0] + acc[r][i][1] * acc[r][i][1]) + (acc[r][i][2] * acc[r][i][2] + acc[r][i][3] * acc[r][i][3]); }
            const u32x2 k1w = *(const LAS u32x2*)(KR + t * 40 + 4 * g), k2w = *(const LAS u32x2*)(KR + t * 40 + 16 + 4 * g);
            f32x4 k1 = {bflo(k1w.x), bfhi(k1w.x), bflo(k1w.y), bfhi(k1w.y)}, k2 = {bflo(k2w.x), bfhi(k2w.x), bflo(k2w.y), bfhi(k2w.y)};
            ss += (k1[0] * k1[0] + k1[1] * k1[1]) + (k1[2] * k1[2] + k1[3] * k1[3]) + (k2[0] * k2[0] + k2[1] * k2[1]) + (k2[2] * k2[2] + k2[3] * k2[3]);
            ss += __shfl_xor(ss, 16); ss += __shfl_xor(ss, 32);
            const float rn = rsqrtf(ss * (1.f / 96.f) + EPS);
#pragma unroll
            for (int i = 0; i < 4; ++i) acc[r][i] = acc[r][i] * gk[i] * rn;
            k1 = k1 * gk[4] * rn; k2 = k2 * gk[5] * rn;
            f32x4 o1, o2;
#pragma unroll
            for (int j = 0; j < 4; ++j) { o1[j] = k1[j] * cs[j] - k2[j] * sn[j]; o2[j] = k1[j] * sn[j] + k2[j] * cs[j]; }
            bf16_t* dst = MK + (size_t)(r0 + t) * 384 + 96 * h + 4 * g;
#pragma unroll
            for (int i = 0; i < 4; ++i) { u32x2 w; w.x = cvtpk(acc[r][i][0], acc[r][i][1]); w.y = cvtpk(acc[r][i][2], acc[r][i][3]); *(u32x2*)(dst + 16 * i) = w; }
            { u32x2 w; w.x = cvtpk(o1[0], o1[1]); w.y = cvtpk(o1[2], o1[3]); *(u32x2*)(dst + 64) = w; w.x = cvtpk(o2[0], o2[1]); w.y = cvtpk(o2[2], o2[3]); *(u32x2*)(dst + 80) = w; }
            const float r0k = RS[16 * rb + 4 * g], r1k = RS[16 * rb + 4 * g + 1], r2k = RS[16 * rb + 4 * g + 2], r3k = RS[16 * rb + 4 * g + 3];
#pragma unroll
            for (int i = 0; i < 4; ++i) { u32x2 w; w.x = cvtpk(accv[r][i][0] * r0k, accv[r][i][1] * r1k); w.y = cvtpk(accv[r][i][2] * r2k, accv[r][i][3] * r3k);
                *(u32x2*)(MVT + (size_t)(64 * h + 16 * i + fr) * TM + r0 + 16 * rb + 8 * (g & 1) + 4 * (g >> 1)) = w; } }
      }
    }
    __syncthreads();
}

DI int crow(int r, int hi) { return (r & 3) + 8 * (r >> 2) + 4 * hi; }
template <int DK, bool FOX>
DI void attn_unit(LAS unsigned char* lds, const bf16_t* Qp, int qpitch, const bf16_t* Kp, int kpitch, const bf16_t* VT, const float* C, bf16_t* Yp, float* gss, int grp, int hslot, int b, int qb, int jt0) {
    TID_VARS; const int r32 = lane & 31, hi = lane >> 5;
    constexpr int KC = DK / 8, KP = DK + 8, NKS = DK / 16;
    constexpr int KB_BYTES = 64 * KP * 2, VB_BYTES = 64 * 72 * 2, BUF_BYTES = KB_BYTES + VB_BYTES + 256;
    const bool meta = qb < 0;
    const int q0 = meta ? MB0 : b * SEQ + 256 * qb;
    const int NT = meta ? 1 : 1 + 4 * (qb + 1);
    const int qrow = q0 + 32 * wave + r32;
    const bool wave_on = !meta || wave < 2;
    bf16x8 qf[NKS];
#pragma unroll
    for (int ks = 0; ks < NKS; ++ks) qf[ks] = *(const GAS bf16x8*)(Qp + (size_t)qrow * qpitch + 16 * ks + 8 * hi);
    float cq = 0.f; if (FOX) cq = C[qrow];
    bf16x8 bqx = {0, 0, 0, 0, 0, 0, 0, 0};
    if (FOX) { const unsigned h1 = cvtpk(cq, 0.f) & 0xffffu; const float r1 = cq - __uint_as_float(h1 << 16);
        const unsigned h2 = cvtpk(r1, 0.f) & 0xffffu; const float r2 = r1 - __uint_as_float(h2 << 16); const unsigned h3 = cvtpk(r2, 0.f) & 0xffffu;
        u32x4 bw = {0x3f803f80u, 0x3f80u | (h1 << 16), h2 | (h3 << 16), 0u};
        if (hi) bw = (u32x4){0u, 0u, 0u, 0u};
        bqx = __builtin_bit_cast(bf16x8, bw); }
    f32x16 o0 = {0.f, 0.f, 0.f, 0.f, 0.f, 0.f, 0.f, 0.f, 0.f, 0.f, 0.f, 0.f, 0.f, 0.f, 0.f, 0.f}, o1 = o0;
    float m = 0.f, lsum = 0.f;
    u32x4 kreg0, kreg1 = {0u, 0u, 0u, 0u}, vreg, creg = {0u, 0u, 0u, 0u};
#define AT_LOAD(jt_) do { const int tr_ = ((jt_) == 0) ? MB0 : b * SEQ + 64 * ((jt_) - 1); \
        kreg0 = *(const GAS u32x4*)(Kp + (size_t)(tr_ + tid / KC) * kpitch + 8 * (tid % KC)); \
        if (DK == 96 && tid < 256) kreg1 = *(const GAS u32x4*)(Kp + (size_t)(tr_ + (512 + tid) / KC) * kpitch + 8 * ((512 + tid) % KC)); \
        vreg = *(const GAS u32x4*)(VT + (size_t)(tid >> 3) * TM + tr_ + 8 * (tid & 7)); \
        if (FOX && tid < 16) creg = *(const GAS u32x4*)(C + tr_ + 4 * tid); } while (0)
#define AT_STORE(buf_) do { LAS unsigned char* bb_ = lds + (buf_) * BUF_BYTES; \
        *(LAS u32x4*)(bb_ + ((tid / KC) * KP + 8 * (tid % KC)) * 2) = kreg0; \
        if (DK == 96 && tid < 256) *(LAS u32x4*)(bb_ + (((512 + tid) / KC) * KP + 8 * ((512 + tid) % KC)) * 2) = kreg1; \
        *(LAS u32x4*)(bb_ + KB_BYTES + ((tid >> 3) * 72 + 8 * (tid & 7)) * 2) = vreg; \
        if (FOX && tid < 16) *(LAS u32x4*)(bb_ + KB_BYTES + VB_BYTES + 16 * tid) = creg; } while (0)
#define AT_LOADX(K0, K1, V, CR, jt_) do { const int tr_ = ((jt_) == 0) ? MB0 : b * SEQ + 64 * ((jt_) - 1); \
        K0 = *(const GAS u32x4*)(Kp + (size_t)(tr_ + tid / KC) * kpitch + 8 * (tid % KC)); \
        if (DK == 96 && tid < 256) K1 = *(const GAS u32x4*)(Kp + (size_t)(tr_ + (512 + tid) / KC) * kpitch + 8 * ((512 + tid) % KC)); \
        V = *(const GAS u32x4*)(VT + (size_t)(tid >> 3) * TM + tr_ + 8 * (tid & 7)); \
        if (FOX && tid < 16) CR = *(const GAS u32x4*)(C + tr_ + 4 * tid); } while (0)
#define AT_STOREX(K0, K1, V, CR, buf_) do { LAS unsigned char* bb_ = lds + (buf_) * BUF_BYTES; \
        *(LAS u32x4*)(bb_ + ((tid / KC) * KP + 8 * (tid % KC)) * 2) = K0; \
        if (DK == 96 && tid < 256) *(LAS u32x4*)(bb_ + (((512 + tid) / KC) * KP + 8 * ((512 + tid) % KC)) * 2) = K1; \
        *(LAS u32x4*)(bb_ + KB_BYTES + ((tid >> 3) * 72 + 8 * (tid & 7)) * 2) = V; \
        if (FOX && tid < 16) *(LAS u32x4*)(bb_ + KB_BYTES + VB_BYTES + 16 * tid) = CR; } while (0)
#define AT_COMPUTE(jt) do { \
        bool vis = wave_on, elem = false; const int jr = jt - 1; const int qlo = 256 * qb + 32 * wave; \
        if (jt > 0) { if (FOX) { if (64 * jr > qlo + 31) vis = false; else elem = (64 * jr + 63 > qlo); } else { if (jr > (qlo >> 6)) vis = false; } } \
        if (vis) { \
            const LAS unsigned char* bb = lds + (jt & 1) * BUF_BYTES; \
 \
            f32x16 s0 = {0.f, 0.f, 0.f, 0.f, 0.f, 0.f, 0.f, 0.f, 0.f, 0.f, 0.f, 0.f, 0.f, 0.f, 0.f, 0.f}, s1 = s0; \
_Pragma("unroll") \
            for (int ks = 0; ks < NKS; ++ks) { const bf16x8 a0 = *(const LAS bf16x8*)(bb + (r32 * KP + 16 * ks + 8 * hi) * 2), a1 = *(const LAS bf16x8*)(bb + ((32 + r32) * KP + 16 * ks + 8 * hi) * 2); \
                s0 = __builtin_amdgcn_mfma_f32_32x32x16_bf16(a0, qf[ks], s0, 0, 0, 0); s1 = __builtin_amdgcn_mfma_f32_32x32x16_bf16(a1, qf[ks], s1, 0, 0, 0); } \
            if (FOX) { \
                const LAS float* cb = (const LAS float*)(bb + KB_BYTES + VB_BYTES); \
_Pragma("unroll") \
                for (int kb = 0; kb < 2; ++kb) { const float cv = -cb[32 * kb + r32]; \
                    const unsigned h1 = cvtpk(cv, 0.f) & 0xffffu; const float r1 = cv - __uint_as_float(h1 << 16); \
                    const unsigned h2 = cvtpk(r1, 0.f) & 0xffffu; const float r2 = r1 - __uint_as_float(h2 << 16); \
                    const unsigned h3 = cvtpk(r2, 0.f) & 0xffffu; \
                    u32x4 aw = {h1 | (h2 << 16), h3 | 0x3f800000u, 0x3f803f80u, 0u}; \
                    if (hi) aw = (u32x4){0u, 0u, 0u, 0u}; \
                    const bf16x8 ax = __builtin_bit_cast(bf16x8, aw); \
                    if (kb == 0) s0 = __builtin_amdgcn_mfma_f32_32x32x16_bf16(ax, bqx, s0, 0, 0, 0); else s1 = __builtin_amdgcn_mfma_f32_32x32x16_bf16(ax, bqx, s1, 0, 0, 0); } } \
            if (__any(m != 0.f)) { \
_Pragma("unroll") \
                for (int r = 0; r < 16; ++r) { s0[r] -= m; s1[r] -= m; } } \
            if (jt == 0 || elem) { \
_Pragma("unroll") \
                for (int r = 0; r < 16; ++r) { const int k0 = crow(r, hi), k1 = 32 + k0; bool ok0, ok1; \
                    if (jt == 0) { ok0 = false; ok1 = k1 >= 48; if (FOX && meta) ok1 = ok1 && (k1 <= 32 * wave + r32); } \
                    else { ok0 = (64 * jr + k0 <= qlo + r32); ok1 = (64 * jr + k1 <= qlo + r32); } \
                    s0[r] = ok0 ? s0[r] : -INFINITY; s1[r] = ok1 ? s1[r] : -INFINITY; } \
            } \
            float ta = __builtin_fmaxf(__builtin_fmaxf(s0[0], s0[1]), s1[0]), tb = __builtin_fmaxf(__builtin_fmaxf(s0[2], s0[3]), s1[1]); ta = __builtin_fmaxf(__builtin_fmaxf(ta, s1[2]), s1[3]); \
_Pragma("unroll") \
            for (int r = 4; r < 16; r += 4) { ta = __builtin_fmaxf(__builtin_fmaxf(ta, s0[r]), s0[r + 1]); tb = __builtin_fmaxf(__builtin_fmaxf(tb, s0[r + 2]), s0[r + 3]); ta = __builtin_fmaxf(__builtin_fmaxf(ta, s1[r]), s1[r + 1]); tb = __builtin_fmaxf(__builtin_fmaxf(tb, s1[r + 2]), s1[r + 3]); } \
            const float tmax = swap_other(__builtin_fmaxf(ta, tb), true); \
            if (__any(tmax > 8.f)) { \
                const float dl = tmax > 8.f ? tmax : 0.f; m += dl; const float al = __builtin_amdgcn_exp2f(-dl); lsum *= al; \
_Pragma("unroll") \
                for (int r = 0; r < 16; ++r) { s0[r] -= dl; s1[r] -= dl; o0[r] *= al; o1[r] *= al; } } \
            float ps0 = 0.f, ps1 = 0.f; \
_Pragma("unroll") \
            for (int r = 0; r < 16; ++r) { s0[r] = __builtin_amdgcn_exp2f(s0[r]); s1[r] = __builtin_amdgcn_exp2f(s1[r]); ps0 += s0[r]; ps1 += s1[r]; } \
            lsum += ps0 + ps1; \
            const LAS unsigned char* vb = bb + KB_BYTES; \
_Pragma("unroll") \
            for (int kb = 0; kb < 2; ++kb) \
_Pragma("unroll") \
                for (int hf = 0; hf < 2; ++hf) { u32x4 pw; \
                    if (kb == 0) { pw.x = cvtpk(s0[8 * hf + 0], s0[8 * hf + 1]); pw.y = cvtpk(s0[8 * hf + 2], s0[8 * hf + 3]); pw.z = cvtpk(s0[8 * hf + 4], s0[8 * hf + 5]); pw.w = cvtpk(s0[8 * hf + 6], s0[8 * hf + 7]); } \
                    else { pw.x = cvtpk(s1[8 * hf + 0], s1[8 * hf + 1]); pw.y = cvtpk(s1[8 * hf + 2], s1[8 * hf + 3]); pw.z = cvtpk(s1[8 * hf + 4], s1[8 * hf + 5]); pw.w = cvtpk(s1[8 * hf + 6], s1[8 * hf + 7]); } \
                    const bf16x8 pb = __builtin_bit_cast(bf16x8, pw); \
                    const bf16x8 v0 = *(const LAS bf16x8*)(vb + (r32 * 72 + 32 * kb + 16 * hf + 8 * hi) * 2), v1 = *(const LAS bf16x8*)(vb + ((32 + r32) * 72 + 32 * kb + 16 * hf + 8 * hi) * 2); \
                    o0 = __builtin_amdgcn_mfma_f32_32x32x16_bf16(v0, pb, o0, 0, 0, 0); o1 = __builtin_amdgcn_mfma_f32_32x32x16_bf16(v1, pb, o1, 0, 0, 0); } \
        } \
    } while (0)
    u32x4 kB0 = kreg0, kB1 = kreg1, vB = vreg, cB = creg;
    AT_LOADX(kreg0, kreg1, vreg, creg, jt0); AT_STOREX(kreg0, kreg1, vreg, creg, 0); if (jt0 + 1 < NT) AT_LOADX(kreg0, kreg1, vreg, creg, jt0 + 1);
    __syncthreads();
    for (int jt = jt0; jt < NT; jt += 2) {
        if (jt + 2 < NT) AT_LOADX(kB0, kB1, vB, cB, jt + 2);
        AT_COMPUTE(jt);
        if (jt + 1 < NT) AT_STOREX(kreg0, kreg1, vreg, creg, (jt + 1) & 1);
        __syncthreads();
        if (jt + 1 >= NT) break;
        if (jt + 3 < NT) AT_LOADX(kreg0, kreg1, vreg, creg, jt + 3);
        { const int j1 = jt + 1; AT_COMPUTE(j1); }
        if (jt + 2 < NT) AT_STOREX(kB0, kB1, vB, cB, (jt + 2) & 1);
        __syncthreads();
    }
#undef AT_LOADX
#undef AT_STOREX
#undef AT_COMPUTE
#undef AT_LOAD
#undef AT_STORE
    if (wave_on) {
        const float lt = swap_other(lsum, false); const float inv = lt > 0.f ? 1.f / lt : 0.f;
        const bool valid = !meta || (32 * wave + r32 >= META_OFF);
        float sq = 0.f; bf16_t* yrow = Yp + (size_t)qrow * D;
#pragma unroll
        for (int db = 0; db < 2; ++db)
#pragma unroll
            for (int i = 0; i < 4; ++i) { float y0, y1, y2, y3;
                if (db == 0) { y0 = o0[4 * i] * inv; y1 = o0[4 * i + 1] * inv; y2 = o0[4 * i + 2] * inv; y3 = o0[4 * i + 3] * inv; } else { y0 = o1[4 * i] * inv; y1 = o1[4 * i + 1] * inv; y2 = o1[4 * i + 2] * inv; y3 = o1[4 * i + 3] * inv; }
                u32x2 w; w.x = cvtpk(y0, y1); w.y = cvtpk(y2, y3);
                if (valid) *(u32x2*)(yrow + 32 * db + 8 * i + 4 * hi) = w;
                const float z0 = bflo(w.x), z1 = bfhi(w.x), z2 = bflo(w.y), z3 = bfhi(w.y); sq += (z0 * z0 + z1 * z1) + (z2 * z2 + z3 * z3); }
        sq = swap_other(sq, false);
        if (hi == 0 && valid) gss[(size_t)qrow * 16 + 4 * grp + hslot] = sq;
    }
}
DI void attn_dispatch(const Params& p, const Frame& F, int mixer, int b, int h, int qb, float* gss) {
    bf16_t* Y = (bf16_t*)(p.ws + WS_BUFB);
    if (mixer == 0) { const bf16_t* MQ = (const bf16_t*)(p.ws + WS_ATT + AT_MQ) + 96 * h; const bf16_t* MK = (const bf16_t*)(p.ws + WS_ATT + AT_MK) + 96 * h; const bf16_t* MVT = (const bf16_t*)(p.ws + WS_ATT + AT_MVT) + (size_t)64 * h * TM;
        attn_unit<96, false>(F.lds, MQ, 384, MK, 384, MVT, nullptr, Y + Y_MLA + 64 * h, gss, 2, h, b, qb, 0); }
    else { const bf16_t* Z = (const bf16_t*)(p.ws + WS_Z); const bf16_t* FVT = (const bf16_t*)(p.ws + WS_ATT + AT_FVT) + (size_t)64 * h * TM; const float* FC = (const float*)(p.ws + WS_LRU + LRU_FC) + (size_t)h * TM;
        const int jt0 = qb < 0 ? 0 : __builtin_amdgcn_readfirstlane(((const int*)(p.ws + WS_LRU + LRU_FJ0))[(h * NB + b) * 32 + qb]);
        attn_unit<64, true>(F.lds, Z + ZC_FQ + 64 * h, ZC, Z + ZC_FK + 64 * h, ZC, FVT, FC, Y + Y_FOX + 64 * h, gss, 3, h, b, qb, jt0); }
}

__global__ void __launch_bounds__(512, 2) hymba_fwd(Params p) {
    extern __shared__ __attribute__((aligned(16))) unsigned char lds_raw[];
    Frame F; F.lds = (LAS unsigned char*)lds_raw;
    F.G = gridDim.x; { const int bx = blockIdx.x; F.vcu = (F.G % 8 == 0) ? (bx % 8) * (F.G / 8) + bx / 8 : bx; }
    volatile LAS unsigned* MISC = (volatile LAS unsigned*)(F.lds + MISC_OFF);
    { const int t0 = threadIdx.x; if (t0 < 64) MISC[t0] = 0u;
      if ((t0 & 63) == 0) *(volatile LAS int*)(unsigned)(TIDTAB_LDS + 4 * (int)(__builtin_amdgcn_s_getreg((5 << 11) | 4) & 63u)) = t0 >> 6; }
    __syncthreads();
    unsigned* ctl = (unsigned*)(p.ws + WS_CTL);
    XcdBarrier bar = xcd_barrier_post(ctl + CW_BAR, MISC + 8);
    LAS float* gstab = (LAS float*)(F.lds + GST_OFF);
#define PHASE_PARAMS Params pp = p; Frame FF = F; int bid = blockIdx.x; { unsigned char* w_ = p.ws; asm volatile("" : "+s"(w_), "+s"(FF.vcu), "+s"(FF.G), "+s"(bid)); pp.ws = w_; } (void)pp; (void)bid
#define ssb ((float*)(pp.ws + WS_CTL) + CW_SS)
#define ss_in0 ((float*)(pp.ws + WS_WSM + 786432))
#define gssb ((float*)(pp.ws + WS_GSP))
#define ssp0 ((float*)(pp.ws + WS_SSP))
#define ssp1 ((float*)(pp.ws + WS_SSP) + (size_t)NR * 16)
#define hmeta2 ((float*)(pp.ws + WS_HMETA) + 16 * D)
#define bufA ((bf16_t*)(pp.ws + WS_BUFA))
#define bufB ((bf16_t*)(pp.ws + WS_BUFB))
#define Zb ((bf16_t*)(pp.ws + WS_Z))
#define hmeta ((float*)(pp.ws + WS_HMETA))

    { PHASE_PARAMS; p0_prologue(pp, FF, ss_in0); }
    xcd_barrier(bar);

    for (int l = 0; l < NLAYER; ++l) {
#define ss1 ((l == 0) ? ss_in0 : ssb + TM)
#define gss (gssb + (size_t)l * TM * 16)
        { PHASE_PARAMS; SchedPlain S{(const char*)bufA, (const char*)(pp.ws + WS_WIN + (size_t)l * ZC * D * 2), D, D, l == 0 ? 129 : 128, 11, FF.G, bid};
          { TID_VARS; fill_rs_table(S, l == 0 ? ss_in0 : ssp1, l == 0 ? 1 : 16, gstab, tid); }
          EpiZ E{Zb};
          pg8::gemm_phase<EpiZ, SchedPlain, false, false>(FF.lds, D, D, S, E, gstab);
          if (l == 0) { const int B = FF.G >> 3, U8 = (129 * 11 + 7) >> 3, last = ((U8 + B - 1) / B - 1) * B;
              int rank = 0, nidle = 0, mine = 0;
              for (int x = 0; x < 8; ++x) { int a = S.xcnt(x) - last; a = a < 0 ? 0 : (a > B ? B : a); if (x < (bid & 7)) rank += B - a; if (x == (bid & 7)) mine = a; nidle += B - a; }
              if ((bid >> 3) >= mine) { TID_VARS; convert_weights(pp, (LAS float*)(FF.lds + wave * 16384), CV_I_IN, CV_NITEMS, (rank + (bid >> 3) - mine) * 8 + wave, nidle * 8, lane); } }
          if (l == 1) { TID_VARS; const int fr = lane & 15, g = lane >> 4; LAS float* rsm = (LAS float*)(FF.lds + 8192);
              const int hb_ = FF.G >> 4, jj_ = bid >> 3; const bool idle_ = (FF.G % 16 == 0) && jj_ >= hb_; const int nid_ = (FF.G % 16 == 0) ? FF.G / 2 : FF.G, rk_ = (FF.G % 16 == 0) ? (bid & 7) * hb_ + (jj_ - hb_) : FF.vcu;
              const bool mine_ = (FF.G % 16 == 0) ? idle_ : true;
              if (mine_ && rk_ < ZC / 16) meta_rs(rsm, hmeta2, tid);
              for (int u = mine_ ? rk_ : ZC; u < ZC / 16; u += nid_) { const f32x4 a = skinny_block(FF.lds, bufA + (size_t)MROW0 * D, D, (const bf16_t*)(pp.ws + WS_WIN + (size_t)ZC * D * 2), D, 16 * u, 128, 1.f, tid);
                  if (wave == 0) { const float rs = rsm[fr]; u32x2 w; w.x = cvtpk(a[0] * rs, a[1] * rs); w.y = cvtpk(a[2] * rs, a[3] * rs); *(u32x2*)(Zb + (size_t)(MROW0 + fr) * ZC + 16 * u + 4 * g) = w; } } }
        }
        xcd_barrier(bar);
        { PHASE_PARAMS; const int NU = NB * NSEG + 1;
          for (int u = bid; u < NU; u += FF.G) {
              if (u < NB * NSEG) { const int b = u / NSEG, s = u % NSEG; const int r0 = b * SEQ + 64 * s; lru_local_unit<64>(pp, FF, l, r0, s == 0 ? MB0 + 61 : r0 - 3, u); }
              else lru_local_unit<16>(pp, FF, l, MROW0, MB0 + 45, NB * NSEG);
          }
          for (int u = bid; u < 5 * 256; u += FF.G) { const int mx = u >> 8, r0 = 128 * (u & 255);
              if (mx < 4) mla_prep_unit(pp, FF, l, r0, 128, mx >> 1, mx & 1); else fox_prep_unit<128>(pp, FF, l, r0); }
          { const int mx = FF.G - 1 - bid; if (mx < 4) mla_prep_unit(pp, FF, l, MROW0, 16, mx >> 1, mx & 1); else if (mx == 4) fox_prep_unit<16>(pp, FF, l, MROW0); }
          { TID_VARS; const int gt = FF.vcu * 512 + tid, NTH = FF.G * 512;
            for (int i = gt; i < 2 * 256 * 6; i += NTH) { const int c = i % 6, hd = (i / 6) & 255, arr = i / (6 * 256);
                *(u32x4*)((bf16_t*)(pp.ws + WS_ATT + (arr ? AT_FVT : AT_MVT)) + (size_t)hd * TM + MB0 + 8 * c) = zero4(); } }
          { TID_VARS; const int NW = NB * 4 * NSEG + 4;
            for (int wu = (FF.vcu * 8 + wave); wu < NW; wu += FF.G * 8) {
                if (wu < NB * 4 * NSEG) { const int bh = wu / NSEG, sg = wu % NSEG; hg_local_wave(pp, FF.lds + wave * HG_WL, l, (bh >> 2) * SEQ + 64 * sg, 64, bh & 3, wu, lane); }
                else hg_local_wave(pp, FF.lds + wave * HG_WL, l, MROW0, 16, wu - NB * 4 * NSEG, wu, lane);
            } }
        }
        xcd_barrier(bar);
        { PHASE_PARAMS; TID_VARS; const int bx = FF.G - 1 - bid;
          if (bx < 2) { const int i = bx * 512 + tid; lru_carry(pp, i >> 8, i & 255); }
          for (int u = bid; u < 128; u += FF.G) hg_carry_block(pp, FF.lds, u >> 3, u & 7, tid);
          for (int u = bid - 128; u >= 0 && u < 16; u += FF.G) fox_cscan_block(pp, FF.lds, l, u >> 2, u & 3, tid); }
        xcd_barrier(bar);
        { PHASE_PARAMS;
          for (int u = bid; u < NB * NSEG + 1; u += FF.G) {
              if (u < NB * NSEG) { const int b = u / NSEG, sg = u % NSEG; lru_fix_unit<64>(pp, FF, l, b * SEQ + 64 * sg, u, false, gss); }
              else lru_fix_unit<16>(pp, FF, l, MROW0, NB * NSEG, true, gss);
          }
          { TID_VARS; const int NW = NB * 4 * NSEG + 4;
            for (int wu = (FF.vcu * 8 + wave); wu < NW; wu += FF.G * 8) {
                if (wu < NB * 4 * NSEG) { const int bh = wu / NSEG, sg = wu % NSEG; hg_fix_wave(pp, (bh >> 2) * SEQ + 64 * sg, 64, bh & 3, wu, false, gss, lane); }
                else hg_fix_wave(pp, MROW0, 16, wu - NB * 4 * NSEG, wu, true, gss, lane);
            } }
          __syncthreads();
          for (int u = FF.vcu; u < 1024; u += FF.G) { const int mx = u >> 9, i = u & 511, bh = (i & 255) >> 4, sidx = i & 15, qb = (i >> 8) ? 31 - sidx : sidx;
              attn_dispatch(pp, FF, mx, bh >> 2, bh & 3, qb, gss); }
          if (FF.vcu < 8) attn_dispatch(pp, FF, FF.vcu >> 2, 0, FF.vcu & 3, -1, gss);
        }
        xcd_barrier(bar);
        { PHASE_PARAMS; SchedPlain S{(const char*)bufB, (const char*)(pp.ws + WS_WOUT + (size_t)l * D * D * 2), D, D, 128, 4, FF.G, bid};
          { TID_VARS; Unit u; for (int i = 0; i < 4 && S.next(i, u); ++i) { if (tid < 256) { const int row = u.pm * 256 + tid; const f32x4* gq = (const f32x4*)(gss + (size_t)row * 16); float gsum[4];
#pragma unroll
                    for (int q = 0; q < 4; ++q) { const f32x4 v = gq[q]; gsum[q] = (v[0] + v[1]) + (v[2] + v[3]); }
                    const float r0 = rsqrtf(gsum[0] * (1.f / 256.f) + EPS), r1 = rsqrtf(gsum[1] * (1.f / 256.f) + EPS), r2 = rsqrtf(gsum[2] * (1.f / 256.f) + EPS), r3 = rsqrtf(gsum[3] * (1.f / 256.f) + EPS);
                    *(LAS f32x4*)(gstab + (i * 256 + tid) * 4) = (f32x4){r0 / r1, r1 / r2, r2 / r3, r3}; } }
            __syncthreads(); }
#ifdef FFN_GU_FP8
          EpiRes E{bufA, l == 0 ? ssp0 : nullptr, 1, (unsigned char*)(pp.ws + WS_H8), 1.f};
#else
          EpiRes E{bufA, l == 0 ? ssp0 : nullptr, 1, l == 0 ? nullptr : (unsigned char*)(pp.ws + WS_H8), 1.f};
#endif
          pg8::gemm_phase<EpiRes, SchedPlain, false, true>(FF.lds, D, D, S, E, gstab);
          if (l == 0) { TID_VARS; LAS float* scr = (LAS float*)(FF.lds + 16384 + wave * 8704); const int gw = FF.vcu * 8 + wave, NGW = FF.G * 8;
              constexpr int I_G = 88 * 16, I_D = 32 * 44;
#ifdef FFN_GU_FP8
              for (int it = gw; it < 2 * I_G + I_D; it += NGW) { int r = it;
#else
              for (int it = gw + 2 * I_G; it < 2 * I_G + I_D; it += NGW) { int r = it;
#endif
                  if (r < 2 * I_G) { const int up = r / I_G; r %= I_G; const int sb = r / 16, kb = r % 16;
                      wt_item8(up ? pp.ffn_w_up : pp.ffn_w_gate, DFF, 32 * sb, pp.norm2_g, W8_SCALE, (unsigned char*)(pp.ws + WS_FGU8), D, 256 * (sb >> 2) + 128 * up + 32 * (sb & 3), 64 * kb, scr, lane); }
                  else { r -= 2 * I_G; const int sb = r / 44, kb = r % 44; wt_item8(pp.ffn_w_down, D, 32 * sb, nullptr, W8_SCALE, (unsigned char*)(pp.ws + WS_FD8), DFF, 32 * sb, 64 * kb, scr, lane); } }
              __syncthreads(); }
          if (l == 0) { TID_VARS; const int fr = lane & 15, g = lane >> 4;
              for (int u = FF.vcu; u < 64; u += FF.G) { const size_t row = (size_t)(MROW0 + fr);
                  const f32x4 gv = *(const f32x4*)(gss + row * 16 + 4 * (wave >> 1)); const float sc = rsqrtf(((gv[0] + gv[1]) + (gv[2] + gv[3])) * (1.f / 256.f) + EPS);
                  const f32x4 o = skinny_block(FF.lds, bufB + (size_t)MROW0 * D, D, (const bf16_t*)(pp.ws + WS_WOUT), D, 16 * u, 128, sc, tid);
                  if (wave == 0) { const f32x4 hn = *(const f32x4*)(pp.meta + (size_t)fr * D + 16 * u + 4 * g) + o; *(f32x4*)(hmeta + (size_t)fr * D + 16 * u + 4 * g) = hn;
                      u32x2 w; w.x = cvtpk(hn[0], hn[1]); w.y = cvtpk(hn[2], hn[3]); *(u32x2*)(bufA + row * D + 16 * u + 4 * g) = w; } } }
        }
        xcd_barrier(bar);
        if (l == 0) {
#ifdef FFN_GU_FP8
            { PHASE_PARAMS; SchedPlain S{(const char*)(pp.ws + WS_H8), (const char*)(pp.ws + WS_FGU8), 512, 512, 128, 22, FF.G, bid};
              { TID_VARS; fill_rs_table(S, ssp0, 16, gstab, tid); }
              EpiGU8 E{(unsigned char*)Zb, DFF, 1.f / W8_SCALE};
              pg8::gemm_phase<EpiGU8, SchedPlain, false, false, true>(FF.lds, 512, 512, S, E, gstab);
#else
            { PHASE_PARAMS; SchedPlain S{(const char*)bufA, (const char*)(pp.ws + WS_WGU), D, D, 128, 22, FF.G, bid};
              { TID_VARS; fill_rs_table(S, ssp0, 16, gstab, tid); }
              EpiGU8 E{(unsigned char*)Zb, DFF, 1.f};
              pg8::gemm_phase<EpiGU8, SchedPlain, false, false, false>(FF.lds, D, D, S, E, gstab);
#endif
              { TID_VARS; const int fr = lane & 15, g = lane >> 4; LAS float* rsm = (LAS float*)(FF.lds + 8192);
                if (FF.vcu < DFF / 16) meta_rs(rsm, hmeta, tid);
                for (int u = FF.vcu; u < DFF / 16; u += FF.G) { const int c0 = 16 * u, tj = c0 >> 7, wi = c0 & 127;
                    const f32x4 ag = skinny_block(FF.lds, bufA + (size_t)MROW0 * D, D, (const bf16_t*)(pp.ws + WS_WGU), D, 256 * tj + wi, 128, 1.f, tid);
                    const f32x4 au = skinny_block(FF.lds, bufA + (size_t)MROW0 * D, D, (const bf16_t*)(pp.ws + WS_WGU), D, 256 * tj + 128 + wi, 128, 1.f, tid);
                    if (wave == 0) { const float rs = rsm[fr]; float a[4];
#pragma unroll
                        for (int j = 0; j < 4; ++j) { const float gg = ag[j] * rs, uu = au[j] * rs; a[j] = gg * uu * __builtin_amdgcn_rcpf(1.f + __expf(-gg)); }
                        u32x2 w; w.x = cvtpk(a[0], a[1]); w.y = cvtpk(a[2], a[3]); *(u32x2*)(Zb + (size_t)(MROW0 + fr) * DFF + c0 + 4 * g) = w; } } }
            }
            xcd_barrier(bar);
            { PHASE_PARAMS; SchedPlain S{(const char*)Zb, (const char*)(pp.ws + WS_FD8), DFF / 2, DFF / 2, 128, 4, FF.G, bid};
              EpiRes E{bufA, ssp1, 0, nullptr, 1.f / (W8_SCALE * ACT8_SCALE)};
              pg8::gemm_phase<EpiRes, SchedPlain, false, false, true>(FF.lds, DFF / 2, DFF / 2, S, E, gstab);
              { TID_VARS; const int fr = lane & 15, g = lane >> 4;
                for (int u = FF.vcu; u < 64; u += FF.G) {
                    const f32x4 o = skinny_block(FF.lds, Zb + (size_t)MROW0 * DFF, DFF, (const bf16_t*)(pp.ws + WS_WD), DFF, 16 * u, 352, 1.f, tid);
                    if (wave == 0) { const f32x4 hn = *(const f32x4*)(hmeta + (size_t)fr * D + 16 * u + 4 * g) + o; *(f32x4*)(hmeta2 + (size_t)fr * D + 16 * u + 4 * g) = hn;
                        u32x2 w; w.x = cvtpk(hn[0], hn[1]); w.y = cvtpk(hn[2], hn[3]); *(u32x2*)(bufA + (size_t)(MROW0 + fr) * D + 16 * u + 4 * g) = w; } } }
            }
            xcd_barrier(bar);
        }
    }
#if STAGE >= 2
#define mlist ((int*)(pp.ws + WS_CTL + CTL_LIST))
#define mlrs ((float*)(pp.ws + WS_CTL + CTL_LRS))
#define mlgate ((float*)(pp.ws + WS_CTL + CTL_LGATE))
#define mcnt ((unsigned*)(pp.ws + WS_CTL) + CW_MCNT)
    { PHASE_PARAMS; TID_VARS;
      LAS float* WR = (LAS float*)FF.lds;
      LAS int* ph = (LAS int*)(FF.lds + 32768);
      for (int i = tid; i < 1024 * 8; i += 512) WR[i] = pp.moe_w_router[i] * pp.norm2_g[D + (i >> 3)];
      for (int u = bid; u < NR / 128; u += FF.G) {
          if (tid < 64) ph[tid] = 0;
          __syncthreads();
          {
              const int t16 = lane & 15, kq = lane >> 4, tl = wave * 16 + t16, tok = u * 128 + tl;
              float ss = 0.f, lg[8];
#pragma unroll
              for (int e = 0; e < 8; ++e) lg[e] = 0.f;
              const bf16_t* hrow = bufA + (size_t)tok * D + 256 * kq;
#pragma unroll 4
              for (int c = 0; c < 32; ++c) { const u32x4 hw = *(const u32x4*)(hrow + 8 * c); const float hv[8] = {bflo(hw.x), bfhi(hw.x), bflo(hw.y), bfhi(hw.y), bflo(hw.z), bfhi(hw.z), bflo(hw.w), bfhi(hw.w)};
#pragma unroll
                  for (int q = 0; q < 8; ++q) { const float hx = hv[q]; ss += hx * hx; const int k = 256 * kq + 8 * c + q; const f32x4 w0 = *(const LAS f32x4*)(WR + k * 8), w1 = *(const LAS f32x4*)(WR + k * 8 + 4);
                      lg[0] += hx * w0[0]; lg[1] += hx * w0[1]; lg[2] += hx * w0[2]; lg[3] += hx * w0[3]; lg[4] += hx * w1[0]; lg[5] += hx * w1[1]; lg[6] += hx * w1[2]; lg[7] += hx * w1[3]; } }
              ss += __shfl_xor(ss, 16); ss += __shfl_xor(ss, 32);
#pragma unroll
              for (int e = 0; e < 8; ++e) { lg[e] += __shfl_xor(lg[e], 16); lg[e] += __shfl_xor(lg[e], 32); }
              if (kq == 0) { const float rs = rsqrtf(ss * (1.f / 1024.f) + EPS);
                  int e1 = 0; float v1 = lg[0];
#pragma unroll
                  for (int e = 1; e < 8; ++e) if (lg[e] > v1) { v1 = lg[e]; e1 = e; }
                  int e2 = -1; float v2 = -INFINITY;
#pragma unroll
                  for (int e = 0; e < 8; ++e) if (e != e1 && lg[e] > v2) { v2 = lg[e]; e2 = e; }
                  const float g1 = 1.f / (1.f + __expf((v2 - v1) * rs)), g2 = 1.f - g1;
                  const int lo = e1 < e2 ? e1 : e2, hi = e1 < e2 ? e2 : e1; const float glo = e1 < e2 ? g1 : g2, ghi = e1 < e2 ? g2 : g1;
                  __hip_atomic_fetch_add(&ph[lo * 8 + hi], 1, __ATOMIC_RELAXED, __HIP_MEMORY_SCOPE_WORKGROUP);
                  *(f32x4*)(pp.ws + WS_TOKREC + (size_t)tok * 16) = (f32x4){__int_as_float(lo | (hi << 8)), glo, ghi, rs}; } }
          __syncthreads();
          if (tid < 64) ((int*)(pp.ws + WS_PAIRH))[u * 64 + tid] = ph[tid];
          __syncthreads();
      }
      { LAS float* scr = (LAS float*)(FF.lds + 49152 + wave * 8704);
        const int gw = FF.vcu * 8 + wave, NGW = FF.G * 8; constexpr int I_GU = 112 * 16, I_DN = 32 * 56, I_E = 2 * I_GU + I_DN;
#define MOE_ITEM(it_, W_, ldw_, c0_, g_, WT_, K8_, n0_, k0_) const float* W_; const float* g_; unsigned char* WT_; int ldw_, c0_, K8_, n0_, k0_; \
        { const int e = (it_) / I_E; int r = (it_) % I_E; \
          if (r < 2 * I_GU) { const int up = r / I_GU; r %= I_GU; const int sb = r / 16, kb = r % 16; \
              W_ = (up ? pp.moe_w_up : pp.moe_w_gate) + (size_t)e * D * DFE; ldw_ = DFE; c0_ = 32 * sb; g_ = pp.norm2_g + D; WT_ = (unsigned char*)(pp.ws + WS_MGU) + (size_t)e * 7168 * D; K8_ = D; n0_ = 256 * (sb >> 2) + 128 * up + 32 * (sb & 3); k0_ = 64 * kb; } \
          else { r -= 2 * I_GU; const int sb = r / 56, kb = r % 56; \
              W_ = pp.moe_w_down + (size_t)e * DFE * D; ldw_ = D; c0_ = 32 * sb; g_ = nullptr; WT_ = (unsigned char*)(pp.ws + WS_MD) + (size_t)e * D * DFE; K8_ = DFE; n0_ = 32 * sb; k0_ = 64 * kb; } }
        for (int it = gw; it < NEXP * I_E; it += 2 * NGW) { const int it2 = it + NGW; const bool two = it2 < NEXP * I_E;
            MOE_ITEM(it, Wa, lda_, ca, ga, Ta, Ka, na, ka); MOE_ITEM((two ? it2 : it), Wb, ldb_, cb, gb, Tb, Kb, nb, kb2);
            f32x4 va[8], vb[8]; wt_load8(Wa, lda_, ca, ka, lane, va); wt_load8(Wb, ldb_, cb, kb2, lane, vb);
            wt_finish8(va, ga, W8_SCALE, Ta, Ka, na, ka, scr, lane); if (two) wt_finish8(vb, gb, W8_SCALE, Tb, Kb, nb, kb2, scr, lane); }
#undef MOE_ITEM
      }
    }
    xcd_barrier(bar);
    { PHASE_PARAMS; TID_VARS;
      LAS int* part = (LAS int*)FF.lds;
      LAS int* Tt = part + 512;
      LAS int* Qt = Tt + 64;
      LAS int* pfx = Qt + 64;
      LAS int* typ = pfx + 64;
      LAS int* lc = typ + 128;
      LAS int* pq = lc + 32;
      LAS int* tmpq = pq + 32;
      const int* PH = (const int*)(pp.ws + WS_PAIRH);
      { const int p = tid & 63, ch = tid >> 6; int a = 0;
        for (int i = 0; i < 32; ++i) a += PH[(ch * 32 + i) * 64 + p];
        part[ch * 64 + p] = a; }
      __syncthreads();
      if (tid < 64) { int a = 0; for (int ch = 0; ch < 8; ++ch) a += part[ch * 64 + tid]; Tt[tid] = a; Qt[tid] = 0; }
      __syncthreads();
      if (tid == 0) {
          for (int e = 0; e < 8; ++e) { int c = 0; for (int lo = 0; lo < 8; ++lo) c += Tt[lo * 8 + e]; pq[e] = c; }
          int qh = 0, qt = 0, carry = 0;
          for (int e = 7; e >= 1; --e) { const int r = pq[e] & 255, need = (256 - r) & 255;
              if (r == 0) continue;
              if (carry >= need) { int rem = need; carry -= need;
                  while (rem > 0) { const int sx = pq[8 + qh], n = rem < pq[16 + qh] ? rem : pq[16 + qh]; Qt[e * 8 + sx] += n; pq[16 + qh] -= n; rem -= n; if (pq[16 + qh] == 0) ++qh; } }
              else { pq[8 + qt] = e; pq[16 + qt] = r; ++qt; carry += r; } }
          for (; qh < qt; ++qh) if (pq[16 + qh] > 0) Qt[pq[8 + qh]] += pq[16 + qh];
          bool ok = true; for (int p = 0; p < 64; ++p) ok = ok && (Qt[p] <= Tt[p]);
          if (!ok) for (int p = 0; p < 64; ++p) Qt[p] = 0; }
      __syncthreads();
      for (int u = bid; u < NR / 128; u += FF.G) {
          if (tid < 16) lc[tid] = 0;
          { const int p = tid & 63, g = tid >> 6, c0 = u >> 5, i0 = c0 * 32 + 4 * g; int a = 0;
#pragma unroll
            for (int i = 0; i < 4; ++i) { const int v = PH[(i0 + i < NR / 128 ? i0 + i : 0) * 64 + p]; a += (i0 + i < u) ? v : 0; }
            tmpq[g * 64 + p] = a; }
          __syncthreads();
          if (tid < 64) { int a = 0; const int c0 = u >> 5; for (int ch = 0; ch < c0; ++ch) a += part[ch * 64 + tid]; for (int g = 0; g < 8; ++g) a += tmpq[g * 64 + tid]; pfx[tid] = a; }
          f32x4 rec = {0.f, 0.f, 0.f, 0.f}; int lo = 0, hi = 0;
          if (tid < 128) { rec = *(const f32x4*)(pp.ws + WS_TOKREC + (size_t)(u * 128 + tid) * 16); const int pk = __float_as_int(rec[0]); lo = pk & 255; hi = pk >> 8; typ[tid] = lo * 8 + hi; }
          __syncthreads();
          int p0 = 0, p1 = 0, e0 = 0, e1 = 0; float g0 = 0.f, g1 = 0.f;
          if (tid < 128) { const int ty = lo * 8 + hi; int rk = pfx[ty];
              for (int j = 0; j < tid; j += 4) { const i32x4 t4 = *(const LAS i32x4*)(typ + j); rk += ((t4[0] == ty) ? 1 : 0) + ((j + 1 < tid && t4[1] == ty) ? 1 : 0) + ((j + 2 < tid && t4[2] == ty) ? 1 : 0) + ((j + 3 < tid && t4[3] == ty) ? 1 : 0); }
              const bool sw = rk < Qt[ty]; e0 = sw ? hi : lo; e1 = sw ? lo : hi; g0 = sw ? rec[2] : rec[1]; g1 = sw ? rec[1] : rec[2];
              p0 = __hip_atomic_fetch_add(&lc[e0], 1, __ATOMIC_RELAXED, __HIP_MEMORY_SCOPE_WORKGROUP); p1 = __hip_atomic_fetch_add(&lc[8 + e1], 1, __ATOMIC_RELAXED, __HIP_MEMORY_SCOPE_WORKGROUP); }
          __syncthreads();
          if (tid < 16) lc[16 + tid] = (int)atomicAdd(mcnt + tid, (unsigned)lc[tid]);
          __syncthreads();
          if (tid < 128) { const int tok = u * 128 + tid; const float rs = rec[3];
              const int i0 = e0 * 32768 + lc[16 + e0] + p0, i1 = (8 + e1) * 32768 + lc[16 + 8 + e1] + p1;
              mlist[i0] = tok; mlrs[i0] = rs; mlgate[i0] = g0; mlist[i1] = tok; mlrs[i1] = rs; mlgate[i1] = g1; }
          __syncthreads();
      }
    }
    xcd_barrier(bar);
    LAS int* tab0 = (LAS int*)(F.lds + GST_OFF);
    { PHASE_PARAMS; TID_VARS; __syncthreads();
      if (tid < 2) { const int ps = tid; LAS int* tb = tab0 + ps * 640; int t = 0;
          for (int e = 0; e < 8; ++e) { const int n = (int)__hip_atomic_load(mcnt + ps * 8 + e, __ATOMIC_RELAXED, __HIP_MEMORY_SCOPE_AGENT); for (int o = 0; o < n; o += 256) { tb[t * 4] = e; tb[t * 4 + 1] = o; tb[t * 4 + 2] = n; tb[t * 4 + 3] = 0; ++t; } }
          tab0[1280 + ps] = t; }
      __syncthreads();
      const int nT0 = tab0[1280], nT1 = tab0[1281];
      for (int it = FF.vcu * 8 + wave; it < (nT0 + nT1) * 32; it += FF.G * 8) { const int u = it >> 5, r0 = (it & 31) * 8, ps = u < nT0 ? 0 : 1, t = ps ? u - nT0 : u; const LAS int* tb = tab0 + ps * 640;
          const int e = tb[t * 4], off = tb[t * 4 + 1], n = tb[t * 4 + 2]; const int* lst = mlist + (ps * 8 + e) * 32768;
          unsigned char* dst = (unsigned char*)(pp.ws + WS_MAS) + ((size_t)(ps * 136 + t) * 256 + r0) * 1024; const unsigned char* src = (const unsigned char*)(pp.ws + WS_H8);
          int tk[8]; u32x4 v[8];
#pragma unroll
          for (int i = 0; i < 8; ++i) { const int idx = off + r0 + i; tk[i] = lst[idx < n ? idx : n - 1]; }
#pragma unroll
          for (int i = 0; i < 8; ++i) v[i] = *(const u32x4*)(src + (size_t)tk[i] * 1024 + 16 * lane);
#pragma unroll
          for (int i = 0; i < 8; ++i) { if (off + r0 + i >= n) v[i] = (u32x4){0u, 0u, 0u, 0u}; *(u32x4*)(dst + (size_t)i * 1024 + 16 * lane) = v[i]; } }
    }
    xcd_barrier(bar);
    {
        LAS int* tabA = tab0; LAS int* tabB = tab0 + 640;
        const int nT0 = __builtin_amdgcn_readfirstlane(tab0[1280]), nT1 = __builtin_amdgcn_readfirstlane(tab0[1281]);
        { PHASE_PARAMS; SchedMoe S{(const char*)(pp.ws + WS_MAS), (const char*)(pp.ws + WS_MGU), (size_t)7168 * D, 512, 512, nT0, 28, FF.G, bid, tabA, mlist, false, 0u, 0, 0};
          EpiMoeGU E{(unsigned char*)(pp.ws + WS_MACT), mlrs, tabA};
          { TID_VARS; fill_moe_rs_table(S, mlrs, gstab + 2048, tid); }
          pg8::gemm_phase<EpiMoeGU, SchedMoe, false, false, true>(FF.lds, 512, 512, S, E, gstab + 2048); }
        xcd_barrier(bar);
        { PHASE_PARAMS;
          { SchedMoe S{(const char*)(pp.ws + WS_MACT), (const char*)(pp.ws + WS_MD), (size_t)D * DFE, DFE / 2, DFE / 2, nT0, 4, FF.G, bid, tabA, mlist, false, 0u, 0, 0};
            EpiMoeDown E{pp.out, mlist, mlgate, tabA, bufA, false};
            pg8::gemm_phase<EpiMoeDown, SchedMoe, false, false, true>(FF.lds, DFE / 2, DFE / 2, S, E, gstab); }
          { const int ud8 = (nT0 * 4 + 7) >> 3, udx = nT0 * 4 - (bid & 7) * ud8, udc = udx < ud8 ? udx : ud8;
            const int nheavy = udc > 2 * (FF.G >> 3) ? udc - 2 * (FF.G >> 3) : 0;
            SchedMoe S{(const char*)(pp.ws + WS_MAS) + (size_t)136 * 256 * 1024, (const char*)(pp.ws + WS_MGU), (size_t)7168 * D, 512, 512, nT1, 28, FF.G, bid, tabB, mlist + 8 * 32768, false, 0u, nheavy, 4};
            EpiMoeGU E{(unsigned char*)(pp.ws + WS_MACT1), mlrs + 8 * 32768, tabB};
            { TID_VARS; fill_moe_rs_table(S, mlrs + 8 * 32768, gstab + 2048, tid); }
            pg8::gemm_phase<EpiMoeGU, SchedMoe, false, false, true>(FF.lds, 512, 512, S, E, gstab + 2048); } }
        xcd_barrier(bar);
        { PHASE_PARAMS; SchedMoe S{(const char*)(pp.ws + WS_MACT1), (const char*)(pp.ws + WS_MD), (size_t)D * DFE, DFE / 2, DFE / 2, nT1, 4, FF.G, bid, tabB, mlist + 8 * 32768, false, 0u, 0, 0};
          EpiMoeDown E{pp.out, mlist + 8 * 32768, mlgate + 8 * 32768, tabB, bufA, true};
          pg8::gemm_phase<EpiMoeDown, SchedMoe, false, false, true>(FF.lds, DFE / 2, DFE / 2, S, E, gstab); }
    }
#endif
}

extern "C" void kernel_launch(void* const* d_in, const int* in_sizes, int n_in, void* d_out, int out_size, void* d_ws, size_t ws_size, hipStream_t stream) {
    static int grid = 0;
    if (grid == 0) {
        if (n_in != 31 || out_size != NR * D || ws_size < WS_END) { fprintf(stderr, "kernel_launch: unexpected sizes n_in %d out %d ws %zu\n", n_in, out_size, ws_size); grid = -1; return; }
        int dev = 0, cus = 0, per_cu = 0;
        if (hipGetDevice(&dev) != hipSuccess || hipDeviceGetAttribute(&cus, hipDeviceAttributeMultiprocessorCount, dev) != hipSuccess) { grid = -1; return; }
        if (hipFuncSetAttribute((const void*)hymba_fwd, hipFuncAttributeMaxDynamicSharedMemorySize, LDS_BYTES) != hipSuccess) { fprintf(stderr, "kernel_launch: hipFuncSetAttribute failed\n"); grid = -1; return; }
        if (hipOccupancyMaxActiveBlocksPerMultiprocessor(&per_cu, (const void*)hymba_fwd, 512, LDS_BYTES) != hipSuccess || per_cu < 1) { fprintf(stderr, "kernel_launch: occupancy query says %d\n", per_cu); (void)hipGetLastError(); per_cu = 1; }
        grid = cus;
    }
    if (grid < 0) return;
    (void)hipMemsetAsync((char*)d_ws + WS_CTL, 0, CTL_BYTES, stream);
    Params p{};
    const float** pp = (const float**)&p;
    for (int i = 0; i < 31; ++i) pp[i] = (const float*)d_in[i];
    p.out = (float*)d_out; p.ws = (unsigned char*)d_ws;
    hipLaunchKernelGGL(hymba_fwd, dim3(grid), dim3(512), LDS_BYTES, stream, p);
}
```

```cpp
#include <hip/hip_runtime.h>
#include <cstdint>
#include <cstdio>

#define LAS __attribute__((address_space(3)))
#define GAS __attribute__((address_space(1)))
#define DI __device__ __forceinline__
typedef unsigned short bf16_t;
typedef short bf16x8 __attribute__((ext_vector_type(8)));
typedef short s16x4 __attribute__((ext_vector_type(4)));
typedef float f32x2 __attribute__((ext_vector_type(2)));
typedef int i32x4 __attribute__((ext_vector_type(4)));
typedef float f32x4 __attribute__((ext_vector_type(4)));
typedef float f32x16 __attribute__((ext_vector_type(16)));
typedef unsigned u32x2 __attribute__((ext_vector_type(2)));
typedef unsigned u32x4 __attribute__((ext_vector_type(4)));
typedef __bf16 bf16x2_t __attribute__((ext_vector_type(2)));

#ifndef STAGE
#define STAGE 2
#endif
#if STAGE >= 2
#define NLAYER 2
#else
#define NLAYER 1
#endif

constexpr int NB = 4, SEQ = 8192, D = 1024, NR = NB * SEQ;
constexpr int MB0 = NR, META_OFF = 48, NMETA = 16;
constexpr int MROW0 = MB0 + META_OFF;
constexpr int TM = NR + 256;
constexpr int ZC = 2816;
constexpr float EPS = 1e-6f;
constexpr int ZC_XA = 0, ZC_GA = 256, ZC_HQ = 512, ZC_HF = 768, ZC_HV = 1024, ZC_HG = 1280, ZC_CQ = 1536, ZC_CKV = 1792, ZC_KR = 1920, ZC_FF = 1952, ZC_FQ = 2048, ZC_FK = 2304, ZC_FV = 2560;
constexpr int Y_LRU = 0, Y_HG = 256, Y_MLA = 512, Y_FOX = 768;
constexpr int DFF = 2816, DFE = 3584, NEXP = 8;
constexpr int NSEG = 128;

constexpr size_t MiB = 1u << 20;
constexpr size_t WS_CTL = 0, CTL_BYTES = 8 * MiB;
constexpr size_t WS_WIN = 8 * MiB;
constexpr size_t WS_WOUT = 19 * MiB;
constexpr size_t WS_WGU = 23 * MiB;
constexpr size_t WS_WD = 34 * MiB;
constexpr size_t WS_WSM = 40 * MiB;
constexpr size_t WS_BUFA = 41 * MiB;
constexpr size_t WS_BUFB = 106 * MiB;
constexpr size_t WS_Z = 171 * MiB;
constexpr size_t WS_ATT = 349 * MiB;
constexpr size_t WS_LRU = 430 * MiB;
constexpr size_t WS_HG = 465 * MiB;
constexpr size_t WS_SSP = 499 * MiB;
constexpr size_t WS_GSP = 503 * MiB;
constexpr size_t WS_END = 508 * MiB;
constexpr size_t SM_LRUW = 0;
constexpr size_t SM_WUQ = 131072;
constexpr size_t SM_WUKV = 131072 + 294912;
constexpr size_t SM_ROPE = 131072 + 294912 + 262144;
constexpr int CW_BAR = 4096;
constexpr int CW_SS = 16384;
constexpr int CW_GSS = CW_SS + 3 * TM;
constexpr int CW_ENDW = CW_GSS + 2 * TM * 4;
static_assert((size_t)CW_ENDW * 4 <= CTL_BYTES, "ctl");
constexpr size_t LRU_LA = 0, LRU_BC = (size_t)TM * 256 * 2, LRU_AGGA = 2 * (size_t)TM * 256 * 2, LRU_AGGB = LRU_AGGA + (size_t)(NB * NSEG + 1) * 256 * 4, LRU_HIN = LRU_AGGB + (size_t)(NB * NSEG + 1) * 256 * 4;
static_assert(LRU_HIN + (size_t)(NB * NSEG + 1) * 256 * 4 <= 35 * MiB, "lru");
constexpr int HG_SLOTS = NB * 4 * NSEG + 4;
constexpr size_t HG_UT = 0, HG_DL = (size_t)HG_SLOTS * 4096 * 4;
static_assert(HG_DL + (size_t)HG_SLOTS * 64 * 4 <= 34 * MiB, "hg");
constexpr size_t AT_MQ = 0, AT_MK = (size_t)TM * 384 * 2, AT_MVT = 2 * (size_t)TM * 384 * 2, AT_FVT = AT_MVT + (size_t)256 * TM * 2, AT_END = AT_FVT + (size_t)256 * TM * 2;
static_assert(AT_END <= 81 * MiB, "att");
constexpr size_t LRU_FC = ((LRU_HIN + (size_t)(NB * NSEG + 1) * 256 * 4 + 255) / 256) * 256, LRU_FLF = LRU_FC + (size_t)4 * TM * 4;
constexpr size_t LRU_FJ0 = LRU_FLF + (size_t)4 * TM * 4;
static_assert(LRU_HIN + (size_t)(NB * NSEG + 1) * 256 * 4 <= LRU_FC && LRU_FJ0 + 4 * 4 * 32 * 4 <= 35 * MiB, "lru2");
constexpr size_t HG_ROPE = 33 * MiB - 256 * 1024;
static_assert(HG_DL + (size_t)HG_SLOTS * 64 * 4 <= HG_ROPE && HG_ROPE + (size_t)8208 * 16 * 8 <= 34 * MiB, "hg2");

constexpr size_t WS_MGU = 106 * MiB;
constexpr size_t WS_MD = 162 * MiB;
constexpr size_t WS_MACT = 190 * MiB;
static_assert(WS_MACT + (size_t)136 * 256 * DFE <= WS_LRU, "moe act");
constexpr size_t WS_MAS = 309 * MiB;
static_assert(WS_MAS + (size_t)2 * 136 * 256 * 1024 <= WS_LRU, "moe sorted A");
constexpr size_t WS_H8 = 377 * MiB;
static_assert(WS_MAS + (size_t)2 * 136 * 256 * 1024 <= WS_H8 && WS_H8 + (size_t)NR * 1024 <= WS_LRU, "h8");
constexpr size_t WS_FGU8 = 409 * MiB, WS_FD8 = 415 * MiB;
static_assert(WS_FD8 + (size_t)D * DFF <= WS_LRU, "ffn fp8");
constexpr size_t WS_MACT1 = 377 * MiB;
static_assert(WS_MACT1 + (size_t)136 * 256 * DFE <= WS_SSP, "moe act1");
constexpr float W8_SCALE = 256.f, ACT8_SCALE = 16.f;
constexpr size_t WS_TOKREC = 497 * MiB, WS_PAIRH = 498 * MiB;
constexpr size_t CTL_LIST = 2 * MiB, CTL_LRS = 4 * MiB, CTL_LGATE = 6 * MiB;
constexpr int CW_MCNT = CW_ENDW + 64;
constexpr size_t WS_HMETA = WS_GSP + 4456448;
static_assert(2 * (size_t)TM * 16 * 4 <= 4456448 && WS_HMETA + 2 * 16 * 1024 * 4 <= WS_END && (size_t)(CW_MCNT + 16) * 4 <= CTL_LIST, "misc");

constexpr int RING_BYTES = 131072;
constexpr int GST_OFF = RING_BYTES, GST_BYTES = 24576;
constexpr int MISC_OFF = GST_OFF + GST_BYTES;
constexpr int LDS_BYTES = MISC_OFF + 512;

DI unsigned cvtpk(float lo, float hi) { f32x2 v = {lo, hi}; bf16x2_t b = __builtin_convertvector(v, bf16x2_t); return __builtin_bit_cast(unsigned, b); }
DI bf16_t f2bf(float f) { return (bf16_t)(cvtpk(f, 0.f) & 0xffffu); }
DI float bf2f(bf16_t h) { return __uint_as_float(((unsigned)h) << 16); }
DI float bflo(unsigned w) { return __uint_as_float(w << 16); }
DI float bfhi(unsigned w) { return __uint_as_float(w & 0xffff0000u); }
DI float clamp8(float x) { return __builtin_amdgcn_fmed3f(x, -440.f, 440.f); }
DI unsigned pk4_fp8(float a, float b, float c, float d) { unsigned w = __builtin_amdgcn_cvt_pk_fp8_f32(clamp8(a), clamp8(b), 0u, false); return __builtin_amdgcn_cvt_pk_fp8_f32(clamp8(c), clamp8(d), w, true); }
DI u32x2 swiglu8_fp8(const f32x4 g0, const f32x4 g1, const f32x4 u0, const f32x4 u1, float rs) {
    const float rsu = rs * ACT8_SCALE; f32x2 a[4];
#pragma unroll
    for (int q = 0; q < 4; ++q) { const f32x4 gv = q < 2 ? g0 : g1, uv = q < 2 ? u0 : u1; const int o = 2 * (q & 1);
        const f32x2 g = (f32x2){gv[o], gv[o + 1]} * rs, u = (f32x2){uv[o], uv[o + 1]} * rsu, t = g * -1.4426950408889634f;
        const f32x2 d = (f32x2){__builtin_amdgcn_exp2f(t.x), __builtin_amdgcn_exp2f(t.y)} + 1.f;
        a[q] = (g * u) * (f32x2){__builtin_amdgcn_rcpf(d.x), __builtin_amdgcn_rcpf(d.y)}; }
    u32x2 w; w.x = pk4_fp8(a[0].x, a[0].y, a[1].x, a[1].y); w.y = pk4_fp8(a[2].x, a[2].y, a[3].x, a[3].y); return w;
}
DI u32x4 zero4() { unsigned z = 0u; asm volatile("" : "+v"(z)); return (u32x4){z, z, z, z}; }
DI float wave_sum(float v) {
#define WS_DPP(ctrl, rmask) v += __int_as_float(__builtin_amdgcn_update_dpp(0, __float_as_int(v), ctrl, rmask, 0xf, false))
    WS_DPP(0xB1, 0xf); WS_DPP(0x4E, 0xf); WS_DPP(0x141, 0xf); WS_DPP(0x140, 0xf); WS_DPP(0x142, 0xa); WS_DPP(0x143, 0xc);
#undef WS_DPP
    return __int_as_float(__builtin_amdgcn_readlane(__float_as_int(v), 63));
}
constexpr int TIDTAB_LDS = 131072 + 24576 + 256;
DI int fresh_tid() {
    const int slot = (int)(__builtin_amdgcn_s_getreg((5 << 11) | 4) & 63u);
    const int w = __builtin_amdgcn_readfirstlane(*(volatile LAS int*)(unsigned)(TIDTAB_LDS + 4 * slot));
    int l0 = 0; asm volatile("v_mbcnt_lo_u32_b32 %0, -1, 0\n\tv_mbcnt_hi_u32_b32 %0, -1, %0" : "=v"(l0));
    return w * 64 + l0;
}
DI float sigmoidf_(float x) { return __builtin_amdgcn_rcpf(1.f + __expf(-x)); }
DI float gelu_tanh(float x) { const float u = 0.7978845608028654f * (x + 0.044715f * x * x * x); const float e = __expf(2.f * u); const float t = 1.f - 2.f * __builtin_amdgcn_rcpf(e + 1.f); return 0.5f * x * (1.f + t); }
#define LDS_WAIT() asm volatile("s_waitcnt lgkmcnt(0)" ::: "memory")
#define VM_WAIT() asm volatile("s_waitcnt vmcnt(0)" ::: "memory")

#define XB_TMO      128
#define XB_XCNT(j)  (256  + 64 * (j))
#define XB_XSUB(j)  (1280 + 64 * (j))
#define XB_XGEN(j)  (2304 + 64 * (j))
#define XB_TOP      3328
#define XB_TOPGEN   3392
#define XCD_BAR_WORDS 3456
#define XB_SPIN_CAP (1u << 22)
DI unsigned xb_ld(unsigned* p)              { return __hip_atomic_load(p, __ATOMIC_RELAXED, __HIP_MEMORY_SCOPE_AGENT); }
DI unsigned xb_add(unsigned* p, unsigned v) { return __hip_atomic_fetch_add(p, v, __ATOMIC_RELAXED, __HIP_MEMORY_SCOPE_AGENT); }
DI unsigned xb_xcc_id() { return (unsigned)__builtin_amdgcn_s_getreg((3 << 11) | 20) & 0xFu; }
#define XB_SPIN(cond, bar) do { unsigned _sp = 0; while (cond) { __builtin_amdgcn_s_sleep(1); \
    if ((++_sp & 255u) == 0u) { if (xb_ld(&(bar)[XB_TMO])) break; if (_sp > XB_SPIN_CAP) { atomicAdd(&(bar)[XB_TMO], 1u); break; } } } } while (0)
struct XcdBarrier { unsigned* bar; unsigned x; volatile LAS unsigned* st; };
DI XcdBarrier xcd_barrier_post(unsigned* bar, volatile LAS unsigned* st) {
    XcdBarrier b; b.bar = bar; b.x = xb_xcc_id(); b.st = st;
    if (fresh_tid() == 0) (void)xb_add(&bar[XB_XCNT(b.x)], 1u);
    return b;
}
DI void xcd_barrier_complete(unsigned* bar, unsigned x, unsigned& nloc, unsigned& nx) {
    const unsigned G = gridDim.x * gridDim.y * gridDim.z;
    unsigned sum, cnt, mine, sp = 0u;
    for (;;) {
        sum = 0u; cnt = 0u; mine = 0u;
#pragma unroll
        for (unsigned j = 0; j < 16; ++j) { const unsigned c = xb_ld(&bar[XB_XCNT(j)]); sum += c; cnt += (c > 0u) ? 1u : 0u; mine = (j == x) ? c : mine; }
        if (sum == G) break;
        __builtin_amdgcn_s_sleep(1);
        if ((++sp & 255u) == 0u) { if (xb_ld(&bar[XB_TMO])) break; if (sp > XB_SPIN_CAP) { atomicAdd(&bar[XB_TMO], 1u); break; } }
    }
    nloc = mine > 0u ? mine : 1u; nx = cnt > 0u ? cnt : 1u;
}
DI void xcd_barrier(const XcdBarrier& b) {
    asm volatile("s_waitcnt vmcnt(0)" ::: "memory");
    __syncthreads();
    if (fresh_tid() == 0) {
        unsigned* bar = b.bar; unsigned bx_ = b.x; asm volatile("" : "+s"(bx_), "+s"(bar));
        __builtin_amdgcn_s_waitcnt(0);
        unsigned nloc = b.st[0], nx = b.st[1];
        if (nloc == 0u) { xcd_barrier_complete(bar, bx_, nloc, nx); b.st[0] = nloc; b.st[1] = nx; }
        const unsigned old = xb_add(&bar[XB_XSUB(bx_)], 1u);
        const unsigned gen = old / nloc;
        if (old + 1u == (gen + 1u) * nloc) {
            __builtin_amdgcn_fence(__ATOMIC_RELEASE, "agent");
            asm volatile("s_waitcnt vmcnt(0)" ::: "memory");
            const unsigned og = xb_add(&bar[XB_TOP], 1u);
            const unsigned tg = og / nx;
            if (og + 1u == (tg + 1u) * nx) xb_add(&bar[XB_TOPGEN], 1u);
            else XB_SPIN(xb_ld(&bar[XB_TOPGEN]) == tg, bar);
            __builtin_amdgcn_fence(__ATOMIC_ACQUIRE, "agent");
            xb_add(&bar[XB_XGEN(bx_)], 1u);
            asm volatile("s_waitcnt vmcnt(0)" ::: "memory");
        } else {
            XB_SPIN(xb_ld(&bar[XB_XGEN(bx_)]) == gen, bar);
            asm volatile("buffer_inv sc0" ::: "memory");
            asm volatile("s_waitcnt vmcnt(0)" ::: "memory");
        }
    }
    __syncthreads();
}

namespace pg8 {
typedef int v8i_t __attribute__((ext_vector_type(8))); typedef int v4i_t __attribute__((ext_vector_type(4)));
DI void mfma8(f32x4& c, v8i_t b, v8i_t a) { asm volatile("v_mfma_f32_16x16x128_f8f6f4 %0, %1, %2, %0" : "+v"(c) : "v"(b), "v"(a)); }
DI v8i_t cat8(bf16x8 a, bf16x8 b) { const v4i_t x = __builtin_bit_cast(v4i_t, a), y = __builtin_bit_cast(v4i_t, b); return __builtin_shufflevector(x, y, 0, 1, 2, 3, 4, 5, 6, 7); }
constexpr int BM = 256, BK = 64, HALF = 128, HTB = HALF * BK * 2, STAGE_BYTES = 8 * HTB;
__host__ __device__ __forceinline__ int lds_byte(int r, int c) { const int st = (r >> 4) * 2 + (c >> 5), rr = r & 15, cc = c & 31, ob = rr * 64 + cc * 2; return st * 1024 + (ob ^ (((ob >> 9) & 1) << 5)); }
__host__ __device__ __forceinline__ void stage_rc(int b, int& R, int& C) { const int st = b / 1024, sb = b % 1024, swz = sb ^ (((sb >> 9) & 1) << 5); R = (st >> 1) * 16 + swz / 64; C = (st & 1) * 32 + (swz % 64) / 2; }
__host__ __device__ __forceinline__ int perm32(int rho) { const int n = rho >> 4, i = rho & 15; return 8 * (i >> 2) + 4 * n + (i & 3); }
__host__ __device__ __forceinline__ int perm32x(int rho) { const int n = rho >> 4, i = rho & 15, q = i >> 2, gq = ((q & 1) << 1) | (q >> 1); return 8 * gq + 4 * n + (i & 3); }
struct Unit { int pm, pn, e; };

template <class Epi, class Sched, bool GATHER, bool GS, bool FP8 = false>
DI void gemm_phase(LAS unsigned char* lds, const int lda, const int K, const Sched& S, const Epi& E, const LAS float* gstab) {
    const int tid = fresh_tid(), wid = __builtin_amdgcn_readfirstlane(tid >> 6), lane = tid & 63, wr = wid >> 2, wc = wid & 3, fr = lane & 15, fq = lane >> 4;
    const int nt = K / BK;
    unsigned voffA0[2], voffA1[2], voffB[2], nvA0[2], nvA1[2]; int RA[2], CA[2];
#pragma unroll
    for (int i = 0; i < 2; ++i) { int R, C; stage_rc(tid * 16 + i * 8192, R, C); const int Rb = (R & ~31) + (Epi::PERMX ? perm32x(R & 31) : perm32(R & 31));
        RA[i] = R; CA[i] = C * 2; voffA0[i] = (unsigned)(R * lda + C) * 2u; voffA1[i] = (unsigned)((R + HALF) * lda + C) * 2u; voffB[i] = (unsigned)(Rb * K + C) * 2u; nvA0[i] = voffA0[i]; nvA1[i] = voffA1[i]; }
    const size_t kstep = (size_t)(BK * 2);
    const size_t hstepB = (size_t)HALF * K * 2;
    const size_t hstepA = (size_t)HALF * lda * 2;
    const size_t q64A = (size_t)64 * lda * 2, q64B = (size_t)64 * K * 2;
    const unsigned ldsw = (unsigned)wid * 1024u;
    const int aoff = lds_byte(wr * 64 + fr, fq * 8), boff = lds_byte(wc * 32 + fr, fq * 8);
#define PG8_SA(b, h) (((b) * 2 + (h)) * HTB)
#define PG8_SB(b, h) ((4 + (b) * 2 + (h)) * HTB)
#define PG8_STAGE2(bufoff, gbase, o0, o1) do { \
        __builtin_amdgcn_global_load_lds((const unsigned*)((const char*)(gbase) + (o0)), (LAS unsigned*)(lds + (bufoff) + ldsw), 16, 0, 0); \
        __builtin_amdgcn_global_load_lds((const unsigned*)((const char*)(gbase) + (o1)), (LAS unsigned*)(lds + (bufoff) + ldsw + 8192), 16, 0, 0); } while (0)
#define PG8_STAGE_B(bufoff, gbase) do { \
        __builtin_amdgcn_global_load_lds((const unsigned*)((const char*)(gbase) + voffB[0]), (LAS unsigned*)(lds + (bufoff) + ldsw), 16, 0, 0); \
        __builtin_amdgcn_global_load_lds((const unsigned*)((const char*)(gbase) + q64B + voffB[0]), (LAS unsigned*)(lds + (bufoff) + ldsw + 8192), 16, 0, 0); } while (0)
#define PG8_STAGE_A0(bufoff, gbase, o0, o1) do { if constexpr (GATHER) PG8_STAGE2(bufoff, gbase, o0, o1); else { \
        __builtin_amdgcn_global_load_lds((const unsigned*)((const char*)(gbase) + (o0)), (LAS unsigned*)(lds + (bufoff) + ldsw), 16, 0, 0); \
        __builtin_amdgcn_global_load_lds((const unsigned*)((const char*)(gbase) + q64A + (o0)), (LAS unsigned*)(lds + (bufoff) + ldsw + 8192), 16, 0, 0); } } while (0)
#define PG8_STAGE_A1(bufoff, gbase, o0, o1, p0, p1) do { if constexpr (GATHER) PG8_STAGE2(bufoff, gbase, o0, o1); else PG8_STAGE_A0(bufoff, (gbase) + hstepA, p0, p1); } while (0)
#define PG8_LDA(dst, b, h) do { _Pragma("unroll") for (int m = 0; m < 4; ++m) _Pragma("unroll") for (int k = 0; k < 2; ++k) dst[m][k] = *(const LAS bf16x8*)(lds + PG8_SA(b, h) + aoff + m * 2048 + k * 1024); } while (0)
#define PG8_LDB(dst, b, h) do { _Pragma("unroll") for (int n = 0; n < 2; ++n) _Pragma("unroll") for (int k = 0; k < 2; ++k) dst[n][k] = *(const LAS bf16x8*)(lds + PG8_SB(b, h) + boff + n * 2048 + k * 1024); } while (0)
#define PG8_MMA(ai, bj, At, Bt) do { __builtin_amdgcn_s_setprio(1); _Pragma("unroll") for (int m = 0; m < 4; ++m) _Pragma("unroll") for (int n = 0; n < 2; ++n) { \
        if constexpr (FP8) { mfma8(acc[ai][bj][m][n], cat8(Bt[n][0], Bt[n][1]), cat8(At[m][0], At[m][1])); } \
        else { _Pragma("unroll") for (int k = 0; k < 2; ++k) acc[ai][bj][m][n] = __builtin_amdgcn_mfma_f32_16x16x32_bf16(Bt[n][k], At[m][k], acc[ai][bj][m][n], 0, 0, 0); } } if constexpr (FP8) asm volatile("s_nop 1" ::: "memory"); __builtin_amdgcn_s_setprio(0); } while (0)
#define PG8_WAIT_V(n) asm volatile("s_waitcnt vmcnt(" #n ")" ::: "memory")
#define PG8_WAIT_L(n) asm volatile("s_waitcnt lgkmcnt(" #n ")" ::: "memory")
#define PG8_BAR __builtin_amdgcn_s_barrier()
#define PG8_SCHED __builtin_amdgcn_sched_barrier(0)
    Unit cur, nxt; int ui = 0;
    if (!S.next(0, cur)) return;
    f32x4 acc[2][2][4][2];
#pragma unroll
    for (int a = 0; a < 2; ++a)
#pragma unroll
        for (int b = 0; b < 2; ++b)
#pragma unroll
            for (int m = 0; m < 4; ++m)
#pragma unroll
                for (int n = 0; n < 2; ++n) acc[a][b][m][n] = (f32x4){0.f, 0.f, 0.f, 0.f};
    bf16x8 At[4][2], B0[2][2], B1[2][2];
    const char* cA = S.abase(cur); const char* cB = S.bbase(cur);
    if constexpr (GATHER) {
#pragma unroll
        for (int i = 0; i < 2; ++i) { voffA0[i] = S.arow_off(cur, RA[i]) + (unsigned)CA[i]; voffA1[i] = S.arow_off(cur, RA[i] + HALF) + (unsigned)CA[i]; nvA0[i] = voffA0[i]; nvA1[i] = voffA1[i]; }
    }
    PG8_STAGE_B(PG8_SB(0, 0), cB); PG8_STAGE_B(PG8_SB(0, 1), cB + hstepB); PG8_STAGE_A0(PG8_SA(0, 0), cA, voffA0[0], voffA0[1]); PG8_STAGE_A1(PG8_SA(0, 1), cA, voffA1[0], voffA1[1], voffA0[0], voffA0[1]);
    if (wr == 1) PG8_BAR;
    PG8_WAIT_V(2); PG8_BAR;
    PG8_STAGE_B(PG8_SB(1, 0), cB + kstep); PG8_STAGE_A0(PG8_SA(1, 0), cA + kstep, voffA0[0], voffA0[1]); PG8_STAGE_B(PG8_SB(1, 1), cB + hstepB + kstep);
    PG8_WAIT_V(6); PG8_BAR;
    for (;;) {
        const bool has_next = S.next(ui + 1, nxt);
        const char* nA = has_next ? S.abase(nxt) : cA; const char* nB = has_next ? S.bbase(nxt) : cB;
        for (int t = 0; t < nt; t += 2) {
            const bool last = (t == nt - 2);
            const char* a1 = cA + (size_t)(t + 1) * kstep;
            const char* a2 = last ? nA : cA + (size_t)(t + 2) * kstep; const char* b2 = last ? nB : cB + (size_t)(t + 2) * kstep;
            const char* a3 = a2 + kstep; const char* b3 = b2 + kstep;
            if constexpr (GATHER) {
                if (t == nt - 4) {
                    if (has_next) { const int tid2 = fresh_tid();
#pragma unroll
                        for (int i = 0; i < 2; ++i) { int R2, C2; stage_rc(tid2 * 16 + i * 8192, R2, C2); nvA0[i] = S.arow_off(nxt, R2) + (unsigned)(C2 * 2); nvA1[i] = S.arow_off(nxt, R2 + HALF) + (unsigned)(C2 * 2); }
                    } else {
#pragma unroll
                        for (int i = 0; i < 2; ++i) { nvA0[i] = voffA0[i]; nvA1[i] = voffA1[i]; }
                    }
                }
            }
            unsigned xo0[2], xo1[2];
#pragma unroll
            for (int i = 0; i < 2; ++i) { xo0[i] = (GATHER && last) ? nvA0[i] : voffA0[i]; xo1[i] = (GATHER && last) ? nvA1[i] : voffA1[i]; }
            if constexpr (GS) {
                PG8_SCHED;
                if (t != 0 && (t & 3) == 0) {
                    const int g = (t >> 2) - 1; const int fr2 = fresh_tid() & 15;
#pragma unroll
                    for (int ai = 0; ai < 2; ++ai)
#pragma unroll
                        for (int m = 0; m < 4; ++m) { const float f = gstab[((ui & 3) * 256 + ai * HALF + wr * 64 + m * 16 + fr2) * 4 + g];
#pragma unroll
                            for (int bj = 0; bj < 2; ++bj)
#pragma unroll
                                for (int n = 0; n < 2; ++n) acc[ai][bj][m][n] *= f; }
                }
                PG8_SCHED;
            }
            PG8_LDB(B0, 0, 0); PG8_LDB(B1, 0, 1); PG8_SCHED; PG8_LDA(At, 0, 0); PG8_STAGE_A1(PG8_SA(1, 1), a1, voffA1[0], voffA1[1], voffA0[0], voffA0[1]);
            PG8_WAIT_V(8); PG8_WAIT_L(0); PG8_BAR; PG8_MMA(0, 0, At, B0); PG8_MMA(0, 1, At, B1); PG8_BAR; PG8_SCHED;
            PG8_LDA(At, 0, 1); PG8_STAGE_B(PG8_SB(0, 0), b2); PG8_STAGE_B(PG8_SB(0, 1), b2 + hstepB); PG8_STAGE_A0(PG8_SA(0, 0), a2, xo0[0], xo0[1]);
            PG8_WAIT_V(8); PG8_WAIT_L(0); PG8_BAR; PG8_MMA(1, 0, At, B0); PG8_MMA(1, 1, At, B1); PG8_BAR; PG8_SCHED;
            PG8_LDB(B0, 1, 0); PG8_LDB(B1, 1, 1); PG8_SCHED; PG8_LDA(At, 1, 0); PG8_STAGE_A1(PG8_SA(0, 1), a2, xo1[0], xo1[1], xo0[0], xo0[1]);
            PG8_WAIT_V(8); PG8_WAIT_L(0); PG8_BAR; PG8_MMA(0, 0, At, B0); PG8_MMA(0, 1, At, B1); PG8_BAR; PG8_SCHED;
            PG8_LDA(At, 1, 1); PG8_STAGE_B(PG8_SB(1, 0), b3); PG8_STAGE_B(PG8_SB(1, 1), b3 + hstepB); PG8_STAGE_A0(PG8_SA(1, 0), a3, xo0[0], xo0[1]);
            PG8_WAIT_V(8); PG8_WAIT_L(0); PG8_BAR; PG8_MMA(1, 0, At, B0); PG8_MMA(1, 1, At, B1); PG8_BAR; PG8_SCHED;
        }
        if (wr == 0) PG8_BAR;
        if constexpr (FP8) asm volatile("s_nop 15\n\ts_nop 15" ::: "memory");
        { const int l2 = fresh_tid() & 63; E(acc, cur, ui, wr, wc, l2 & 15, l2 >> 4, gstab); }
        if (!has_next) break;
#pragma unroll
        for (int a = 0; a < 2; ++a)
#pragma unroll
            for (int b = 0; b < 2; ++b)
#pragma unroll
                for (int m = 0; m < 4; ++m)
#pragma unroll
                    for (int n = 0; n < 2; ++n) acc[a][b][m][n] = (f32x4){0.f, 0.f, 0.f, 0.f};
        cur = nxt; cA = nA; cB = nB; ++ui;
        if constexpr (GATHER) {
#pragma unroll
            for (int i = 0; i < 2; ++i) { voffA0[i] = nvA0[i]; voffA1[i] = nvA1[i]; }
        }
        if (wr == 1) PG8_BAR;
    }
    PG8_WAIT_V(0);
    PG8_BAR;
#undef PG8_SA
#undef PG8_SB
#undef PG8_STAGE2
#undef PG8_STAGE_B
#undef PG8_STAGE_A0
#undef PG8_STAGE_A1
#undef PG8_LDA
#undef PG8_LDB
#undef PG8_MMA
#undef PG8_WAIT_V
#undef PG8_WAIT_L
#undef PG8_BAR
#undef PG8_SCHED
}
}
using pg8::Unit;

constexpr int XR = 4;
struct SchedPlain {
    const char* A; const char* Bt; int lda, K, nM, nN, G, c;
    DI bool next(int i, Unit& u) const {
        const int U = nM * nN, U8 = (U + 7) >> 3, o = i * (G >> 3) + (c >> 3), L = (c & 7) * U8 + o; if (o >= U8 || L >= U) return false;
        const int grp = L / (XR * nN), rem = L - grp * (XR * nN), fm = grp * XR, gsz = (nM - fm) < XR ? (nM - fm) : XR;
        u.pm = fm + rem % gsz; u.pn = rem / gsz; u.e = 0; return true;
    }
    DI int xcnt(int x) const { const int U = nM * nN, U8 = (U + 7) >> 3; const int n = U - x * U8; return n < 0 ? 0 : (n > U8 ? U8 : n); }
    DI const char* abase(const Unit& u) const { return A + (size_t)u.pm * 256 * lda * 2; }
    DI const char* bbase(const Unit& u) const { return Bt + (size_t)u.pn * 256 * K * 2; }
    DI unsigned arow_off(const Unit&, int) const { return 0u; }
    DI void a_ready(const Unit&) const {}
};

DI float ss_sum(const float* ss, int row, int nslot) {
    if (nslot == 1) return ss[row];
    const f32x4* q = (const f32x4*)(ss + (size_t)row * 16); const f32x4 a = q[0], b = q[1], c = q[2], d = q[3];
    return (((a[0] + a[1]) + (a[2] + a[3])) + ((b[0] + b[1]) + (b[2] + b[3]))) + (((c[0] + c[1]) + (c[2] + c[3])) + ((d[0] + d[1]) + (d[2] + d[3])));
}
struct EpiZ {
    static constexpr bool PERMX = false;
    bf16_t* Z;
    DI void operator()(const f32x4 (&acc)[2][2][4][2], const Unit& u, int ui, int wr, int wc, int fr, int fq, const LAS float* rst) const {
        const int row0 = u.pm * 256 + wr * 64 + fr, col0 = u.pn * 256 + wc * 32 + 8 * fq;
#pragma unroll
        for (int ai = 0; ai < 2; ++ai)
#pragma unroll
            for (int m = 0; m < 4; ++m) { const int row = row0 + ai * 128 + m * 16; const float rs = rst[ui * 256 + ai * 128 + wr * 64 + m * 16 + fr];
                bf16_t* rowp = Z + (size_t)row * ZC + col0;
#pragma unroll
                for (int bj = 0; bj < 2; ++bj) { const f32x4 v0 = acc[ai][bj][m][0] * rs, v1 = acc[ai][bj][m][1] * rs; u32x4 w;
                    w.x = cvtpk(v0[0], v0[1]); w.y = cvtpk(v0[2], v0[3]); w.z = cvtpk(v1[0], v1[1]); w.w = cvtpk(v1[2], v1[3]); *(u32x4*)(rowp + bj * 128) = w; } }
    }
};
struct EpiRes {
    static constexpr bool PERMX = false;
    bf16_t* hb; float* ss_out; int gs; unsigned char* h8; float ascale;
    DI void operator()(const f32x4 (&acc)[2][2][4][2], const Unit& u, int ui, int wr, int wc, int fr, int fq, const LAS float* gstab) const {
        const int row0 = u.pm * 256 + wr * 64 + fr, col0 = u.pn * 256 + wc * 32 + 8 * fq;
#pragma unroll
        for (int ai = 0; ai < 2; ++ai) {
        u32x4 rw[1][4][2];
#pragma unroll
            for (int m = 0; m < 4; ++m)
#pragma unroll
                for (int bj = 0; bj < 2; ++bj) rw[0][m][bj] = *(const u32x4*)(hb + (size_t)(row0 + ai * 128 + m * 16) * D + col0 + bj * 128);
        asm volatile("" ::: "memory");
#pragma unroll
            for (int m = 0; m < 4; ++m) { const int row = row0 + ai * 128 + m * 16; const size_t off = (size_t)row * D + col0;
                const float f = gs ? gstab[((ui & 3) * 256 + ai * 128 + wr * 64 + m * 16 + fr) * 4 + 3] : ascale; float sq = 0.f;
#pragma unroll
                for (int bj = 0; bj < 2; ++bj) { const u32x4 r = rw[0][m][bj];
                    const f32x4 r0 = {bflo(r.x), bfhi(r.x), bflo(r.y), bfhi(r.y)}, r1 = {bflo(r.z), bfhi(r.z), bflo(r.w), bfhi(r.w)};
                    const f32x4 v0 = r0 + acc[ai][bj][m][0] * f, v1 = r1 + acc[ai][bj][m][1] * f;
                    u32x4 w; w.x = cvtpk(v0[0], v0[1]); w.y = cvtpk(v0[2], v0[3]); w.z = cvtpk(v1[0], v1[1]); w.w = cvtpk(v1[2], v1[3]); *(u32x4*)(hb + off + bj * 128) = w;
                    if (h8) { u32x2 w8; w8.x = pk4_fp8(v0[0], v0[1], v0[2], v0[3]); w8.y = pk4_fp8(v1[0], v1[1], v1[2], v1[3]); *(u32x2*)(h8 + off + bj * 128) = w8; }
                    sq += (v0[0] * v0[0] + v0[1] * v0[1]) + (v0[2] * v0[2] + v0[3] * v0[3]) + (v1[0] * v1[0] + v1[1] * v1[1]) + (v1[2] * v1[2] + v1[3] * v1[3]); }
                sq += __shfl_xor(sq, 16); sq += __shfl_xor(sq, 32);
                if (fq == 0 && ss_out) ss_out[(size_t)row * 16 + u.pn * 4 + wc] = sq; }
        asm volatile("" ::: "memory"); }
    }
};


struct EpiGU {
    static constexpr bool PERMX = false;
    bf16_t* ACT; int ldact; const float* ss;
    DI void operator()(const f32x4 (&acc)[2][2][4][2], const Unit& u, int, int wr, int wc, int fr, int fq, const LAS float*) const {
        const int row0 = u.pm * 256 + wr * 64 + fr, col0 = u.pn * 128 + wc * 32 + 8 * fq;
#pragma unroll
        for (int ai = 0; ai < 2; ++ai)
#pragma unroll
            for (int m = 0; m < 4; ++m) { const int row = row0 + ai * 128 + m * 16; const float rs = rsqrtf(ss_sum(ss, row, 16) * (1.f / 1024.f) + EPS); float a[8];
#pragma unroll
                for (int n = 0; n < 2; ++n)
#pragma unroll
                    for (int e = 0; e < 4; ++e) { const float g = acc[ai][0][m][n][e] * rs, uu = acc[ai][1][m][n][e] * rs; a[4 * n + e] = g * uu * __builtin_amdgcn_rcpf(1.f + __expf(-g)); }
                u32x4 w; w.x = cvtpk(a[0], a[1]); w.y = cvtpk(a[2], a[3]); w.z = cvtpk(a[4], a[5]); w.w = cvtpk(a[6], a[7]);
                *(u32x4*)(ACT + (size_t)row * ldact + col0) = w; }
    }
};
struct EpiGU8 {
    static constexpr bool PERMX = true;
    unsigned char* ACT; int ldact; float wsc;
    DI void operator()(const f32x4 (&acc)[2][2][4][2], const Unit& u, int ui, int wr, int wc, int fr, int fq, const LAS float* rst) const {
        const int row0 = u.pm * 256 + wr * 64 + fr, col0 = u.pn * 128 + wc * 32 + 16 * (fq & 1), hi = fq >> 1;
#pragma unroll
        for (int ai = 0; ai < 2; ++ai)
#pragma unroll
            for (int mp = 0; mp < 2; ++mp) { const int m0 = 2 * mp, m1 = m0 + 1; const LAS float* rp = rst + ui * 256 + ai * 128 + wr * 64 + fr;
                const u32x2 wa = swiglu8_fp8(acc[ai][0][m0][0], acc[ai][0][m0][1], acc[ai][1][m0][0], acc[ai][1][m0][1], rp[m0 * 16] * wsc);
                const u32x2 wb = swiglu8_fp8(acc[ai][0][m1][0], acc[ai][0][m1][1], acc[ai][1][m1][0], acc[ai][1][m1][1], rp[m1 * 16] * wsc);
                const auto s0 = __builtin_amdgcn_permlane32_swap(wa.x, wb.x, false, false), s1 = __builtin_amdgcn_permlane32_swap(wa.y, wb.y, false, false);
                *(u32x4*)(ACT + (size_t)(row0 + ai * 128 + (m0 + hi) * 16) * ldact + col0) = (u32x4){s0[0], s1[0], s0[1], s1[1]}; asm volatile("" ::: "memory"); }
    }
};
struct SchedMoe {
    const char* A; const char* B0; size_t bstride; int lda, K, nT, nN, G, c; const LAS int* tab; const int* list; bool gather; unsigned rowbytes; int nh, skew;
    DI bool next(int i, Unit& u) const { int o; const int U = nT * nN, U8 = (U + 7) >> 3, B = G >> 3, j = c >> 3;
        if (nh == 0) o = i * B + j;
        else if (j >= nh) o = (i < skew) ? i * (B - nh) + (j - nh) : skew * (B - nh) + (i - skew) * B + j;
        else o = skew * (B - nh) + i * B + j;
        const int L = (c & 7) * U8 + o; if (o >= U8 || L >= U) return false;
        const int grp = L / (XR * nN), rem = L - grp * (XR * nN), fm = grp * XR, gsz = (nT - fm) < XR ? (nT - fm) : XR;
        u.pm = fm + rem % gsz; u.pn = rem / gsz; u.e = tab[u.pm * 4]; return true; }
    DI const char* abase(const Unit& u) const { return gather ? A : A + (size_t)u.pm * 256 * lda * 2; }
    DI const char* bbase(const Unit& u) const { return B0 + (size_t)u.e * bstride + (size_t)u.pn * 256 * K * 2; }
    DI unsigned arow_off(const Unit& u, int r) const { const int off = tab[u.pm * 4 + 1], n = tab[u.pm * 4 + 2]; const int idx = off + r; const int tok = idx < n ? list[u.e * 32768 + idx] : 0; return (unsigned)tok * rowbytes; }
    DI void a_ready(const Unit&) const {}
};
struct EpiMoeGU {
    static constexpr bool PERMX = true;
    unsigned char* ACT; const float* lrs; const LAS int* tab;
    DI void operator()(const f32x4 (&acc)[2][2][4][2], const Unit& u, int ui, int wr, int wc, int fr, int fq, const LAS float* rst) const {
        const int r0 = wr * 64 + fr, col0 = u.pn * 128 + wc * 32 + 16 * (fq & 1), hi = fq >> 1; const LAS float* rsp = rst + ui * 256 + r0;
#pragma unroll
        for (int ai = 0; ai < 2; ++ai)
#pragma unroll
            for (int mp = 0; mp < 2; ++mp) { const int m0 = 2 * mp, m1 = m0 + 1;
                const u32x2 wa = swiglu8_fp8(acc[ai][0][m0][0], acc[ai][0][m0][1], acc[ai][1][m0][0], acc[ai][1][m0][1], rsp[ai * 128 + m0 * 16] * (1.f / W8_SCALE));
                const u32x2 wb = swiglu8_fp8(acc[ai][0][m1][0], acc[ai][0][m1][1], acc[ai][1][m1][0], acc[ai][1][m1][1], rsp[ai * 128 + m1 * 16] * (1.f / W8_SCALE));
                const auto s0 = __builtin_amdgcn_permlane32_swap(wa.x, wb.x, false, false), s1 = __builtin_amdgcn_permlane32_swap(wa.y, wb.y, false, false);
                *(u32x4*)(ACT + (size_t)(u.pm * 256 + r0 + ai * 128 + (m0 + hi) * 16) * DFE + col0) = (u32x4){s0[0], s1[0], s0[1], s1[1]}; }
    }
};
struct EpiMoeDown {
    static constexpr bool PERMX = false;
    float* out; const int* list; const float* lgate; const LAS int* tab; bf16_t* hb; bool last;
    DI void operator()(const f32x4 (&acc)[2][2][4][2], const Unit& u, int, int wr, int wc, int fr, int fq, const LAS float*) const {
        const int off = tab[u.pm * 4 + 1], n = tab[u.pm * 4 + 2]; const int r0 = wr * 64 + fr, col0 = u.pn * 256 + wc * 32 + 8 * fq;
        int tok[2][4]; float gt[2][4];
#pragma unroll
        for (int ai = 0; ai < 2; ++ai)
#pragma unroll
            for (int m = 0; m < 4; ++m) { const int idx = off + r0 + ai * 128 + m * 16, ci = idx < n ? idx : n - 1;
                tok[ai][m] = list[u.e * 32768 + ci]; gt[ai][m] = lgate[u.e * 32768 + ci] * (1.f / (W8_SCALE * ACT8_SCALE)); }
        u32x4 rw[2][4][2];
#pragma unroll
        for (int ai = 0; ai < 2; ++ai)
#pragma unroll
            for (int m = 0; m < 4; ++m)
#pragma unroll
                for (int bj = 0; bj < 2; ++bj) rw[ai][m][bj] = *(const u32x4*)(hb + (size_t)tok[ai][m] * D + col0 + bj * 128);
        asm volatile("" ::: "memory");
#pragma unroll
        for (int ai = 0; ai < 2; ++ai)
#pragma unroll
            for (int m = 0; m < 4; ++m) if (off + r0 + ai * 128 + m * 16 < n) { const size_t ro = (size_t)tok[ai][m] * D + col0; const float g = gt[ai][m];
#pragma unroll
                for (int bj = 0; bj < 2; ++bj) { const u32x4 r = rw[ai][m][bj];
                    const f32x4 v0 = (f32x4){bflo(r.x), bfhi(r.x), bflo(r.y), bfhi(r.y)} + acc[ai][bj][m][0] * g, v1 = (f32x4){bflo(r.z), bfhi(r.z), bflo(r.w), bfhi(r.w)} + acc[ai][bj][m][1] * g;
                    if (last) { __builtin_nontemporal_store(v0, (f32x4*)(out + ro + bj * 128)); __builtin_nontemporal_store(v1, (f32x4*)(out + ro + bj * 128 + 4)); }
                    else { u32x4 w; w.x = cvtpk(v0[0], v0[1]); w.y = cvtpk(v0[2], v0[3]); w.z = cvtpk(v1[0], v1[1]); w.w = cvtpk(v1[2], v1[3]); *(u32x4*)(hb + ro + bj * 128) = w; } } }
    }
};
DI f32x4 skinny_acc(const bf16_t* A, int lda, const bf16_t* Bt, int K, int n0, int k0, int k1, int lane) {
    const int fr = lane & 15, g = lane >> 4; f32x4 acc = {0.f, 0.f, 0.f, 0.f};
    const bf16_t* ap = A + (size_t)fr * lda + 8 * g; const bf16_t* bp = Bt + (size_t)(n0 + fr) * K + 8 * g;
#pragma unroll 4
    for (int k = k0; k < k1; k += 32) { const bf16x8 a = *(const bf16x8*)(ap + k), b = *(const bf16x8*)(bp + k); acc = __builtin_amdgcn_mfma_f32_16x16x32_bf16(b, a, acc, 0, 0, 0); }
    return acc;
}

DI f32x4 skinny_block(LAS unsigned char* lds, const bf16_t* A, int lda, const bf16_t* Bt, int K, int n0, int kc, float scale, int tid) {
    const int lane = tid & 63, wave = tid >> 6;
    const f32x4 part = skinny_acc(A, lda, Bt, K, n0, wave * kc, wave * kc + kc, lane) * scale;
    LAS f32x4* red = (LAS f32x4*)lds; red[wave * 64 + lane] = part;
    __syncthreads();
    f32x4 tot = red[lane];
#pragma unroll
    for (int w = 1; w < 8; ++w) tot = tot + red[w * 64 + lane];
    __syncthreads();
    return tot;
}
DI void meta_rs(LAS float* rsm, const float* hm, int tid) {
    const int row = tid >> 5, l32 = tid & 31; const f32x4* q = (const f32x4*)(hm + (size_t)row * D) + l32; float sv = 0.f;
#pragma unroll
    for (int j = 0; j < 8; ++j) { const f32x4 v = q[32 * j]; sv += (v[0] * v[0] + v[1] * v[1]) + (v[2] * v[2] + v[3] * v[3]); }
    sv += __shfl_xor(sv, 1); sv += __shfl_xor(sv, 2); sv += __shfl_xor(sv, 4); sv += __shfl_xor(sv, 8); sv += __shfl_xor(sv, 16);
    if (l32 == 0) rsm[row] = rsqrtf(sv * (1.f / 1024.f) + EPS);
    __syncthreads();
}

template <class Sched> DI void fill_rs_table(const Sched& S, const float* ss, int nslot, LAS float* rst, int tid) {
    Unit u;
    for (int i = 0; i < 16 && S.next(i, u); ++i) if (tid < 256) rst[i * 256 + tid] = rsqrtf(ss_sum(ss, u.pm * 256 + tid, nslot) * (1.f / 1024.f) + EPS);
    __syncthreads();
}
DI void fill_moe_rs_table(const SchedMoe& S, const float* lrs, LAS float* rst, int tid) {
    Unit u;
    for (int i = 0; i < 16 && S.next(i, u); ++i) if (tid < 256) rst[i * 256 + tid] = lrs[u.e * 32768 + S.tab[u.pm * 4 + 1] + tid];
    __syncthreads();
}
struct Params {
    const float* x; const float* meta; const float* norm1_g; const float* norm2_g; const float* w_in; const float* w_out; const float* out_norm_g;
    const float* lru_conv_w; const float* lru_conv_b; const float* lru_wa; const float* lru_ba; const float* lru_wx; const float* lru_bx; const float* lru_lambda;
    const float* hg_lb_logits; const float* mla_gq; const float* mla_w_uq; const float* mla_gkv; const float* mla_w_ukv; const float* mla_gqn; const float* mla_gkn;
    const float* fox_gqn; const float* fox_gkn; const float* fox_bf; const float* ffn_w_gate; const float* ffn_w_up; const float* ffn_w_down;
    const float* moe_w_router; const float* moe_w_gate; const float* moe_w_up; const float* moe_w_down;
    float* out; unsigned char* ws;
};

struct Frame {
    LAS unsigned char* lds; int G, vcu;
};
#define TID_VARS const int tid = fresh_tid(); const int lane = tid & 63; const int wave = __builtin_amdgcn_readfirstlane(tid >> 6); (void)lane; (void)wave

DI void wt_item(const float* W, int ldw, int c0, int nv, const float* g, bf16_t* WT, int K, int n0, int k0, LAS float* scr, int lane) {
    { const int c4 = (lane & 7) * 4; f32x4 v[8];
#pragma unroll
      for (int i = 0; i < 8; ++i) { const int kk = 8 * i + (lane >> 3); const float* src = W + (size_t)(k0 + kk) * ldw + c0 + c4;
          if (c4 + 3 < nv) v[i] = __builtin_nontemporal_load((const f32x4*)src); else { v[i] = (f32x4){0.f, 0.f, 0.f, 0.f}; if (c4 < nv) v[i][0] = src[0]; if (c4 + 1 < nv) v[i][1] = src[1]; if (c4 + 2 < nv) v[i][2] = src[2]; } }
#pragma unroll
      for (int i = 0; i < 8; ++i) { const int kk = 8 * i + (lane >> 3); const float gs = g ? g[k0 + kk] : 1.f; LAS float* d = scr + kk * 33 + c4; d[0] = v[i][0] * gs; d[1] = v[i][1] * gs; d[2] = v[i][2] * gs; d[3] = v[i][3] * gs; } }
    LDS_WAIT(); asm volatile("" ::: "memory");
    const int c = lane & 7;
#pragma unroll
    for (int j = 0; j < 4; ++j) { const int n = (lane >> 3) + 8 * j; const LAS float* s = scr + (8 * c) * 33 + n;
        u32x4 o; o.x = cvtpk(s[0 * 33], s[1 * 33]); o.y = cvtpk(s[2 * 33], s[3 * 33]); o.z = cvtpk(s[4 * 33], s[5 * 33]); o.w = cvtpk(s[6 * 33], s[7 * 33]);
        *(u32x4*)(WT + (size_t)(n0 + n) * K + k0 + 8 * c) = o; }
    LDS_WAIT(); asm volatile("" ::: "memory");
}
DI void wt_load8(const float* W, int ldw, int c0, int k0, int lane, f32x4 (&v)[8]) {
    const int c4 = (lane & 7) * 4;
#pragma unroll
    for (int i = 0; i < 8; ++i) { const int kk = 8 * i + (lane >> 3); v[i] = __builtin_nontemporal_load((const f32x4*)(W + (size_t)(k0 + kk) * ldw + c0 + c4)); }
}
DI void wt_finish8(const f32x4 (&v)[8], const float* g, float scale, unsigned char* WT, int K8, int n0, int k0, LAS float* scr, int lane) {
    { const int c4 = (lane & 7) * 4;
#pragma unroll
      for (int i = 0; i < 8; ++i) { const int kk = 8 * i + (lane >> 3); const float gs = g ? g[k0 + kk] * scale : scale; LAS float* d = scr + kk * 33 + c4; d[0] = v[i][0] * gs; d[1] = v[i][1] * gs; d[2] = v[i][2] * gs; d[3] = v[i][3] * gs; } }
    LDS_WAIT(); asm volatile("" ::: "memory");
    const int c = lane & 3;
#pragma unroll
    for (int j = 0; j < 2; ++j) { const int n = (lane >> 2) + 16 * j; const LAS float* sp = scr + (16 * c) * 33 + n; u32x4 o;
        o.x = pk4_fp8(sp[0 * 33], sp[1 * 33], sp[2 * 33], sp[3 * 33]); o.y = pk4_fp8(sp[4 * 33], sp[5 * 33], sp[6 * 33], sp[7 * 33]); o.z = pk4_fp8(sp[8 * 33], sp[9 * 33], sp[10 * 33], sp[11 * 33]); o.w = pk4_fp8(sp[12 * 33], sp[13 * 33], sp[14 * 33], sp[15 * 33]);
        *(u32x4*)(WT + (size_t)(n0 + n) * K8 + k0 + 16 * c) = o; }
    LDS_WAIT(); asm volatile("" ::: "memory");
}
DI void wt_item8(const float* W, int ldw, int c0, const float* g, float scale, unsigned char* WT, int K8, int n0, int k0, LAS float* scr, int lane) {
    f32x4 v[8]; wt_load8(W, ldw, c0, k0, lane, v); wt_finish8(v, g, scale, WT, K8, n0, k0, scr, lane);
}
DI void inmap(int nb, int& c0, int& nv) {
    nv = 32;
    if (nb < 48) c0 = 32 * nb;
    else if (nb < 54) c0 = 1536 + 32 * (nb - 48);
    else if (nb < 56) { c0 = 0; nv = 0; }
    else if (nb < 60) c0 = 1728 + 32 * (nb - 56);
    else if (nb == 60) c0 = 1856;
    else if (nb == 61) { c0 = 2656; nv = 4; }
    else if (nb < 64) { c0 = 0; nv = 0; }
    else if (nb < 72) c0 = 1888 + 32 * (nb - 64);
    else if (nb < 80) c0 = 2144 + 32 * (nb - 72);
    else c0 = 2400 + 32 * (nb - 80);
}
DI float row_to_bf16(const float* xrow, bf16_t* orow, int lane) {
    const f32x4* xr = (const f32x4*)xrow + lane; f32x4 v[4]; float s = 0.f;
#pragma unroll
    for (int j = 0; j < 4; ++j) { v[j] = xr[64 * j]; s += (v[j].x * v[j].x + v[j].y * v[j].y) + (v[j].z * v[j].z + v[j].w * v[j].w); }
    u32x2* o8 = (u32x2*)orow + lane;
#pragma unroll
    for (int j = 0; j < 4; ++j) { u32x2 w; w.x = cvtpk(v[j].x, v[j].y); w.y = cvtpk(v[j].z, v[j].w); o8[64 * j] = w; }
    return wave_sum(s);
}

constexpr int CV_I_IN = 88 * 16, CV_I_OUT = 32 * 16, CV_I_G = 88 * 16, CV_I_D = 32 * 44, CV_NITEMS = 2 * CV_I_IN + 2 * CV_I_OUT + 2 * CV_I_G + CV_I_D;
DI void convert_weights(const Params& p, LAS float* scr, int it0, int it1, int gw, int NGW, int lane) {
    bf16_t* Win = (bf16_t*)(p.ws + WS_WIN); bf16_t* Wout = (bf16_t*)(p.ws + WS_WOUT); bf16_t* Wgu = (bf16_t*)(p.ws + WS_WGU); bf16_t* Wd = (bf16_t*)(p.ws + WS_WD);
    constexpr int I_IN = CV_I_IN, I_OUT = CV_I_OUT, I_G = CV_I_G;
    for (int it = it0 + gw; it < it1; it += NGW) {
        int r = it;
        if (r < 2 * I_IN) { const int l = r / I_IN; r %= I_IN; const int nb = r / 16, kb = r % 16; int c0, nv; inmap(nb, c0, nv);
            wt_item(p.w_in + (size_t)l * D * 2660, 2660, c0, nv, p.norm1_g + l * D, Win + (size_t)l * ZC * D, D, 32 * nb, 64 * kb, scr, lane); continue; }
        r -= 2 * I_IN;
        if (r < 2 * I_OUT) { const int l = r / I_OUT; r %= I_OUT; const int nb = r / 16, kb = r % 16;
            wt_item(p.w_out + (size_t)l * D * D, D, 32 * nb, 32, p.out_norm_g + l * D, Wout + (size_t)l * D * D, D, 32 * nb, 64 * kb, scr, lane); continue; }
        r -= 2 * I_OUT;
        if (r < 2 * I_G) { const int up = r / I_G; r %= I_G; const int sb = r / 16, kb = r % 16;
            wt_item(up ? p.ffn_w_up : p.ffn_w_gate, DFF, 32 * sb, 32, p.norm2_g, Wgu, D, 256 * (sb >> 2) + 128 * up + 32 * (sb & 3), 64 * kb, scr, lane); continue; }
        r -= 2 * I_G;
        { const int sb = r / 44, kb = r % 44; wt_item(p.ffn_w_down, D, 32 * sb, 32, nullptr, Wd, DFF, 32 * sb, 64 * kb, scr, lane); }
    }
}
DI void p0_prologue(const Params& p, const Frame& F, float* ss0) {
    TID_VARS;
    LAS float* scr = (LAS float*)(F.lds + wave * 16384);
    const int gw = F.vcu * 8 + wave, NGW = F.G * 8;
    bf16_t* Win = (bf16_t*)(p.ws + WS_WIN); bf16_t* Wout = (bf16_t*)(p.ws + WS_WOUT); bf16_t* Wgu = (bf16_t*)(p.ws + WS_WGU); bf16_t* Wd = (bf16_t*)(p.ws + WS_WD);
    convert_weights(p, scr, 0, CV_I_IN, gw, NGW, lane);
    { bf16_t* LW = (bf16_t*)(p.ws + WS_WSM + SM_LRUW); const int gt = F.vcu * 512 + tid, NT = F.G * 512;
      for (int i = gt; i < 2 * 2 * 4 * 64 * 64; i += NT) { const int c = i & 63, d = (i >> 6) & 63, blk = (i >> 12) & 3, mat = (i >> 14) & 1, l = i >> 15;
          const float* src = mat ? p.lru_wx : p.lru_wa; LW[i] = f2bf(src[((size_t)(l * 4 + blk) * 64 + c) * 64 + d]); } }
    { const int gt = F.vcu * 512 + tid, NT = F.G * 512;
      bf16_t* WQ = (bf16_t*)(p.ws + WS_WSM + SM_WUQ); bf16_t* WKV = (bf16_t*)(p.ws + WS_WSM + SM_WUKV);
      for (int i = gt; i < 2 * 384 * 192; i += NT) { const int k = i % 192, n = (i / 192) % 384, l = i / (192 * 384); WQ[i] = f2bf(p.mla_w_uq[((size_t)l * 192 + k) * 384 + n] * p.mla_gq[l * 192 + k]); }
      for (int i = gt; i < 2 * 512 * 128; i += NT) { const int k = i % 128, n = (i / 128) % 512, l = i / (128 * 512); WKV[i] = f2bf(p.mla_w_ukv[((size_t)l * 128 + k) * 512 + n] * p.mla_gkv[l * 128 + k]); }
      float* ROPE = (float*)(p.ws + WS_HG + HG_ROPE);
      for (int i = gt; i < 8208 * 16; i += NT) { const int pos = i >> 4, fi = i & 15, a = fi >> 2, bq = fi & 3;
          const double base = bq == 0 ? 1.0 : bq == 1 ? 0.5623413251903491 : bq == 2 ? 0.31622776601683794 : 0.1778279410038923;
          const double sc = a == 0 ? 1.0 : a == 1 ? 0.1 : a == 2 ? 0.01 : 0.001;
          double rev = (double)pos * (base * sc) * 0.15915494309189535; rev -= __builtin_floor(rev);
          ROPE[2 * i] = __builtin_amdgcn_cosf((float)rev); ROPE[2 * i + 1] = __builtin_amdgcn_sinf((float)rev); } }
    bf16_t* bufA = (bf16_t*)(p.ws + WS_BUFA);
    for (int m0 = 4 * gw; m0 < NR; m0 += 4 * NGW) {
        f32x4 v[4][4];
#pragma unroll
        for (int r = 0; r < 4; ++r)
#pragma unroll
            for (int j = 0; j < 4; ++j) v[r][j] = __builtin_nontemporal_load((const f32x4*)(p.x + (size_t)(m0 + r) * D) + lane + 64 * j);
#pragma unroll
        for (int r = 0; r < 4; ++r) { float sq = 0.f; u32x2* o8 = (u32x2*)(bufA + (size_t)(m0 + r) * D) + lane;
#pragma unroll
            for (int j = 0; j < 4; ++j) { sq += (v[r][j].x * v[r][j].x + v[r][j].y * v[r][j].y) + (v[r][j].z * v[r][j].z + v[r][j].w * v[r][j].w); u32x2 w; w.x = cvtpk(v[r][j].x, v[r][j].y); w.y = cvtpk(v[r][j].z, v[r][j].w); o8[64 * j] = w; }
            sq = wave_sum(sq); if (lane == 0) ss0[m0 + r] = sq; } }
    for (int m = gw; m < 256; m += NGW) {
        const int row = MB0 + m;
        if (m >= META_OFF && m < META_OFF + NMETA) { const float s = row_to_bf16(p.meta + (size_t)(m - META_OFF) * D, bufA + (size_t)row * D, lane); if (lane == 0) ss0[row] = s; }
        else { u32x4* o = (u32x4*)(bufA + (size_t)row * D) + lane; o[0] = zero4(); o[64] = zero4(); if (lane == 0) ss0[row] = 0.f; }
    }
}

template <int nrows> DI void lru_local_unit(const Params& p, const Frame& F, int l, int r0, int hrow, int aggidx) {
    const bf16_t* Z = (const bf16_t*)(p.ws + WS_Z);
    bf16_t* LA = (bf16_t*)(p.ws + WS_LRU + LRU_LA); bf16_t* LB = (bf16_t*)(p.ws + WS_LRU + LRU_BC);
    float* AGGA = (float*)(p.ws + WS_LRU + LRU_AGGA); float* AGGB = (float*)(p.ws + WS_LRU + LRU_AGGB);
    constexpr int UP = 264;
    LAS bf16_t* U = (LAS bf16_t*)F.lds;
    LAS bf16_t* TLA = (LAS bf16_t*)(F.lds + 64 * UP * 2);
    LAS bf16_t* TLB = (LAS bf16_t*)(F.lds + 64 * UP * 2 + 64 * 256 * 2);
    TID_VARS; const int w = wave;
    { const int c = tid & 255, half = tid >> 8; constexpr int nh = nrows >> 1; const int t0 = half * nh;
      const float cw0 = p.lru_conv_w[(l * 4 + 0) * 256 + c], cw1 = p.lru_conv_w[(l * 4 + 1) * 256 + c], cw2 = p.lru_conv_w[(l * 4 + 2) * 256 + c], cw3 = p.lru_conv_w[(l * 4 + 3) * 256 + c], cb = p.lru_conv_b[l * 256 + c];
      bf16_t xr[nh + 3];
#pragma unroll
      for (int i = 0; i < 3; ++i) xr[i] = Z[(size_t)((t0 == 0 ? hrow : r0 + t0 - 3) + i) * ZC + ZC_XA + c];
#pragma unroll
      for (int t = 0; t < nh; ++t) xr[3 + t] = Z[(size_t)(r0 + t0 + t) * ZC + ZC_XA + c];
#pragma unroll
      for (int t = 0; t < nh; ++t) { const float u = cb + cw0 * bf2f(xr[t]) + cw1 * bf2f(xr[t + 1]) + cw2 * bf2f(xr[t + 2]) + cw3 * bf2f(xr[t + 3]); U[(t0 + t) * UP + c] = f2bf(u); } }
    __syncthreads();
    { const int blk = w >> 1, fr = lane & 15, fq = lane >> 4;
      const bf16_t* LW = (const bf16_t*)(p.ws + WS_WSM + SM_LRUW) + (size_t)l * 2 * 4 * 4096;
      bf16x8 baA[2][2], bxA[2][2]; f32x4 bavA[2], bxvA[2], lamA[2];
#pragma unroll
      for (int cbk = 0; cbk < 2; ++cbk) { const int dbase = 16 * (2 * (w & 1) + cbk), ch4 = blk * 64 + dbase + 4 * fq;
#pragma unroll
          for (int ks = 0; ks < 2; ++ks) { baA[cbk][ks] = *(const bf16x8*)(LW + ((size_t)(0 * 4 + blk) * 64 + dbase + fr) * 64 + 32 * ks + 8 * fq); bxA[cbk][ks] = *(const bf16x8*)(LW + ((size_t)(1 * 4 + blk) * 64 + dbase + fr) * 64 + 32 * ks + 8 * fq); }
          bavA[cbk] = *(const f32x4*)(p.lru_ba + l * 256 + ch4); bxvA[cbk] = *(const f32x4*)(p.lru_bx + l * 256 + ch4); lamA[cbk] = *(const f32x4*)(p.lru_lambda + l * 256 + ch4); }
#pragma unroll
      for (int cbk = 0; cbk < 2; ++cbk) { const int dbase = 16 * (2 * (w & 1) + cbk), ch4 = blk * 64 + dbase + 4 * fq;
          const bf16x8 ba[2] = {baA[cbk][0], baA[cbk][1]}, bx[2] = {bxA[cbk][0], bxA[cbk][1]};
          const f32x4 bav = bavA[cbk], bxv = bxvA[cbk], lam = lamA[cbk];
          float sp[4];
#pragma unroll
          for (int j = 0; j < 4; ++j) sp[j] = log1pf(__expf(-lam[j]));
          for (int rb = 0; rb < (nrows >> 4); ++rb) {
              f32x4 ar = {0.f, 0.f, 0.f, 0.f}, ai = {0.f, 0.f, 0.f, 0.f};
#pragma unroll
              for (int ks = 0; ks < 2; ++ks) { const bf16x8 a = *(const LAS bf16x8*)(U + (16 * rb + fr) * UP + blk * 64 + 32 * ks + 8 * fq);
                  ar = __builtin_amdgcn_mfma_f32_16x16x32_bf16(ba[ks], a, ar, 0, 0, 0); ai = __builtin_amdgcn_mfma_f32_16x16x32_bf16(bx[ks], a, ai, 0, 0, 0); }
              const int t = 16 * rb + fr;
              const u32x2 uw = *(const LAS u32x2*)(U + t * UP + ch4); const float uv[4] = {bflo(uw.x), bfhi(uw.x), bflo(uw.y), bfhi(uw.y)};
              float la[4], bc[4];
#pragma unroll
              for (int j = 0; j < 4; ++j) { const float r = sigmoidf_(ar[j] + bav[j]), ig = sigmoidf_(ai[j] + bxv[j]);
                  la[j] = -8.f * r * sp[j]; const float x2 = 2.f * la[j];
                  const float om = (x2 > -0.1f) ? -x2 * (1.f + x2 * (0.5f + x2 * (1.f / 6.f + x2 * (1.f / 24.f + x2 * (1.f / 120.f))))) : 1.f - __expf(x2);
                  bc[j] = __builtin_amdgcn_sqrtf(om) * ig * uv[j]; }
              u32x2 wa, wb; wa.x = cvtpk(la[0], la[1]); wa.y = cvtpk(la[2], la[3]); wb.x = cvtpk(bc[0], bc[1]); wb.y = cvtpk(bc[2], bc[3]);
              *(LAS u32x2*)(TLA + t * 256 + ch4) = wa; *(LAS u32x2*)(TLB + t * 256 + ch4) = wb;
              *(u32x2*)(LA + (size_t)(r0 + t) * 256 + ch4) = wa; *(u32x2*)(LB + (size_t)(r0 + t) * 256 + ch4) = wb; } } }
    __syncthreads();
    { const int c = tid & 255, qd = tid >> 8; constexpr int RH = nrows >> 1; float h = 0.f, sl = 0.f;
#pragma unroll
      for (int t = 0; t < RH; ++t) { const float la = bf2f(TLA[(qd * RH + t) * 256 + c]), bc = bf2f(TLB[(qd * RH + t) * 256 + c]); h = __expf(la) * h + bc; sl += la; }
      LAS float* XA = (LAS float*)U;
      __syncthreads();
      XA[(qd * 256 + c) * 2] = sl; XA[(qd * 256 + c) * 2 + 1] = h;
      __syncthreads();
      if (tid < 256) { const float s0 = XA[c * 2], h0 = XA[c * 2 + 1], s1 = XA[(256 + c) * 2], h1 = XA[(256 + c) * 2 + 1];
          AGGA[(size_t)aggidx * 256 + c] = s0 + s1; AGGB[(size_t)aggidx * 256 + c] = __expf(s1) * h0 + h1; } }
    __syncthreads();
}
DI void lru_carry(const Params& p, int b, int c) {
    const float* AGGA = (const float*)(p.ws + WS_LRU + LRU_AGGA); const float* AGGB = (const float*)(p.ws + WS_LRU + LRU_AGGB); float* HIN = (float*)(p.ws + WS_LRU + LRU_HIN);
    float h = AGGB[(size_t)(NB * NSEG) * 256 + c];
    for (int hf = 0; hf < 4; ++hf) {
        float a[32], bb[32];
#pragma unroll
        for (int s = 0; s < 32; ++s) { const size_t i = (size_t)(b * NSEG + hf * 32 + s) * 256 + c; a[s] = AGGA[i]; bb[s] = AGGB[i]; }
#pragma unroll
        for (int s = 0; s < 32; ++s) { const float hin = h; h = __expf(a[s]) * h + bb[s]; a[s] = hin; }
#pragma unroll
        for (int s = 0; s < 32; ++s) { const size_t i = (size_t)(b * NSEG + hf * 32 + s) * 256 + c; HIN[i] = a[s]; }
    }
}
template <int nrows> DI void lru_fix_unit(const Params& p, const Frame& F, int l, int r0, int aggidx, bool meta, float* gss) {
    const bf16_t* Z = (const bf16_t*)(p.ws + WS_Z); const bf16_t* LA = (const bf16_t*)(p.ws + WS_LRU + LRU_LA); const bf16_t* LB = (const bf16_t*)(p.ws + WS_LRU + LRU_BC);
    const float* HIN = (const float*)(p.ws + WS_LRU + LRU_HIN); bf16_t* Y = (bf16_t*)(p.ws + WS_BUFB);
    LAS float* AG = (LAS float*)F.lds;
    LAS float* red = (LAS float*)(F.lds + 8192);
    TID_VARS; constexpr int RQ = nrows >> 2; const int c2 = tid & 127, rq = tid >> 7;
    unsigned la2[RQ], bc2[RQ], ga2[RQ];
#pragma unroll
    for (int t = 0; t < RQ; ++t) { const size_t row = (size_t)(r0 + rq * RQ + t); la2[t] = *(const unsigned*)(LA + row * 256 + 2 * c2); bc2[t] = *(const unsigned*)(LB + row * 256 + 2 * c2); ga2[t] = *(const unsigned*)(Z + row * ZC + ZC_GA + 2 * c2); }
    float hin0 = 0.f, hin1 = 0.f; if (!meta) { const f32x2 hv = *(const f32x2*)(HIN + (size_t)aggidx * 256 + 2 * c2); hin0 = hv.x; hin1 = hv.y; }
    float hl0[RQ], hl1[RQ], ac0[RQ], ac1[RQ]; float h0 = 0.f, h1 = 0.f, A0 = 1.f, A1 = 1.f;
#pragma unroll
    for (int t = 0; t < RQ; ++t) { const float a0 = __expf(bflo(la2[t])), a1 = __expf(bfhi(la2[t])); h0 = a0 * h0 + bflo(bc2[t]); h1 = a1 * h1 + bfhi(bc2[t]); A0 *= a0; A1 *= a1; hl0[t] = h0; hl1[t] = h1; ac0[t] = A0; ac1[t] = A1; }
    *(LAS f32x4*)(AG + (rq * 128 + c2) * 4) = (f32x4){A0, h0, A1, h1};
    __syncthreads();
    for (int q = 0; q < rq; ++q) { const f32x4 v = *(const LAS f32x4*)(AG + (q * 128 + c2) * 4); hin0 = v[0] * hin0 + v[1]; hin1 = v[2] * hin1 + v[3]; }
#pragma unroll
    for (int t = 0; t < RQ; ++t) { const size_t row = (size_t)(r0 + rq * RQ + t);
        const float y0 = (hl0[t] + ac0[t] * hin0) * gelu_tanh(bflo(ga2[t])), y1 = (hl1[t] + ac1[t] * hin1) * gelu_tanh(bfhi(ga2[t]));
        const unsigned w = cvtpk(y0, y1); *(unsigned*)(Y + row * D + Y_LRU + 2 * c2) = w;
        const float z0 = bflo(w), z1 = bfhi(w); const float sv = wave_sum(z0 * z0 + z1 * z1); if (lane == 0) red[(rq * RQ + t) * 2 + (wave & 1)] = sv; }
    __syncthreads();
    if (tid < nrows) *(f32x4*)(gss + (size_t)(r0 + tid) * 16) = (f32x4){red[tid * 2] + red[tid * 2 + 1], 0.f, 0.f, 0.f};
    __syncthreads();
}


constexpr int HG_WL = 11776;
DI void hg_local_wave(const Params& p, LAS unsigned char* wl, int l, int r0, int nrows, int h, int slot, int lane) {
    bf16_t* Z = (bf16_t*)(p.ws + WS_Z);
    float* UT = (float*)(p.ws + WS_HG + HG_UT) + (size_t)slot * 4096; float* DL = (float*)(p.ws + WS_HG + HG_DL) + (size_t)slot * 64;
    LAS bf16_t* QD = (LAS bf16_t*)wl; LAS bf16_t* KD = QD + 16 * 72; LAS bf16_t* KET = KD + 16 * 72; LAS bf16_t* VT = KET + 64 * 24; LAS bf16_t* ATT = VT + 64 * 24; LAS float* DEC = (LAS float*)(ATT + 16 * 24);
    const int fr = lane & 15, g = lane >> 4;
    float lbv = 0.f;
    if (l == 1) { const float l0 = p.hg_lb_logits[h * 64 + lane], l1 = p.hg_lb_logits[256 + h * 64 + lane]; lbv = sigmoidf_(l1 - l0); }
    f32x4 S[4][4];
#pragma unroll
    for (int a = 0; a < 4; ++a)
#pragma unroll
        for (int b = 0; b < 4; ++b) S[a][b] = (f32x4){0.f, 0.f, 0.f, 0.f};
    float Bseg = 0.f;
    const bf16x8 zero8 = {0, 0, 0, 0, 0, 0, 0, 0};
    for (int c = 0; c < (nrows >> 4); ++c) {
        const int rc = r0 + 16 * c;
        float bsum = 0.f; float kdv[16];
        bf16_t zf_[16], zq_[16], zv_[16];
#pragma unroll
        for (int t = 0; t < 16; ++t) { const size_t zo = (size_t)(rc + t) * ZC + 64 * h + lane; zf_[t] = Z[zo + ZC_HF]; zq_[t] = Z[zo + ZC_HQ]; zv_[t] = Z[zo + ZC_HV]; }
        asm volatile("" ::: "memory");
#pragma unroll
        for (int t = 0; t < 16; ++t) {
            const size_t zo = (size_t)(rc + t) * ZC + 64 * h + lane;
            const float fz = bf2f(zf_[t]), q = bf2f(zq_[t]); const bf16_t vraw = zv_[t];
            const float sg = sigmoidf_(fz); const float f = lbv + (1.f - lbv) * sg; const float k = (1.f - lbv) * (1.f - sg);
            bsum += __logf(f);
            const float eb = __expf(bsum), enb = __expf(-bsum);
            QD[t * 72 + lane] = f2bf(q * eb); kdv[t] = k * enb; KD[t * 72 + lane] = f2bf(kdv[t]); (void)vraw;
            Z[zo + ZC_HQ] = f2bf(q * __expf(Bseg + bsum));
        }
        const float eend = __expf(bsum);
        { u32x4 ka, kb, va, vb;
          ka.x = cvtpk(kdv[0] * eend, kdv[1] * eend); ka.y = cvtpk(kdv[2] * eend, kdv[3] * eend); ka.z = cvtpk(kdv[4] * eend, kdv[5] * eend); ka.w = cvtpk(kdv[6] * eend, kdv[7] * eend);
          kb.x = cvtpk(kdv[8] * eend, kdv[9] * eend); kb.y = cvtpk(kdv[10] * eend, kdv[11] * eend); kb.z = cvtpk(kdv[12] * eend, kdv[13] * eend); kb.w = cvtpk(kdv[14] * eend, kdv[15] * eend);
          va.x = zv_[0] | ((unsigned)zv_[1] << 16); va.y = zv_[2] | ((unsigned)zv_[3] << 16); va.z = zv_[4] | ((unsigned)zv_[5] << 16); va.w = zv_[6] | ((unsigned)zv_[7] << 16);
          vb.x = zv_[8] | ((unsigned)zv_[9] << 16); vb.y = zv_[10] | ((unsigned)zv_[11] << 16); vb.z = zv_[12] | ((unsigned)zv_[13] << 16); vb.w = zv_[14] | ((unsigned)zv_[15] << 16);
          *(LAS u32x4*)(KET + lane * 24) = ka; *(LAS u32x4*)(KET + lane * 24 + 8) = kb; *(LAS u32x4*)(VT + lane * 24) = va; *(LAS u32x4*)(VT + lane * 24 + 8) = vb; }
        DEC[lane] = eend; Bseg += bsum;
        LDS_WAIT();
        f32x4 at = {0.f, 0.f, 0.f, 0.f};
#pragma unroll
        for (int ks = 0; ks < 2; ++ks) { const bf16x8 a = *(const LAS bf16x8*)(KD + fr * 72 + 32 * ks + 8 * g), b = *(const LAS bf16x8*)(QD + fr * 72 + 32 * ks + 8 * g);
            at = __builtin_amdgcn_mfma_f32_16x16x32_bf16(a, b, at, 0, 0, 0); }
#pragma unroll
        for (int j = 0; j < 4; ++j) if (4 * g + j > fr) at[j] = 0.f;
        { u32x2 w; w.x = cvtpk(at[0], at[1]); w.y = cvtpk(at[2], at[3]); *(LAS u32x2*)(ATT + fr * 24 + 4 * g) = w; }
        LDS_WAIT();
        const bf16x8 aatt = (g < 2) ? *(const LAS bf16x8*)(ATT + fr * 24 + 8 * g) : zero8;
        bf16x8 bv[4], aket[4];
#pragma unroll
        for (int i = 0; i < 4; ++i) { bv[i] = (g < 2) ? *(const LAS bf16x8*)(VT + (fr + 16 * i) * 24 + 8 * g) : zero8; aket[i] = (g < 2) ? *(const LAS bf16x8*)(KET + (fr + 16 * i) * 24 + 8 * g) : zero8; }
        f32x4 o[4];
#pragma unroll
        for (int cb = 0; cb < 4; ++cb) o[cb] = __builtin_amdgcn_mfma_f32_16x16x32_bf16(bv[cb], aatt, (f32x4){0.f, 0.f, 0.f, 0.f}, 0, 0, 0);
#pragma unroll
        for (int ks = 0; ks < 2; ++ks) {
            const u32x2 q0 = *(const LAS u32x2*)(QD + fr * 72 + 32 * ks + 4 * g), q1 = *(const LAS u32x2*)(QD + fr * 72 + 32 * ks + 16 + 4 * g);
            const bf16x8 aq = __builtin_bit_cast(bf16x8, (u32x4){q0.x, q0.y, q1.x, q1.y});
#pragma unroll
            for (int cb = 0; cb < 4; ++cb) { const f32x4 s0 = S[2 * ks][cb], s1 = S[2 * ks + 1][cb];
                const bf16x8 bs = __builtin_bit_cast(bf16x8, (u32x4){cvtpk(s0[0], s0[1]), cvtpk(s0[2], s0[3]), cvtpk(s1[0], s1[1]), cvtpk(s1[2], s1[3])});
                o[cb] = __builtin_amdgcn_mfma_f32_16x16x32_bf16(bs, aq, o[cb], 0, 0, 0); }
        }
#pragma unroll
        for (int cb = 0; cb < 4; ++cb) { u32x2 w; w.x = cvtpk(o[cb][0], o[cb][1]); w.y = cvtpk(o[cb][2], o[cb][3]); *(u32x2*)(Z + (size_t)(rc + fr) * ZC + ZC_HF + 64 * h + 16 * cb + 4 * g) = w; }
#pragma unroll
        for (int rb = 0; rb < 4; ++rb) { const f32x4 d4 = *(const LAS f32x4*)(DEC + 16 * rb + 4 * g);
#pragma unroll
            for (int cb = 0; cb < 4; ++cb) { const f32x4 u = __builtin_amdgcn_mfma_f32_16x16x32_bf16(aket[rb], bv[cb], (f32x4){0.f, 0.f, 0.f, 0.f}, 0, 0, 0); S[rb][cb] = S[rb][cb] * d4 + u; } }
        LDS_WAIT();
    }
#pragma unroll
    for (int rb = 0; rb < 4; ++rb)
#pragma unroll
        for (int cb = 0; cb < 4; ++cb) *(f32x4*)(UT + (fr + 16 * cb) * 64 + 16 * rb + 4 * g) = S[rb][cb];
    DL[lane] = Bseg;
}
DI void hg_carry_block(const Params& p, LAS unsigned char* lds, int bh, int part, int tid) {
    float* UT = (float*)(p.ws + WS_HG + HG_UT); const float* DL = (const float*)(p.ws + WS_HG + HG_DL);
    LAS float* DEC = (LAS float*)lds;
    for (int i = tid; i < 128 * 64; i += 512) DEC[i] = __expf(DL[(size_t)bh * 128 * 64 + i]);
    const int e = part * 512 + tid, dk = e & 63;
    float s = UT[(size_t)(2048 + (bh & 3)) * 4096 + e];
    __syncthreads();
    for (int hf = 0; hf < 2; ++hf) {
        float u[64];
#pragma unroll
        for (int i = 0; i < 64; ++i) u[i] = UT[(size_t)(bh * 128 + hf * 64 + i) * 4096 + e];
#pragma unroll
        for (int i = 0; i < 64; ++i) { const float sin_ = s; s = DEC[(hf * 64 + i) * 64 + dk] * s + u[i]; u[i] = sin_; }
#pragma unroll
        for (int i = 0; i < 64; ++i) UT[(size_t)(bh * 128 + hf * 64 + i) * 4096 + e] = u[i];
    }
    __syncthreads();
}
DI void hg_fix_wave(const Params& p, int r0, int nrows, int h, int slot, bool meta, float* gss, int lane) {
    const bf16_t* Z = (const bf16_t*)(p.ws + WS_Z); bf16_t* Y = (bf16_t*)(p.ws + WS_BUFB);
    const float* SI = (const float*)(p.ws + WS_HG + HG_UT) + (size_t)slot * 4096;
    const int fr = lane & 15, g = lane >> 4;
    bf16x8 bS[2][4];
    if (!meta) {
#pragma unroll
        for (int ks = 0; ks < 2; ++ks)
#pragma unroll
            for (int cb = 0; cb < 4; ++cb) { const f32x4 s0 = *(const f32x4*)(SI + (fr + 16 * cb) * 64 + 32 * ks + 8 * g), s1 = *(const f32x4*)(SI + (fr + 16 * cb) * 64 + 32 * ks + 8 * g + 4);
                bS[ks][cb] = __builtin_bit_cast(bf16x8, (u32x4){cvtpk(s0[0], s0[1]), cvtpk(s0[2], s0[3]), cvtpk(s1[0], s1[1]), cvtpk(s1[2], s1[3])}); }
    }
    for (int rbk = 0; rbk < (nrows >> 4); ++rbk) {
        f32x4 o[4];
#pragma unroll
        for (int cb = 0; cb < 4; ++cb) o[cb] = (f32x4){0.f, 0.f, 0.f, 0.f};
        if (!meta) {
#pragma unroll
            for (int ks = 0; ks < 2; ++ks) { const bf16x8 a = *(const bf16x8*)(Z + (size_t)(r0 + 16 * rbk + fr) * ZC + ZC_HQ + 64 * h + 32 * ks + 8 * g);
#pragma unroll
                for (int cb = 0; cb < 4; ++cb) o[cb] = __builtin_amdgcn_mfma_f32_16x16x32_bf16(bS[ks][cb], a, o[cb], 0, 0, 0); }
        }
        const size_t row = (size_t)(r0 + 16 * rbk + fr); float sq = 0.f;
#pragma unroll
        for (int cb = 0; cb < 4; ++cb) { const int col4 = 64 * h + 16 * cb + 4 * g;
            const u32x2 ow = *(const u32x2*)(Z + row * ZC + ZC_HF + col4), gw = *(const u32x2*)(Z + row * ZC + ZC_HG + col4);
            const float ol[4] = {bflo(ow.x), bfhi(ow.x), bflo(ow.y), bfhi(ow.y)}, gg[4] = {bflo(gw.x), bfhi(gw.x), bflo(gw.y), bfhi(gw.y)}; float val[4];
#pragma unroll
            for (int j = 0; j < 4; ++j) val[j] = (o[cb][j] + ol[j]) * (gg[j] * sigmoidf_(gg[j]));
            u32x2 w; w.x = cvtpk(val[0], val[1]); w.y = cvtpk(val[2], val[3]); *(u32x2*)(Y + row * D + Y_HG + col4) = w;
            const float z0 = bflo(w.x), z1 = bfhi(w.x), z2 = bflo(w.y), z3 = bfhi(w.y); sq += (z0 * z0 + z1 * z1) + (z2 * z2 + z3 * z3); }
        sq += __shfl_xor(sq, 16); sq += __shfl_xor(sq, 32);
        if (g == 0) gss[row * 16 + 4 + h] = sq;
    }
}

constexpr float LOG2E = 1.4426950408889634f;
constexpr float QS_FOX = 0.125f * LOG2E, QS_MLA = 0.10206207261596575f * LOG2E;
DI int row_pos(int row) { return row < NR ? 16 + (row & (SEQ - 1)) : row - MROW0; }
DI float swap_other(float x, bool domax) { auto rr = __builtin_amdgcn_permlane32_swap(__float_as_uint(x), __float_as_uint(x), false, false); const float a = __uint_as_float(rr[0]), b = __uint_as_float(rr[1]); return domax ? fmaxf(a, b) : a + b; }

template <int nrows> DI void fox_prep_unit(const Params& p, const Frame& F, int l, int r0) {
    TID_VARS; bf16_t* Z = (bf16_t*)(p.ws + WS_Z); bf16_t* FVT = (bf16_t*)(p.ws + WS_ATT + AT_FVT); float* FLF = (float*)(p.ws + WS_LRU + LRU_FLF);
    LAS bf16_t* VTILE = (LAS bf16_t*)F.lds;
    const int d0 = (4 * lane) & 63;
    const f32x4 gq = *(const f32x4*)(p.fox_gqn + l * 64 + d0), gk = *(const f32x4*)(p.fox_gkn + l * 64 + d0);
    const float bfv = p.fox_bf[l * 4 + (lane & 3)];
    { constexpr int NT = nrows / 8; u32x2 qw[NT], kw[NT], vw[NT]; float fx[NT];
#pragma unroll
      for (int i = 0; i < NT; ++i) { const size_t row = (size_t)(r0 + wave + 8 * i); qw[i] = *(const u32x2*)(Z + row * ZC + ZC_FQ + 4 * lane); kw[i] = *(const u32x2*)(Z + row * ZC + ZC_FK + 4 * lane); vw[i] = *(const u32x2*)(Z + row * ZC + ZC_FV + 4 * lane);
          fx[i] = bf2f(Z[row * ZC + ZC_FF + (lane & 3)]); }
#pragma unroll
      for (int i = 0; i < NT; ++i) { const int t = wave + 8 * i; const size_t row = (size_t)(r0 + t);
        { const u32x2 w = qw[i]; const float a0 = bflo(w.x), a1 = bfhi(w.x), a2 = bflo(w.y), a3 = bfhi(w.y);
          float ss = (a0 * a0 + a1 * a1) + (a2 * a2 + a3 * a3); ss += __shfl_xor(ss, 1); ss += __shfl_xor(ss, 2); ss += __shfl_xor(ss, 4); ss += __shfl_xor(ss, 8);
          const float rs = rsqrtf(ss * (1.f / 64.f) + EPS) * QS_FOX; u32x2 o; o.x = cvtpk(a0 * rs * gq[0], a1 * rs * gq[1]); o.y = cvtpk(a2 * rs * gq[2], a3 * rs * gq[3]); *(u32x2*)(Z + row * ZC + ZC_FQ + 4 * lane) = o; }
        { const u32x2 w = kw[i]; const float a0 = bflo(w.x), a1 = bfhi(w.x), a2 = bflo(w.y), a3 = bfhi(w.y);
          float ss = (a0 * a0 + a1 * a1) + (a2 * a2 + a3 * a3); ss += __shfl_xor(ss, 1); ss += __shfl_xor(ss, 2); ss += __shfl_xor(ss, 4); ss += __shfl_xor(ss, 8);
          const float rs = rsqrtf(ss * (1.f / 64.f) + EPS); u32x2 o; o.x = cvtpk(a0 * rs * gk[0], a1 * rs * gk[1]); o.y = cvtpk(a2 * rs * gk[2], a3 * rs * gk[3]); *(u32x2*)(Z + row * ZC + ZC_FK + 4 * lane) = o; }
        *(LAS u32x2*)(VTILE + t * 264 + 4 * lane) = vw[i];
        if (lane < 4) { const float x = fx[i] + bfv; const float ls = fminf(x, 0.f) - log1pf(__expf(-fabsf(x))); FLF[(size_t)lane * TM + row] = ls * LOG2E; } } }
    __syncthreads();
    { const int hd = tid & 255, half = tid >> 8, ng = nrows >> 4;
      for (int gi = half; gi < ng; gi += 2) { unsigned short v[16];
#pragma unroll
          for (int ko = 0; ko < 16; ++ko) v[8 * ((ko >> 2) & 1) + (ko & 3) + 4 * (ko >> 3)] = VTILE[(16 * gi + ko) * 264 + hd];
          u32x4 w0, w1; w0.x = v[0] | ((unsigned)v[1] << 16); w0.y = v[2] | ((unsigned)v[3] << 16); w0.z = v[4] | ((unsigned)v[5] << 16); w0.w = v[6] | ((unsigned)v[7] << 16);
          w1.x = v[8] | ((unsigned)v[9] << 16); w1.y = v[10] | ((unsigned)v[11] << 16); w1.z = v[12] | ((unsigned)v[13] << 16); w1.w = v[14] | ((unsigned)v[15] << 16);
          u32x4* dst = (u32x4*)(FVT + (size_t)hd * TM + r0 + 16 * gi); dst[0] = w0; dst[1] = w1; } }
    __syncthreads();
}
DI void fox_cscan_block(const Params& p, LAS unsigned char* lds, int l, int b, int h, int tid) {
    const float* FLF = (const float*)(p.ws + WS_LRU + LRU_FLF) + (size_t)h * TM; float* FC = (float*)(p.ws + WS_LRU + LRU_FC) + (size_t)h * TM;
    LAS float* wt = (LAS float*)lds;
    const int lane = tid & 63, wave = tid >> 6;
    float cm = 0.f;
    { float mv[16];
#pragma unroll
      for (int i = 0; i < 16; ++i) mv[i] = FLF[MROW0 + i];
#pragma unroll
      for (int i = 0; i < 16; ++i) { cm += mv[i]; if (b == 0 && tid == 0) FC[MROW0 + i] = cm; } }
    const f32x4* src = (const f32x4*)(FLF + (size_t)b * SEQ + 16 * tid); f32x4 v[4];
#pragma unroll
    for (int j = 0; j < 4; ++j) v[j] = src[j];
    float run = 0.f;
#pragma unroll
    for (int j = 0; j < 4; ++j) { run += v[j].x; v[j].x = run; run += v[j].y; v[j].y = run; run += v[j].z; v[j].z = run; run += v[j].w; v[j].w = run; }
    float inc = run;
#pragma unroll
    for (int o = 1; o < 64; o <<= 1) { const float t = __shfl_up(inc, o); if (lane >= o) inc += t; }
    if (lane == 63) wt[wave] = inc;
    __syncthreads();
    float base = cm + (inc - run);
    for (int w = 0; w < wave; ++w) base += wt[w];
    f32x4* dst = (f32x4*)(FC + (size_t)b * SEQ + 16 * tid);
    LAS f32x4* cl = (LAS f32x4*)(lds + 256);
#pragma unroll
    for (int j = 0; j < 4; ++j) { const f32x4 cvv = v[j] + base; dst[j] = cvv; cl[4 * tid + j] = cvv; }
    __syncthreads();
    if (tid < 32) { const LAS float* c1 = (const LAS float*)cl; const int qb = tid; float gq = 0.f, gk = 0.f;
        for (int i = 0; i < 64; ++i) { gq = fmaxf(gq, fabsf(p.fox_gqn[l * 64 + i])); gk = fmaxf(gk, fabsf(p.fox_gkn[l * 64 + i])); }
        const float T = 150.f + 12.f * gq * gk;
        const float cq0 = c1[256 * qb];
        int lo = 0, hi = 4 * qb;
        while (lo < hi) { const int mid = (lo + hi) >> 1; if (cq0 - c1[64 * mid + 63] >= -T) hi = mid; else lo = mid + 1; }
        const bool meta_on = (cq0 - cm) >= -T;
        ((int*)(p.ws + WS_LRU + LRU_FJ0))[(h * NB + b) * 32 + qb] = meta_on ? 0 : ((1 + lo) & ~1); }
    __syncthreads();
}
template <int part, int nrows> DI void mla_prep_unit(const Params& p, const Frame& F, int l, int r0) {
    TID_VARS; const bf16_t* Z = (const bf16_t*)(p.ws + WS_Z);
    bf16_t* MQ = (bf16_t*)(p.ws + WS_ATT + AT_MQ); bf16_t* MK = (bf16_t*)(p.ws + WS_ATT + AT_MK); bf16_t* MVT = (bf16_t*)(p.ws + WS_ATT + AT_MVT);
    const float* ROPE = (const float*)(p.ws + WS_HG + HG_ROPE);
    constexpr int KW = part ? 128 : 192, WP = KW + 8, NWR = part ? 256 : 192, CH = KW / 8;
    const bf16_t* Wg = part ? (const bf16_t*)(p.ws + WS_WSM + SM_WUKV) + (size_t)l * 512 * 128 : (const bf16_t*)(p.ws + WS_WSM + SM_WUQ) + (size_t)l * 384 * 192;
    LAS bf16_t* WL = (LAS bf16_t*)F.lds;
    LAS bf16_t* AT = WL + 192 * 200;
    LAS bf16_t* KR = AT + 128 * 200;
    LAS float* RS = (LAS float*)(KR + 128 * 40);
    const int zc0 = part ? ZC_CKV : ZC_CQ;
    { u32x4 wv[10], av[7];
#pragma unroll
      for (int i = 0; i < 10; ++i) { const int c = tid + 512 * i; wv[i] = (u32x4){0u, 0u, 0u, 0u}; if (c < NWR * CH) wv[i] = *(const u32x4*)(Wg + (size_t)(c / CH) * KW + 8 * (c % CH)); }
#pragma unroll
      for (int i = 0; i < 7; ++i) { const int c = tid + 512 * i; av[i] = (u32x4){0u, 0u, 0u, 0u}; if (c < nrows * CH) av[i] = *(const u32x4*)(Z + (size_t)(r0 + c / CH) * ZC + zc0 + 8 * (c % CH)); }
      u32x4 kv = {0u, 0u, 0u, 0u}; if (part && tid < nrows * 4) kv = *(const u32x4*)(Z + (size_t)(r0 + (tid >> 2)) * ZC + ZC_KR + 8 * (tid & 3));
#pragma unroll
      for (int i = 0; i < 10; ++i) { const int c = tid + 512 * i; if (c < NWR * CH) *(LAS u32x4*)(WL + (c / CH) * WP + 8 * (c % CH)) = wv[i]; }
#pragma unroll
      for (int i = 0; i < 7; ++i) { const int c = tid + 512 * i; if (c < nrows * CH) *(LAS u32x4*)(AT + (c / CH) * WP + 8 * (c % CH)) = av[i]; }
      if (part && tid < nrows * 4) *(LAS u32x4*)(KR + (tid >> 2) * 40 + 8 * (tid & 3)) = kv; }
    __syncthreads();
    { const int row = tid >> 2, qd = tid & 3, nq = KW / 4; float ss = 0.f;
      if (row < nrows) { for (int c = 0; c < nq; c += 8) { const u32x4 w = *(const LAS u32x4*)(AT + row * WP + qd * nq + c);
            ss += (bflo(w.x) * bflo(w.x) + bfhi(w.x) * bfhi(w.x)) + (bflo(w.y) * bflo(w.y) + bfhi(w.y) * bfhi(w.y)) + (bflo(w.z) * bflo(w.z) + bfhi(w.z) * bfhi(w.z)) + (bflo(w.w) * bflo(w.w) + bfhi(w.w) * bfhi(w.w)); } }
      ss += __shfl_xor(ss, 1); ss += __shfl_xor(ss, 2);
      if (qd == 0 && row < nrows) RS[row] = rsqrtf(ss / (float)KW + EPS); }
    __syncthreads();
    u32x4 wv2[10];
#pragma unroll
    for (int i = 0; i < 10; ++i) { const int c = tid + 512 * i; wv2[i] = (u32x4){0u, 0u, 0u, 0u}; if (c < NWR * CH) wv2[i] = *(const u32x4*)(Wg + (size_t)NWR * KW + (size_t)(c / CH) * KW + 8 * (c % CH)); }
    const int hh = wave & 1, rbp = wave >> 1, fr = lane & 15, g = lane >> 4; constexpr int nrb = nrows >> 4;
    const int rb0 = 2 * rbp; const bool two = rb0 + 1 < nrb;
#pragma unroll 1
    for (int hp = 0; hp < 2; ++hp) { const int h = 2 * hp + hh;
    if (rb0 < nrb) {
      if (part == 0) {
        f32x4 acc[2][6];
#pragma unroll
        for (int r = 0; r < 2; ++r)
#pragma unroll
            for (int i = 0; i < 6; ++i) acc[r][i] = (f32x4){0.f, 0.f, 0.f, 0.f};
#pragma unroll
        for (int ks = 0; ks < 6; ++ks) { const bf16x8 a0 = *(const LAS bf16x8*)(AT + (16 * rb0 + fr) * 200 + 32 * ks + 8 * g), a1 = *(const LAS bf16x8*)(AT + (16 * (two ? rb0 + 1 : rb0) + fr) * 200 + 32 * ks + 8 * g);
#pragma unroll
            for (int i = 0; i < 6; ++i) { const bf16x8 bw = *(const LAS bf16x8*)(WL + (96 * hh + 16 * i + fr) * 200 + 32 * ks + 8 * g);
                acc[0][i] = __builtin_amdgcn_mfma_f32_16x16x32_bf16(bw, a0, acc[0][i], 0, 0, 0); acc[1][i] = __builtin_amdgcn_mfma_f32_16x16x32_bf16(bw, a1, acc[1][i], 0, 0, 0); } }
        f32x4 gq[6];
#pragma unroll
        for (int i = 0; i < 6; ++i) gq[i] = *(const f32x4*)(p.mla_gqn + l * 96 + 16 * i + 4 * g);
        f32x4 rcA[2][2];
#pragma unroll
        for (int r = 0; r < 2; ++r) { const int pos = row_pos(r0 + 16 * ((r == 1 && !two) ? rb0 : rb0 + r) + fr); rcA[r][0] = *(const f32x4*)(ROPE + ((size_t)pos * 16 + 4 * g) * 2); rcA[r][1] = *(const f32x4*)(ROPE + ((size_t)pos * 16 + 4 * g) * 2 + 4); }
#pragma unroll
        for (int r = 0; r < 2; ++r) { if (r == 1 && !two) break;
            const int t = 16 * (rb0 + r) + fr;
            const f32x4 rc0 = rcA[r][0], rc1 = rcA[r][1];
            const float cs[4] = {rc0[0], rc0[2], rc1[0], rc1[2]}, sn[4] = {rc0[1], rc0[3], rc1[1], rc1[3]};
            const float rq = RS[t]; float ss = 0.f;
#pragma unroll
            for (int i = 0; i < 6; ++i) { acc[r][i] = acc[r][i] * rq; ss += (acc[r][i][0] * acc[r][i][0] + acc[r][i][1] * acc[r][i][1]) + (acc[r][i][2] * acc[r][i][2] + acc[r][i][3] * acc[r][i][3]); }
            ss += __shfl_xor(ss, 16); ss += __shfl_xor(ss, 32);
            const float rn = rsqrtf(ss * (1.f / 96.f) + EPS);
#pragma unroll
            for (int i = 0; i < 6; ++i) acc[r][i] = acc[r][i] * gq[i] * rn;
#pragma unroll
            for (int j = 0; j < 4; ++j) { const float t1 = acc[r][4][j], t2 = acc[r][5][j]; acc[r][4][j] = t1 * cs[j] - t2 * sn[j]; acc[r][5][j] = t1 * sn[j] + t2 * cs[j]; }
            bf16_t* dst = MQ + (size_t)(r0 + t) * 384 + 96 * h + 4 * g;
#pragma unroll
            for (int i = 0; i < 6; ++i) { u32x2 w; w.x = cvtpk(acc[r][i][0] * QS_MLA, acc[r][i][1] * QS_MLA); w.y = cvtpk(acc[r][i][2] * QS_MLA, acc[r][i][3] * QS_MLA); *(u32x2*)(dst + 16 * i) = w; } }
      } else {
        f32x4 acc[2][4], accv[2][4];
#pragma unroll
        for (int r = 0; r < 2; ++r)
#pragma unroll
            for (int i = 0; i < 4; ++i) { acc[r][i] = (f32x4){0.f, 0.f, 0.f, 0.f}; accv[r][i] = (f32x4){0.f, 0.f, 0.f, 0.f}; }
#pragma unroll
        for (int ks = 0; ks < 4; ++ks) { const bf16x8 a0 = *(const LAS bf16x8*)(AT + (16 * rb0 + fr) * 136 + 32 * ks + 8 * g), a1 = *(const LAS bf16x8*)(AT + (16 * (two ? rb0 + 1 : rb0) + fr) * 136 + 32 * ks + 8 * g);
#pragma unroll
            for (int i = 0; i < 4; ++i) { const bf16x8 bw = *(const LAS bf16x8*)(WL + (128 * hh + 16 * i + fr) * 136 + 32 * ks + 8 * g), bv2 = *(const LAS bf16x8*)(WL + (128 * hh + 64 + 16 * i + fr) * 136 + 32 * ks + 8 * g);
                acc[0][i] = __builtin_amdgcn_mfma_f32_16x16x32_bf16(bw, a0, acc[0][i], 0, 0, 0); acc[1][i] = __builtin_amdgcn_mfma_f32_16x16x32_bf16(bw, a1, acc[1][i], 0, 0, 0);
                accv[0][i] = __builtin_amdgcn_mfma_f32_16x16x32_bf16(a0, bv2, accv[0][i], 0, 0, 0); accv[1][i] = __builtin_amdgcn_mfma_f32_16x16x32_bf16(a1, bv2, accv[1][i], 0, 0, 0); } }
        f32x4 gk[6];
#pragma unroll
        for (int i = 0; i < 6; ++i) gk[i] = *(const f32x4*)(p.mla_gkn + l * 96 + 16 * i + 4 * g);
        f32x4 rcA[2][2];
#pragma unroll
        for (int r = 0; r < 2; ++r) { const int pos = row_pos(r0 + 16 * ((r == 1 && !two) ? rb0 : rb0 + r) + fr); rcA[r][0] = *(const f32x4*)(ROPE + ((size_t)pos * 16 + 4 * g) * 2); rcA[r][1] = *(const f32x4*)(ROPE + ((size_t)pos * 16 + 4 * g) * 2 + 4); }
#pragma unroll
        for (int r = 0; r < 2; ++r) { if (r == 1 && !two) break;
            const int rb = rb0 + r; const int t = 16 * rb + fr;
            const f32x4 rc0 = rcA[r][0], rc1 = rcA[r][1];
            const float cs[4] = {rc0[0], rc0[2], rc1[0], rc1[2]}, sn[4] = {rc0[1], rc0[3], rc1[1], rc1[3]};
            const float rk = RS[t]; float ss = 0.f;
#pragma unroll
            for (int i = 0; i < 4; ++i) { acc[r][i] = acc[r][i] * rk; ss += (acc[r][i][0] * acc[r][i][0] + acc[r][i][1] * acc[r][i][1]) + (acc[r][i][2] * acc[r][i][2] + acc[r][i][3] * acc[r][i][3]); }
            const u32x2 k1w = *(const LAS u32x2*)(KR + t * 40 + 4 * g), k2w = *(const LAS u32x2*)(KR + t * 40 + 16 + 4 * g);
            f32x4 k1 = {bflo(k1w.x), bfhi(k1w.x), bflo(k1w.y), bfhi(k1w.y)}, k2 = {bflo(k2w.x), bfhi(k2w.x), bflo(k2w.y), bfhi(k2w.y)};
            ss += (k1[0] * k1[0] + k1[1] * k1[1]) + (k1[2] * k1[2] + k1[3] * k1[3]) + (k2[0] * k2[0] + k2[1] * k2[1]) + (k2[2] * k2[2] + k2[3] * k2[3]);
            ss += __shfl_xor(ss, 16); ss += __shfl_xor(ss, 32);
            const float rn = rsqrtf(ss * (1.f / 96.f) + EPS);
#pragma unroll
            for (int i = 0; i < 4; ++i) acc[r][i] = acc[r][i] * gk[i] * rn;
            k1 = k1 * gk[4] * rn; k2 = k2 * gk[5] * rn;
            f32x4 o1, o2;
#pragma unroll
            for (int j = 0; j < 4; ++j) { o1[j] = k1[j] * cs[j] - k2[j] * sn[j]; o2[j] = k1[j] * sn[j] + k2[j] * cs[j]; }
            bf16_t* dst = MK + (size_t)(r0 + t) * 384 + 96 * h + 4 * g;
#pragma unroll
            for (int i = 0; i < 4; ++i) { u32x2 w; w.x = cvtpk(acc[r][i][0], acc[r][i][1]); w.y = cvtpk(acc[r][i][2], acc[r][i][3]); *(u32x2*)(dst + 16 * i) = w; }
            { u32x2 w; w.x = cvtpk(o1[0], o1[1]); w.y = cvtpk(o1[2], o1[3]); *(u32x2*)(dst + 64) = w; w.x = cvtpk(o2[0], o2[1]); w.y = cvtpk(o2[2], o2[3]); *(u32x2*)(dst + 80) = w; }
            const float r0k = RS[16 * rb + 4 * g], r1k = RS[16 * rb + 4 * g + 1], r2k = RS[16 * rb + 4 * g + 2], r3k = RS[16 * rb + 4 * g + 3];
#pragma unroll
            for (int i = 0; i < 4; ++i) { u32x2 w; w.x = cvtpk(accv[r][i][0] * r0k, accv[r][i][1] * r1k); w.y = cvtpk(accv[r][i][2] * r2k, accv[r][i][3] * r3k);
                *(u32x2*)(MVT + (size_t)(64 * h + 16 * i + fr) * TM + r0 + 16 * rb + 8 * (g & 1) + 4 * (g >> 1)) = w; } }
      }
    }
    if (hp == 0) { __syncthreads();
#pragma unroll
        for (int i = 0; i < 10; ++i) { const int c = tid + 512 * i; if (c < NWR * CH) *(LAS u32x4*)(WL + (c / CH) * WP + 8 * (c % CH)) = wv2[i]; }
        __syncthreads(); }
    }
    __syncthreads();
}

DI int crow(int r, int hi) { return (r & 3) + 8 * (r >> 2) + 4 * hi; }
template <int DK, bool FOX>
DI void attn_unit(LAS unsigned char* lds, const bf16_t* Qp, int qpitch, const bf16_t* Kp, int kpitch, const bf16_t* VT, const float* C, bf16_t* Yp, float* gss, int grp, int hslot, int b, int qb, int jt0) {
    TID_VARS; const int r32 = lane & 31, hi = lane >> 5;
    constexpr int KC = DK / 8, KP = DK + 8, NKS = DK / 16;
    constexpr int KB_BYTES = 64 * KP * 2, VB_BYTES = 64 * 72 * 2, BUF_BYTES = KB_BYTES + VB_BYTES + 256;
    const bool meta = qb < 0;
    const int q0 = meta ? MB0 : b * SEQ + 256 * qb;
    const int NT = meta ? 1 : 1 + 4 * (qb + 1);
    const int qrow = q0 + 32 * wave + r32;
    const bool wave_on = !meta || wave < 2;
    bf16x8 qf[NKS];
#pragma unroll
    for (int ks = 0; ks < NKS; ++ks) qf[ks] = *(const GAS bf16x8*)(Qp + (size_t)qrow * qpitch + 16 * ks + 8 * hi);
    float cq = 0.f; if (FOX) cq = C[qrow];
    bf16x8 bqx = {0, 0, 0, 0, 0, 0, 0, 0};
    if (FOX) { const unsigned h1 = cvtpk(cq, 0.f) & 0xffffu; const float r1 = cq - __uint_as_float(h1 << 16);
        const unsigned h2 = cvtpk(r1, 0.f) & 0xffffu; const float r2 = r1 - __uint_as_float(h2 << 16); const unsigned h3 = cvtpk(r2, 0.f) & 0xffffu;
        u32x4 bw = {0x3f803f80u, 0x3f80u | (h1 << 16), h2 | (h3 << 16), 0u};
        if (hi) bw = (u32x4){0u, 0u, 0u, 0u};
        bqx = __builtin_bit_cast(bf16x8, bw); }
    f32x16 o0 = {0.f, 0.f, 0.f, 0.f, 0.f, 0.f, 0.f, 0.f, 0.f, 0.f, 0.f, 0.f, 0.f, 0.f, 0.f, 0.f}, o1 = o0;
    float m = 0.f, lsum = 0.f;
    u32x4 kreg0, kreg1 = {0u, 0u, 0u, 0u}, vreg, creg = {0u, 0u, 0u, 0u};
#define AT_LOAD(jt_) do { const int tr_ = ((jt_) == 0) ? MB0 : b * SEQ + 64 * ((jt_) - 1); \
        kreg0 = *(const GAS u32x4*)(Kp + (size_t)(tr_ + tid / KC) * kpitch + 8 * (tid % KC)); \
        if (DK == 96 && tid < 256) kreg1 = *(const GAS u32x4*)(Kp + (size_t)(tr_ + (512 + tid) / KC) * kpitch + 8 * ((512 + tid) % KC)); \
        vreg = *(const GAS u32x4*)(VT + (size_t)(tid >> 3) * TM + tr_ + 8 * (tid & 7)); \
        if (FOX && tid < 16) creg = *(const GAS u32x4*)(C + tr_ + 4 * tid); } while (0)
#define AT_STORE(buf_) do { LAS unsigned char* bb_ = lds + (buf_) * BUF_BYTES; \
        *(LAS u32x4*)(bb_ + ((tid / KC) * KP + 8 * (tid % KC)) * 2) = kreg0; \
        if (DK == 96 && tid < 256) *(LAS u32x4*)(bb_ + (((512 + tid) / KC) * KP + 8 * ((512 + tid) % KC)) * 2) = kreg1; \
        *(LAS u32x4*)(bb_ + KB_BYTES + ((tid >> 3) * 72 + 8 * (tid & 7)) * 2) = vreg; \
        if (FOX && tid < 16) *(LAS u32x4*)(bb_ + KB_BYTES + VB_BYTES + 16 * tid) = creg; } while (0)
#define AT_LOADX(K0, K1, V, CR, jt_) do { const int tr_ = ((jt_) == 0) ? MB0 : b * SEQ + 64 * ((jt_) - 1); \
        K0 = *(const GAS u32x4*)(Kp + (size_t)(tr_ + tid / KC) * kpitch + 8 * (tid % KC)); \
        if (DK == 96 && tid < 256) K1 = *(const GAS u32x4*)(Kp + (size_t)(tr_ + (512 + tid) / KC) * kpitch + 8 * ((512 + tid) % KC)); \
        V = *(const GAS u32x4*)(VT + (size_t)(tid >> 3) * TM + tr_ + 8 * (tid & 7)); \
        if (FOX && tid < 16) CR = *(const GAS u32x4*)(C + tr_ + 4 * tid); } while (0)
#define AT_STOREX(K0, K1, V, CR, buf_) do { LAS unsigned char* bb_ = lds + (buf_) * BUF_BYTES; \
        *(LAS u32x4*)(bb_ + ((tid / KC) * KP + 8 * (tid % KC)) * 2) = K0; \
        if (DK == 96 && tid < 256) *(LAS u32x4*)(bb_ + (((512 + tid) / KC) * KP + 8 * ((512 + tid) % KC)) * 2) = K1; \
        *(LAS u32x4*)(bb_ + KB_BYTES + ((tid >> 3) * 72 + 8 * (tid & 7)) * 2) = V; \
        if (FOX && tid < 16) *(LAS u32x4*)(bb_ + KB_BYTES + VB_BYTES + 16 * tid) = CR; } while (0)
#define AT_COMPUTE(jt) do { \
        bool vis = wave_on, elem = false; const int jr = jt - 1; const int qlo = 256 * qb + 32 * wave; \
        if (jt > 0) { if (FOX) { if (64 * jr > qlo + 31) vis = false; else elem = (64 * jr + 63 > qlo); } else { if (jr > (qlo >> 6)) vis = false; } } \
        if (vis) { \
            const LAS unsigned char* bb = lds + (jt & 1) * BUF_BYTES; \
 \
            f32x16 s0 = {0.f, 0.f, 0.f, 0.f, 0.f, 0.f, 0.f, 0.f, 0.f, 0.f, 0.f, 0.f, 0.f, 0.f, 0.f, 0.f}, s1 = s0; \
_Pragma("unroll") \
            for (int ks = 0; ks < NKS; ++ks) { const bf16x8 a0 = *(const LAS bf16x8*)(bb + (r32 * KP + 16 * ks + 8 * hi) * 2), a1 = *(const LAS bf16x8*)(bb + ((32 + r32) * KP + 16 * ks + 8 * hi) * 2); \
                s0 = __builtin_amdgcn_mfma_f32_32x32x16_bf16(a0, qf[ks], s0, 0, 0, 0); s1 = __builtin_amdgcn_mfma_f32_32x32x16_bf16(a1, qf[ks], s1, 0, 0, 0); } \
            if (FOX) { \
                const LAS float* cb = (const LAS float*)(bb + KB_BYTES + VB_BYTES); \
_Pragma("unroll") \
                for (int kb = 0; kb < 2; ++kb) { const float cv = -cb[32 * kb + r32]; \
                    const unsigned h1 = cvtpk(cv, 0.f) & 0xffffu; const float r1 = cv - __uint_as_float(h1 << 16); \
                    const unsigned h2 = cvtpk(r1, 0.f) & 0xffffu; const float r2 = r1 - __uint_as_float(h2 << 16); \
                    const unsigned h3 = cvtpk(r2, 0.f) & 0xffffu; \
                    u32x4 aw = {h1 | (h2 << 16), h3 | 0x3f800000u, 0x3f803f80u, 0u}; \
                    if (hi) aw = (u32x4){0u, 0u, 0u, 0u}; \
                    const bf16x8 ax = __builtin_bit_cast(bf16x8, aw); \
                    if (kb == 0) s0 = __builtin_amdgcn_mfma_f32_32x32x16_bf16(ax, bqx, s0, 0, 0, 0); else s1 = __builtin_amdgcn_mfma_f32_32x32x16_bf16(ax, bqx, s1, 0, 0, 0); } } \
            if (__any(m != 0.f)) { \
_Pragma("unroll") \
                for (int r = 0; r < 16; ++r) { s0[r] -= m; s1[r] -= m; } } \
            if (jt == 0 || elem) { \
_Pragma("unroll") \
                for (int r = 0; r < 16; ++r) { const int k0 = crow(r, hi), k1 = 32 + k0; bool ok0, ok1; \
                    if (jt == 0) { ok0 = false; ok1 = k1 >= 48; if (FOX && meta) ok1 = ok1 && (k1 <= 32 * wave + r32); } \
                    else { ok0 = (64 * jr + k0 <= qlo + r32); ok1 = (64 * jr + k1 <= qlo + r32); } \
                    s0[r] = ok0 ? s0[r] : -INFINITY; s1[r] = ok1 ? s1[r] : -INFINITY; } \
            } \
            float ta = __builtin_fmaxf(__builtin_fmaxf(s0[0], s0[1]), s1[0]), tb = __builtin_fmaxf(__builtin_fmaxf(s0[2], s0[3]), s1[1]); ta = __builtin_fmaxf(__builtin_fmaxf(ta, s1[2]), s1[3]); \
_Pragma("unroll") \
            for (int r = 4; r < 16; r += 4) { ta = __builtin_fmaxf(__builtin_fmaxf(ta, s0[r]), s0[r + 1]); tb = __builtin_fmaxf(__builtin_fmaxf(tb, s0[r + 2]), s0[r + 3]); ta = __builtin_fmaxf(__builtin_fmaxf(ta, s1[r]), s1[r + 1]); tb = __builtin_fmaxf(__builtin_fmaxf(tb, s1[r + 2]), s1[r + 3]); } \
            const float tmax = swap_other(__builtin_fmaxf(ta, tb), true); \
            if (__any(tmax > 8.f)) { \
                const float dl = tmax > 8.f ? tmax : 0.f; m += dl; const float al = __builtin_amdgcn_exp2f(-dl); lsum *= al; \
_Pragma("unroll") \
                for (int r = 0; r < 16; ++r) { s0[r] -= dl; s1[r] -= dl; o0[r] *= al; o1[r] *= al; } } \
            float ps0 = 0.f, ps1 = 0.f; \
_Pragma("unroll") \
            for (int r = 0; r < 16; ++r) { s0[r] = __builtin_amdgcn_exp2f(s0[r]); s1[r] = __builtin_amdgcn_exp2f(s1[r]); ps0 += s0[r]; ps1 += s1[r]; } \
            lsum += ps0 + ps1; \
            const LAS unsigned char* vb = bb + KB_BYTES; \
_Pragma("unroll") \
            for (int kb = 0; kb < 2; ++kb) \
_Pragma("unroll") \
                for (int hf = 0; hf < 2; ++hf) { u32x4 pw; \
                    if (kb == 0) { pw.x = cvtpk(s0[8 * hf + 0], s0[8 * hf + 1]); pw.y = cvtpk(s0[8 * hf + 2], s0[8 * hf + 3]); pw.z = cvtpk(s0[8 * hf + 4], s0[8 * hf + 5]); pw.w = cvtpk(s0[8 * hf + 6], s0[8 * hf + 7]); } \
                    else { pw.x = cvtpk(s1[8 * hf + 0], s1[8 * hf + 1]); pw.y = cvtpk(s1[8 * hf + 2], s1[8 * hf + 3]); pw.z = cvtpk(s1[8 * hf + 4], s1[8 * hf + 5]); pw.w = cvtpk(s1[8 * hf + 6], s1[8 * hf + 7]); } \
                    const bf16x8 pb = __builtin_bit_cast(bf16x8, pw); \
                    const bf16x8 v0 = *(const LAS bf16x8*)(vb + (r32 * 72 + 32 * kb + 16 * hf + 8 * hi) * 2), v1 = *(const LAS bf16x8*)(vb + ((32 + r32) * 72 + 32 * kb + 16 * hf + 8 * hi) * 2); \
                    o0 = __builtin_amdgcn_mfma_f32_32x32x16_bf16(v0, pb, o0, 0, 0, 0); o1 = __builtin_amdgcn_mfma_f32_32x32x16_bf16(v1, pb, o1, 0, 0, 0); } \
        } \
    } while (0)
    u32x4 kB0 = kreg0, kB1 = kreg1, vB = vreg, cB = creg;
    AT_LOADX(kreg0, kreg1, vreg, creg, jt0); AT_STOREX(kreg0, kreg1, vreg, creg, 0); if (jt0 + 1 < NT) AT_LOADX(kreg0, kreg1, vreg, creg, jt0 + 1);
    __syncthreads();
    for (int jt = jt0; jt < NT; jt += 2) {
        if (jt + 2 < NT) AT_LOADX(kB0, kB1, vB, cB, jt + 2);
        AT_COMPUTE(jt);
        if (jt + 1 < NT) AT_STOREX(kreg0, kreg1, vreg, creg, (jt + 1) & 1);
        __syncthreads();
        if (jt + 1 >= NT) break;
        if (jt + 3 < NT) AT_LOADX(kreg0, kreg1, vreg, creg, jt + 3);
        { const int j1 = jt + 1; AT_COMPUTE(j1); }
        if (jt + 2 < NT) AT_STOREX(kB0, kB1, vB, cB, (jt + 2) & 1);
        __syncthreads();
    }
#undef AT_LOADX
#undef AT_STOREX
#undef AT_COMPUTE
#undef AT_LOAD
#undef AT_STORE
    if (wave_on) {
        const float lt = swap_other(lsum, false); const float inv = lt > 0.f ? 1.f / lt : 0.f;
        const bool valid = !meta || (32 * wave + r32 >= META_OFF);
        float sq = 0.f; bf16_t* yrow = Yp + (size_t)qrow * D; u32x2 wv[8];
#pragma unroll
        for (int db = 0; db < 2; ++db)
#pragma unroll
            for (int i = 0; i < 4; ++i) { float y0, y1, y2, y3;
                if (db == 0) { y0 = o0[4 * i] * inv; y1 = o0[4 * i + 1] * inv; y2 = o0[4 * i + 2] * inv; y3 = o0[4 * i + 3] * inv; } else { y0 = o1[4 * i] * inv; y1 = o1[4 * i + 1] * inv; y2 = o1[4 * i + 2] * inv; y3 = o1[4 * i + 3] * inv; }
                u32x2 w; w.x = cvtpk(y0, y1); w.y = cvtpk(y2, y3); wv[4 * db + i] = w;
                const float z0 = bflo(w.x), z1 = bfhi(w.x), z2 = bflo(w.y), z3 = bfhi(w.y); sq += (z0 * z0 + z1 * z1) + (z2 * z2 + z3 * z3); }
#pragma unroll
        for (int kp = 0; kp < 4; ++kp) { const int k = 2 * kp;
            const auto sx = __builtin_amdgcn_permlane32_swap(wv[k].x, wv[k + 1].x, false, false), sy = __builtin_amdgcn_permlane32_swap(wv[k].y, wv[k + 1].y, false, false);
            if (valid) *(u32x4*)(yrow + 8 * k + 8 * hi) = (u32x4){sx[0], sy[0], sx[1], sy[1]}; }
        sq = swap_other(sq, false);
        if (hi == 0 && valid) gss[(size_t)qrow * 16 + 4 * grp + hslot] = sq;
    }
}
DI void attn_dispatch(const Params& p, const Frame& F, int mixer, int b, int h, int qb, float* gss) {
    bf16_t* Y = (bf16_t*)(p.ws + WS_BUFB);
    if (mixer == 0) { const bf16_t* MQ = (const bf16_t*)(p.ws + WS_ATT + AT_MQ) + 96 * h; const bf16_t* MK = (const bf16_t*)(p.ws + WS_ATT + AT_MK) + 96 * h; const bf16_t* MVT = (const bf16_t*)(p.ws + WS_ATT + AT_MVT) + (size_t)64 * h * TM;
        attn_unit<96, false>(F.lds, MQ, 384, MK, 384, MVT, nullptr, Y + Y_MLA + 64 * h, gss, 2, h, b, qb, 0); }
    else { const bf16_t* Z = (const bf16_t*)(p.ws + WS_Z); const bf16_t* FVT = (const bf16_t*)(p.ws + WS_ATT + AT_FVT) + (size_t)64 * h * TM; const float* FC = (const float*)(p.ws + WS_LRU + LRU_FC) + (size_t)h * TM;
        const int jt0 = qb < 0 ? 0 : __builtin_amdgcn_readfirstlane(((const int*)(p.ws + WS_LRU + LRU_FJ0))[(h * NB + b) * 32 + qb]);
        attn_unit<64, true>(F.lds, Z + ZC_FQ + 64 * h, ZC, Z + ZC_FK + 64 * h, ZC, FVT, FC, Y + Y_FOX + 64 * h, gss, 3, h, b, qb, jt0); }
}

DI void moe_conv_items(const Params& pp, LAS float* scr, bool down, int gw, int NGW, int lane) {
    constexpr int I_GU = 112 * 16, I_DN = 32 * 56;
    const int per = down ? I_DN : 2 * I_GU, N = NEXP * per;
#define MOE_ITEM(it_, W_, ldw_, c0_, g_, WT_, K8_, n0_, k0_) const float* W_; const float* g_; unsigned char* WT_; int ldw_, c0_, K8_, n0_, k0_; \
    { const int e = (it_) / per; int r = (it_) % per; \
      if (!down) { const int up = r / I_GU; r %= I_GU; const int sb = r / 16, kb = r % 16; \
          W_ = (up ? pp.moe_w_up : pp.moe_w_gate) + (size_t)e * D * DFE; ldw_ = DFE; c0_ = 32 * sb; g_ = pp.norm2_g + D; WT_ = (unsigned char*)(pp.ws + WS_MGU) + (size_t)e * 7168 * D; K8_ = D; n0_ = 256 * (sb >> 2) + 128 * up + 32 * (sb & 3); k0_ = 64 * kb; } \
      else { const int sb = r / 56, kb = r % 56; \
          W_ = pp.moe_w_down + (size_t)e * DFE * D; ldw_ = D; c0_ = 32 * sb; g_ = nullptr; WT_ = (unsigned char*)(pp.ws + WS_MD) + (size_t)e * D * DFE; K8_ = DFE; n0_ = 32 * sb; k0_ = 64 * kb; } }
    for (int it = gw; it < N; it += 2 * NGW) { const int it2 = it + NGW; const bool two = it2 < N;
        MOE_ITEM(it, Wa, lda_, ca, ga, Ta, Ka, na, ka); MOE_ITEM((two ? it2 : it), Wb, ldb_, cb, gb, Tb, Kb, nb, kb2);
        f32x4 va[8], vb[8]; wt_load8(Wa, lda_, ca, ka, lane, va); wt_load8(Wb, ldb_, cb, kb2, lane, vb);
        wt_finish8(va, ga, W8_SCALE, Ta, Ka, na, ka, scr, lane); if (two) wt_finish8(vb, gb, W8_SCALE, Tb, Kb, nb, kb2, scr, lane); }
#undef MOE_ITEM
}

__global__ void __launch_bounds__(512, 2) hymba_fwd(Params p) {
    extern __shared__ __attribute__((aligned(16))) unsigned char lds_raw[];
    Frame F; F.lds = (LAS unsigned char*)lds_raw;
    F.G = gridDim.x; { const int bx = blockIdx.x; F.vcu = (F.G % 8 == 0) ? (bx % 8) * (F.G / 8) + bx / 8 : bx; }
    volatile LAS unsigned* MISC = (volatile LAS unsigned*)(F.lds + MISC_OFF);
    { const int t0 = threadIdx.x; if (t0 < 64) MISC[t0] = 0u;
      if ((t0 & 63) == 0) *(volatile LAS int*)(unsigned)(TIDTAB_LDS + 4 * (int)(__builtin_amdgcn_s_getreg((5 << 11) | 4) & 63u)) = t0 >> 6; }
    __syncthreads();
    unsigned* ctl = (unsigned*)(p.ws + WS_CTL);
    XcdBarrier bar = xcd_barrier_post(ctl + CW_BAR, MISC + 8);
    LAS float* gstab = (LAS float*)(F.lds + GST_OFF);
#define PHASE_PARAMS Params pp = p; Frame FF = F; int bid = blockIdx.x; { unsigned char* w_ = p.ws; asm volatile("" : "+s"(w_), "+s"(FF.vcu), "+s"(FF.G), "+s"(bid)); pp.ws = w_; } (void)pp; (void)bid
#define ssb ((float*)(pp.ws + WS_CTL) + CW_SS)
#define ss_in0 ((float*)(pp.ws + WS_WSM + 786432))
#define gssb ((float*)(pp.ws + WS_GSP))
#define ssp0 ((float*)(pp.ws + WS_SSP))
#define ssp1 ((float*)(pp.ws + WS_SSP) + (size_t)NR * 16)
#define hmeta2 ((float*)(pp.ws + WS_HMETA) + 16 * D)
#define bufA ((bf16_t*)(pp.ws + WS_BUFA))
#define bufB ((bf16_t*)(pp.ws + WS_BUFB))
#define Zb ((bf16_t*)(pp.ws + WS_Z))
#define hmeta ((float*)(pp.ws + WS_HMETA))

    { PHASE_PARAMS; p0_prologue(pp, FF, ss_in0); }
    xcd_barrier(bar);

    for (int l = 0; l < NLAYER; ++l) {
#define ss1 ((l == 0) ? ss_in0 : ssb + TM)
#define gss (gssb + (size_t)l * TM * 16)
        { PHASE_PARAMS; SchedPlain S{(const char*)bufA, (const char*)(pp.ws + WS_WIN + (size_t)l * ZC * D * 2), D, D, l == 0 ? 129 : 128, 11, FF.G, bid};
          { TID_VARS; fill_rs_table(S, l == 0 ? ss_in0 : ssp1, l == 0 ? 1 : 16, gstab, tid); }
          EpiZ E{Zb};
          pg8::gemm_phase<EpiZ, SchedPlain, false, false>(FF.lds, D, D, S, E, gstab);
          if (l == 0) { const int B = FF.G >> 3, U8 = (129 * 11 + 7) >> 3, last = ((U8 + B - 1) / B - 1) * B;
              int rank = 0, nidle = 0, mine = 0;
              for (int x = 0; x < 8; ++x) { int a = S.xcnt(x) - last; a = a < 0 ? 0 : (a > B ? B : a); if (x < (bid & 7)) rank += B - a; if (x == (bid & 7)) mine = a; nidle += B - a; }
              if ((bid >> 3) >= mine) { TID_VARS; convert_weights(pp, (LAS float*)(FF.lds + wave * 16384), CV_I_IN, CV_NITEMS, (rank + (bid >> 3) - mine) * 8 + wave, nidle * 8, lane); } }
          if (l == 1) { TID_VARS; const int fr = lane & 15, g = lane >> 4; LAS float* rsm = (LAS float*)(FF.lds + 8192);
              const int hb_ = FF.G >> 4, jj_ = bid >> 3; const bool idle_ = (FF.G % 16 == 0) && jj_ >= hb_; const int nid_ = (FF.G % 16 == 0) ? FF.G / 2 : FF.G, rk_ = (FF.G % 16 == 0) ? (bid & 7) * hb_ + (jj_ - hb_) : FF.vcu;
              const bool mine_ = (FF.G % 16 == 0) ? idle_ : true;
              if (mine_ && rk_ < ZC / 16) meta_rs(rsm, hmeta2, tid);
              for (int u = mine_ ? rk_ : ZC; u < ZC / 16; u += nid_) { const f32x4 a = skinny_block(FF.lds, bufA + (size_t)MROW0 * D, D, (const bf16_t*)(pp.ws + WS_WIN + (size_t)ZC * D * 2), D, 16 * u, 128, 1.f, tid);
                  if (wave == 0) { const float rs = rsm[fr]; u32x2 w; w.x = cvtpk(a[0] * rs, a[1] * rs); w.y = cvtpk(a[2] * rs, a[3] * rs); *(u32x2*)(Zb + (size_t)(MROW0 + fr) * ZC + 16 * u + 4 * g) = w; } } }
        }
        xcd_barrier(bar);
        { PHASE_PARAMS; const int NU = NB * NSEG + 1;
          for (int u = bid; u < NU; u += FF.G) {
              if (u < NB * NSEG) { const int b = u / NSEG, s = u % NSEG; const int r0 = b * SEQ + 64 * s; lru_local_unit<64>(pp, FF, l, r0, s == 0 ? MB0 + 61 : r0 - 3, u); }
              else lru_local_unit<16>(pp, FF, l, MROW0, MB0 + 45, NB * NSEG);
          }
          for (int u = bid; u < 3 * 256; u += FF.G) { const int mx = u >> 8, r0 = 128 * (u & 255);
              if (mx == 0) mla_prep_unit<0, 128>(pp, FF, l, r0); else if (mx == 1) mla_prep_unit<1, 128>(pp, FF, l, r0); else fox_prep_unit<128>(pp, FF, l, r0); }
          { const int mx = FF.G - 1 - bid; if (mx == 0) mla_prep_unit<0, 16>(pp, FF, l, MROW0); else if (mx == 1) mla_prep_unit<1, 16>(pp, FF, l, MROW0); else if (mx == 2) fox_prep_unit<16>(pp, FF, l, MROW0); }
          { TID_VARS; const int gt = FF.vcu * 512 + tid, NTH = FF.G * 512;
            for (int i = gt; i < 2 * 256 * 6; i += NTH) { const int c = i % 6, hd = (i / 6) & 255, arr = i / (6 * 256);
                *(u32x4*)((bf16_t*)(pp.ws + WS_ATT + (arr ? AT_FVT : AT_MVT)) + (size_t)hd * TM + MB0 + 8 * c) = zero4(); } }
          { TID_VARS; const int NW = NB * 4 * NSEG + 4;
            for (int wu = (FF.vcu * 8 + wave); wu < NW; wu += FF.G * 8) {
                if (wu < NB * 4 * NSEG) { const int bh = wu / NSEG, sg = wu % NSEG; hg_local_wave(pp, FF.lds + wave * HG_WL, l, (bh >> 2) * SEQ + 64 * sg, 64, bh & 3, wu, lane); }
                else hg_local_wave(pp, FF.lds + wave * HG_WL, l, MROW0, 16, wu - NB * 4 * NSEG, wu, lane);
            } }
        }
        xcd_barrier(bar);
        { PHASE_PARAMS; TID_VARS; const int bx = FF.G - 1 - bid;
          if (bx < 2) { const int i = bx * 512 + tid; lru_carry(pp, i >> 8, i & 255); }
          for (int u = bid; u < 128; u += FF.G) hg_carry_block(pp, FF.lds, u >> 3, u & 7, tid);
          for (int u = bid - 128; u >= 0 && u < 16; u += FF.G) fox_cscan_block(pp, FF.lds, l, u >> 2, u & 3, tid); }
        xcd_barrier(bar);
        { PHASE_PARAMS;
          for (int u = bid; u < NB * NSEG + 1; u += FF.G) {
              if (u < NB * NSEG) { const int b = u / NSEG, sg = u % NSEG; lru_fix_unit<64>(pp, FF, l, b * SEQ + 64 * sg, u, false, gss); }
              else lru_fix_unit<16>(pp, FF, l, MROW0, NB * NSEG, true, gss);
          }
          { TID_VARS; const int NW = NB * 4 * NSEG + 4;
            for (int wu = (FF.vcu * 8 + wave); wu < NW; wu += FF.G * 8) {
                if (wu < NB * 4 * NSEG) { const int bh = wu / NSEG, sg = wu % NSEG; hg_fix_wave(pp, (bh >> 2) * SEQ + 64 * sg, 64, bh & 3, wu, false, gss, lane); }
                else hg_fix_wave(pp, MROW0, 16, wu - NB * 4 * NSEG, wu, true, gss, lane);
            } }
          __syncthreads();
          for (int u = FF.vcu; u < 1024; u += FF.G) { const int mx = u >> 9, i = u & 511, bh = (i & 255) >> 4, sidx = i & 15, qb = (i >> 8) ? 31 - sidx : sidx;
              attn_dispatch(pp, FF, mx, bh >> 2, bh & 3, qb, gss); }
          if (FF.vcu < 8) attn_dispatch(pp, FF, FF.vcu >> 2, 0, FF.vcu & 3, -1, gss);
        }
        xcd_barrier(bar);
        { PHASE_PARAMS; SchedPlain S{(const char*)bufB, (const char*)(pp.ws + WS_WOUT + (size_t)l * D * D * 2), D, D, 128, 4, FF.G, bid};
          { TID_VARS; Unit u; for (int i = 0; i < 4 && S.next(i, u); ++i) { if (tid < 256) { const int row = u.pm * 256 + tid; const f32x4* gq = (const f32x4*)(gss + (size_t)row * 16); float gsum[4];
#pragma unroll
                    for (int q = 0; q < 4; ++q) { const f32x4 v = gq[q]; gsum[q] = (v[0] + v[1]) + (v[2] + v[3]); }
                    const float r0 = rsqrtf(gsum[0] * (1.f / 256.f) + EPS), r1 = rsqrtf(gsum[1] * (1.f / 256.f) + EPS), r2 = rsqrtf(gsum[2] * (1.f / 256.f) + EPS), r3 = rsqrtf(gsum[3] * (1.f / 256.f) + EPS);
                    *(LAS f32x4*)(gstab + (i * 256 + tid) * 4) = (f32x4){r0 / r1, r1 / r2, r2 / r3, r3}; } }
            __syncthreads(); }
#ifdef FFN_GU_FP8
          EpiRes E{bufA, l == 0 ? ssp0 : nullptr, 1, (unsigned char*)(pp.ws + WS_H8), 1.f};
#else
          EpiRes E{bufA, l == 0 ? ssp0 : nullptr, 1, l == 0 ? nullptr : (unsigned char*)(pp.ws + WS_H8), 1.f};
#endif
          pg8::gemm_phase<EpiRes, SchedPlain, false, true>(FF.lds, D, D, S, E, gstab);
          if (l == 0) { TID_VARS; LAS float* scr = (LAS float*)(FF.lds + 16384 + wave * 8704); const int gw = FF.vcu * 8 + wave, NGW = FF.G * 8;
              constexpr int I_G = 88 * 16, I_D = 32 * 44;
#ifdef FFN_GU_FP8
              for (int it = gw; it < 2 * I_G + I_D; it += NGW) { int r = it;
#else
              for (int it = gw + 2 * I_G; it < 2 * I_G + I_D; it += NGW) { int r = it;
#endif
                  if (r < 2 * I_G) { const int up = r / I_G; r %= I_G; const int sb = r / 16, kb = r % 16;
                      wt_item8(up ? pp.ffn_w_up : pp.ffn_w_gate, DFF, 32 * sb, pp.norm2_g, W8_SCALE, (unsigned char*)(pp.ws + WS_FGU8), D, 256 * (sb >> 2) + 128 * up + 32 * (sb & 3), 64 * kb, scr, lane); }
                  else { r -= 2 * I_G; const int sb = r / 44, kb = r % 44; wt_item8(pp.ffn_w_down, D, 32 * sb, nullptr, W8_SCALE, (unsigned char*)(pp.ws + WS_FD8), DFF, 32 * sb, 64 * kb, scr, lane); } }
              __syncthreads(); }
          if (l == 0) { TID_VARS; const int fr = lane & 15, g = lane >> 4;
              for (int u = FF.vcu; u < 64; u += FF.G) { const size_t row = (size_t)(MROW0 + fr);
                  const f32x4 gv = *(const f32x4*)(gss + row * 16 + 4 * (wave >> 1)); const float sc = rsqrtf(((gv[0] + gv[1]) + (gv[2] + gv[3])) * (1.f / 256.f) + EPS);
                  const f32x4 o = skinny_block(FF.lds, bufB + (size_t)MROW0 * D, D, (const bf16_t*)(pp.ws + WS_WOUT), D, 16 * u, 128, sc, tid);
                  if (wave == 0) { const f32x4 hn = *(const f32x4*)(pp.meta + (size_t)fr * D + 16 * u + 4 * g) + o; *(f32x4*)(hmeta + (size_t)fr * D + 16 * u + 4 * g) = hn;
                      u32x2 w; w.x = cvtpk(hn[0], hn[1]); w.y = cvtpk(hn[2], hn[3]); *(u32x2*)(bufA + row * D + 16 * u + 4 * g) = w; } } }
        }
        xcd_barrier(bar);
        if (l == 0) {
#ifdef FFN_GU_FP8
            { PHASE_PARAMS; SchedPlain S{(const char*)(pp.ws + WS_H8), (const char*)(pp.ws + WS_FGU8), 512, 512, 128, 22, FF.G, bid};
              { TID_VARS; fill_rs_table(S, ssp0, 16, gstab, tid); }
              EpiGU8 E{(unsigned char*)Zb, DFF, 1.f / W8_SCALE};
              pg8::gemm_phase<EpiGU8, SchedPlain, false, false, true>(FF.lds, 512, 512, S, E, gstab);
#else
            { PHASE_PARAMS; SchedPlain S{(const char*)bufA, (const char*)(pp.ws + WS_WGU), D, D, 128, 22, FF.G, bid};
              { TID_VARS; fill_rs_table(S, ssp0, 16, gstab, tid); }
              EpiGU8 E{(unsigned char*)Zb, DFF, 1.f};
              pg8::gemm_phase<EpiGU8, SchedPlain, false, false, false>(FF.lds, D, D, S, E, gstab);
#endif
              { TID_VARS; const int fr = lane & 15, g = lane >> 4; LAS float* rsm = (LAS float*)(FF.lds + 8192);
                if (FF.vcu < DFF / 16) meta_rs(rsm, hmeta, tid);
                for (int u = FF.vcu; u < DFF / 16; u += FF.G) { const int c0 = 16 * u, tj = c0 >> 7, wi = c0 & 127;
                    const f32x4 ag = skinny_block(FF.lds, bufA + (size_t)MROW0 * D, D, (const bf16_t*)(pp.ws + WS_WGU), D, 256 * tj + wi, 128, 1.f, tid);
                    const f32x4 au = skinny_block(FF.lds, bufA + (size_t)MROW0 * D, D, (const bf16_t*)(pp.ws + WS_WGU), D, 256 * tj + 128 + wi, 128, 1.f, tid);
                    if (wave == 0) { const float rs = rsm[fr]; float a[4];
#pragma unroll
                        for (int j = 0; j < 4; ++j) { const float gg = ag[j] * rs, uu = au[j] * rs; a[j] = gg * uu * __builtin_amdgcn_rcpf(1.f + __expf(-gg)); }
                        u32x2 w; w.x = cvtpk(a[0], a[1]); w.y = cvtpk(a[2], a[3]); *(u32x2*)(Zb + (size_t)(MROW0 + fr) * DFF + c0 + 4 * g) = w; } } }
            }
            xcd_barrier(bar);
            { PHASE_PARAMS; SchedPlain S{(const char*)Zb, (const char*)(pp.ws + WS_FD8), DFF / 2, DFF / 2, 128, 4, FF.G, bid};
              EpiRes E{bufA, ssp1, 0, nullptr, 1.f / (W8_SCALE * ACT8_SCALE)};
              pg8::gemm_phase<EpiRes, SchedPlain, false, false, true>(FF.lds, DFF / 2, DFF / 2, S, E, gstab);
              { TID_VARS; const int fr = lane & 15, g = lane >> 4;
                for (int u = FF.vcu; u < 64; u += FF.G) {
                    const f32x4 o = skinny_block(FF.lds, Zb + (size_t)MROW0 * DFF, DFF, (const bf16_t*)(pp.ws + WS_WD), DFF, 16 * u, 352, 1.f, tid);
                    if (wave == 0) { const f32x4 hn = *(const f32x4*)(hmeta + (size_t)fr * D + 16 * u + 4 * g) + o; *(f32x4*)(hmeta2 + (size_t)fr * D + 16 * u + 4 * g) = hn;
                        u32x2 w; w.x = cvtpk(hn[0], hn[1]); w.y = cvtpk(hn[2], hn[3]); *(u32x2*)(bufA + (size_t)(MROW0 + fr) * D + 16 * u + 4 * g) = w; } } }
            }
            xcd_barrier(bar);
        }
    }
#if STAGE >= 2
#define mlist ((int*)(pp.ws + WS_CTL + CTL_LIST))
#define mlrs ((float*)(pp.ws + WS_CTL + CTL_LRS))
#define mlgate ((float*)(pp.ws + WS_CTL + CTL_LGATE))
#define mcnt ((unsigned*)(pp.ws + WS_CTL) + CW_MCNT)
    { PHASE_PARAMS; TID_VARS;
      LAS float* WR = (LAS float*)FF.lds;
      LAS int* ph = (LAS int*)(FF.lds + 32768);
      for (int i = tid; i < 1024 * 8; i += 512) WR[i] = pp.moe_w_router[i] * pp.norm2_g[D + (i >> 3)];
      for (int u = bid; u < NR / 128; u += FF.G) {
          if (tid < 64) ph[tid] = 0;
          __syncthreads();
          {
              const int t16 = lane & 15, kq = lane >> 4, tl = wave * 16 + t16, tok = u * 128 + tl;
              float ss = 0.f, lg[8];
#pragma unroll
              for (int e = 0; e < 8; ++e) lg[e] = 0.f;
              const bf16_t* hrow = bufA + (size_t)tok * D + 256 * kq;
#pragma unroll 4
              for (int c = 0; c < 32; ++c) { const u32x4 hw = *(const u32x4*)(hrow + 8 * c); const float hv[8] = {bflo(hw.x), bfhi(hw.x), bflo(hw.y), bfhi(hw.y), bflo(hw.z), bfhi(hw.z), bflo(hw.w), bfhi(hw.w)};
#pragma unroll
                  for (int q = 0; q < 8; ++q) { const float hx = hv[q]; ss += hx * hx; const int k = 256 * kq + 8 * c + q; const f32x4 w0 = *(const LAS f32x4*)(WR + k * 8), w1 = *(const LAS f32x4*)(WR + k * 8 + 4);
                      lg[0] += hx * w0[0]; lg[1] += hx * w0[1]; lg[2] += hx * w0[2]; lg[3] += hx * w0[3]; lg[4] += hx * w1[0]; lg[5] += hx * w1[1]; lg[6] += hx * w1[2]; lg[7] += hx * w1[3]; } }
              ss += __shfl_xor(ss, 16); ss += __shfl_xor(ss, 32);
#pragma unroll
              for (int e = 0; e < 8; ++e) { lg[e] += __shfl_xor(lg[e], 16); lg[e] += __shfl_xor(lg[e], 32); }
              if (kq == 0) { const float rs = rsqrtf(ss * (1.f / 1024.f) + EPS);
                  int e1 = 0; float v1 = lg[0];
#pragma unroll
                  for (int e = 1; e < 8; ++e) if (lg[e] > v1) { v1 = lg[e]; e1 = e; }
                  int e2 = -1; float v2 = -INFINITY;
#pragma unroll
                  for (int e = 0; e < 8; ++e) if (e != e1 && lg[e] > v2) { v2 = lg[e]; e2 = e; }
                  const float g1 = 1.f / (1.f + __expf((v2 - v1) * rs)), g2 = 1.f - g1;
                  const int lo = e1 < e2 ? e1 : e2, hi = e1 < e2 ? e2 : e1; const float glo = e1 < e2 ? g1 : g2, ghi = e1 < e2 ? g2 : g1;
                  __hip_atomic_fetch_add(&ph[lo * 8 + hi], 1, __ATOMIC_RELAXED, __HIP_MEMORY_SCOPE_WORKGROUP);
                  *(f32x4*)(pp.ws + WS_TOKREC + (size_t)tok * 16) = (f32x4){__int_as_float(lo | (hi << 8)), glo, ghi, rs}; } }
          __syncthreads();
          if (tid < 64) ((int*)(pp.ws + WS_PAIRH))[u * 64 + tid] = ph[tid];
          __syncthreads();
      }
      moe_conv_items(pp, (LAS float*)(FF.lds + 49152 + wave * 8704), false, FF.vcu * 8 + wave, FF.G * 8, lane);
    }
    xcd_barrier(bar);
    LAS int* tab0 = (LAS int*)(F.lds + GST_OFF);
    { PHASE_PARAMS; TID_VARS;
      LAS int* part = (LAS int*)FF.lds;
      LAS int* Tt = part + 512;
      LAS int* Qt = Tt + 64;
      LAS int* pfx = Qt + 64;
      LAS int* typ = pfx + 64;
      LAS int* lc = typ + 128;
      LAS int* pq = lc + 32;
      LAS int* tmpq = pq + 32;
      const int* PH = (const int*)(pp.ws + WS_PAIRH);
      { const int p = tid & 63, ch = tid >> 6; int a = 0;
        for (int i = 0; i < 32; ++i) a += PH[(ch * 32 + i) * 64 + p];
        part[ch * 64 + p] = a; }
      __syncthreads();
      if (tid < 64) { int a = 0; for (int ch = 0; ch < 8; ++ch) a += part[ch * 64 + tid]; Tt[tid] = a; Qt[tid] = 0; }
      __syncthreads();
      if (tid == 0) {
          for (int e = 0; e < 8; ++e) { int c = 0; for (int lo = 0; lo < 8; ++lo) c += Tt[lo * 8 + e]; pq[e] = c; }
          int qh = 0, qt = 0, carry = 0;
          for (int e = 7; e >= 1; --e) { const int r = pq[e] & 255, need = (256 - r) & 255;
              if (r == 0) continue;
              if (carry >= need) { int rem = need; carry -= need;
                  while (rem > 0) { const int sx = pq[8 + qh], n = rem < pq[16 + qh] ? rem : pq[16 + qh]; Qt[e * 8 + sx] += n; pq[16 + qh] -= n; rem -= n; if (pq[16 + qh] == 0) ++qh; } }
              else { pq[8 + qt] = e; pq[16 + qt] = r; ++qt; carry += r; } }
          for (; qh < qt; ++qh) if (pq[16 + qh] > 0) Qt[pq[8 + qh]] += pq[16 + qh];
          bool ok = true; for (int p = 0; p < 64; ++p) ok = ok && (Qt[p] <= Tt[p]);
          if (!ok) for (int p = 0; p < 64; ++p) Qt[p] = 0; }
      __syncthreads();
      if (tid < 16) { const int ps = tid >> 3, e = tid & 7; int c = 0;
          for (int o = 0; o < 8; ++o) c += ps == 0 ? (Tt[e * 8 + o] - Qt[e * 8 + o]) + Qt[o * 8 + e] : (Tt[o * 8 + e] - Qt[o * 8 + e]) + Qt[e * 8 + o];
          tab0[1284 + tid] = c; }
      __syncthreads();
      if (tid < 2) { const int ps = tid; LAS int* tb = tab0 + ps * 640; int t = 0;
          for (int e = 0; e < 8; ++e) { const int n = tab0[1284 + ps * 8 + e]; tab0[1300 + ps * 8 + e] = t; for (int o = 0; o < n; o += 256) { tb[t * 4] = e; tb[t * 4 + 1] = o; tb[t * 4 + 2] = n; tb[t * 4 + 3] = 0; ++t; } }
          tab0[1280 + ps] = t; }
      __syncthreads();
      if (bid < 16) { const int ps = bid >> 3, n = tab0[1284 + bid]; if (n & 255) {
              unsigned char* dst = (unsigned char*)(pp.ws + WS_MAS) + ((size_t)(ps * 136 + tab0[1300 + bid] + (n >> 8)) * 256) * 1024;
              for (int r = (n & 255) + wave; r < 256; r += 8) *(u32x4*)(dst + (size_t)r * 1024 + 16 * lane) = zero4(); } }
      LAS int* gq = tmpq + 512;
      for (int u = bid; u < NR / 128; u += FF.G) {
          if (tid < 16) lc[tid] = 0;
          { const int p = tid & 63, g = tid >> 6, c0 = u >> 5, i0 = c0 * 32 + 4 * g; int a = 0;
#pragma unroll
            for (int i = 0; i < 4; ++i) { const int v = PH[(i0 + i < NR / 128 ? i0 + i : 0) * 64 + p]; a += (i0 + i < u) ? v : 0; }
            tmpq[g * 64 + p] = a; }
          __syncthreads();
          if (tid < 64) { int a = 0; const int c0 = u >> 5; for (int ch = 0; ch < c0; ++ch) a += part[ch * 64 + tid]; for (int g = 0; g < 8; ++g) a += tmpq[g * 64 + tid]; pfx[tid] = a; }
          f32x4 rec = {0.f, 0.f, 0.f, 0.f}; int lo = 0, hi = 0;
          if (tid < 128) { rec = *(const f32x4*)(pp.ws + WS_TOKREC + (size_t)(u * 128 + tid) * 16); const int pk = __float_as_int(rec[0]); lo = pk & 255; hi = pk >> 8; typ[tid] = lo * 8 + hi; }
          __syncthreads();
          int p0 = 0, p1 = 0, e0 = 0, e1 = 0; float g0 = 0.f, g1 = 0.f;
          if (tid < 128) { const int ty = lo * 8 + hi; int rk = pfx[ty];
              for (int j = 0; j < tid; j += 4) { const i32x4 t4 = *(const LAS i32x4*)(typ + j); rk += ((t4[0] == ty) ? 1 : 0) + ((j + 1 < tid && t4[1] == ty) ? 1 : 0) + ((j + 2 < tid && t4[2] == ty) ? 1 : 0) + ((j + 3 < tid && t4[3] == ty) ? 1 : 0); }
              const bool sw = rk < Qt[ty]; e0 = sw ? hi : lo; e1 = sw ? lo : hi; g0 = sw ? rec[2] : rec[1]; g1 = sw ? rec[1] : rec[2];
              p0 = __hip_atomic_fetch_add(&lc[e0], 1, __ATOMIC_RELAXED, __HIP_MEMORY_SCOPE_WORKGROUP); p1 = __hip_atomic_fetch_add(&lc[8 + e1], 1, __ATOMIC_RELAXED, __HIP_MEMORY_SCOPE_WORKGROUP); }
          __syncthreads();
          if (tid < 16) lc[16 + tid] = (int)atomicAdd(mcnt + tid, (unsigned)lc[tid]);
          __syncthreads();
          if (tid < 128) { const int tok = u * 128 + tid; const float rs = rec[3];
              const int i0 = e0 * 32768 + lc[16 + e0] + p0, i1 = (8 + e1) * 32768 + lc[16 + 8 + e1] + p1;
              mlist[i0] = tok; mlrs[i0] = rs; mlgate[i0] = g0; mlist[i1] = tok; mlrs[i1] = rs; mlgate[i1] = g1;
              *(LAS i32x4*)(gq + 8 * tid) = (i32x4){tok, 0, e0, lc[16 + e0] + p0}; *(LAS i32x4*)(gq + 8 * tid + 4) = (i32x4){tok, 1, e1, lc[16 + 8 + e1] + p1}; }
          __syncthreads();
          { const unsigned char* src = (const unsigned char*)(pp.ws + WS_H8);
            for (int q0 = wave * 32; q0 < wave * 32 + 32; q0 += 8) { u32x4 v[8]; i32x4 d[8];
#pragma unroll
                for (int i = 0; i < 8; ++i) { d[i] = *(const LAS i32x4*)(gq + 4 * (q0 + i)); v[i] = *(const u32x4*)(src + (size_t)d[i][0] * 1024 + 16 * lane); }
#pragma unroll
                for (int i = 0; i < 8; ++i) { const int ps = d[i][1], pos = d[i][3];
                    *(u32x4*)((unsigned char*)(pp.ws + WS_MAS) + ((size_t)(ps * 136 + tab0[1300 + ps * 8 + d[i][2]] + (pos >> 8)) * 256 + (pos & 255)) * 1024 + 16 * lane) = v[i]; } } }
          __syncthreads();
      }
    }
    xcd_barrier(bar);
    {
        LAS int* tabA = tab0; LAS int* tabB = tab0 + 640;
        const int nT0 = __builtin_amdgcn_readfirstlane(tab0[1280]), nT1 = __builtin_amdgcn_readfirstlane(tab0[1281]);
        { PHASE_PARAMS; SchedMoe S{(const char*)(pp.ws + WS_MAS), (const char*)(pp.ws + WS_MGU), (size_t)7168 * D, 512, 512, nT0, 28, FF.G, bid, tabA, mlist, false, 0u, 0, 0};
          EpiMoeGU E{(unsigned char*)(pp.ws + WS_MACT), mlrs, tabA};
          { TID_VARS; fill_moe_rs_table(S, mlrs, gstab + 2048, tid); }
          pg8::gemm_phase<EpiMoeGU, SchedMoe, false, false, true>(FF.lds, 512, 512, S, E, gstab + 2048);
          { TID_VARS; const int B = FF.G >> 3, U = nT0 * 28, U8 = (U + 7) >> 3, last = ((U8 + B - 1) / B - 1) * B;
            int rank = 0, nidle = 0, mine = 0;
            for (int x = 0; x < 8; ++x) { int c = U - x * U8; c = c < 0 ? 0 : (c > U8 ? U8 : c); int a = c - last; a = a < 0 ? 0 : (a > B ? B : a); if (x < (bid & 7)) rank += B - a; if (x == (bid & 7)) mine = a; nidle += B - a; }
            if ((FF.G & 7) != 0 || nidle == 0) moe_conv_items(pp, (LAS float*)(FF.lds + 49152 + wave * 8704), true, FF.vcu * 8 + wave, FF.G * 8, lane);
            else if ((bid >> 3) >= mine) moe_conv_items(pp, (LAS float*)(FF.lds + 49152 + wave * 8704), true, (rank + (bid >> 3) - mine) * 8 + wave, nidle * 8, lane); } }
        xcd_barrier(bar);
        { PHASE_PARAMS;
          { SchedMoe S{(const char*)(pp.ws + WS_MACT), (const char*)(pp.ws + WS_MD), (size_t)D * DFE, DFE / 2, DFE / 2, nT0, 4, FF.G, bid, tabA, mlist, false, 0u, 0, 0};
            EpiMoeDown E{pp.out, mlist, mlgate, tabA, bufA, false};
            pg8::gemm_phase<EpiMoeDown, SchedMoe, false, false, true>(FF.lds, DFE / 2, DFE / 2, S, E, gstab); }
          { const int ud8 = (nT0 * 4 + 7) >> 3, udx = nT0 * 4 - (bid & 7) * ud8, udc = udx < ud8 ? udx : ud8;
            const int nheavy = udc > 2 * (FF.G >> 3) ? udc - 2 * (FF.G >> 3) : 0;
            SchedMoe S{(const char*)(pp.ws + WS_MAS) + (size_t)136 * 256 * 1024, (const char*)(pp.ws + WS_MGU), (size_t)7168 * D, 512, 512, nT1, 28, FF.G, bid, tabB, mlist + 8 * 32768, false, 0u, nheavy, 4};
            EpiMoeGU E{(unsigned char*)(pp.ws + WS_MACT1), mlrs + 8 * 32768, tabB};
            { TID_VARS; fill_moe_rs_table(S, mlrs + 8 * 32768, gstab + 2048, tid); }
            pg8::gemm_phase<EpiMoeGU, SchedMoe, false, false, true>(FF.lds, 512, 512, S, E, gstab + 2048); } }
        xcd_barrier(bar);
        { PHASE_PARAMS; SchedMoe S{(const char*)(pp.ws + WS_MACT1), (const char*)(pp.ws + WS_MD), (size_t)D * DFE, DFE / 2, DFE / 2, nT1, 4, FF.G, bid, tabB, mlist + 8 * 32768, false, 0u, 0, 0};
          EpiMoeDown E{pp.out, mlist + 8 * 32768, mlgate + 8 * 32768, tabB, bufA, true};
          pg8::gemm_phase<EpiMoeDown, SchedMoe, false, false, true>(FF.lds, DFE / 2, DFE / 2, S, E, gstab); }
    }
#endif
}

extern "C" void kernel_launch(void* const* d_in, const int* in_sizes, int n_in, void* d_out, int out_size, void* d_ws, size_t ws_size, hipStream_t stream) {
    static int grid = 0;
    if (grid == 0) {
        if (n_in != 31 || out_size != NR * D || ws_size < WS_END) { fprintf(stderr, "kernel_launch: unexpected sizes n_in %d out %d ws %zu\n", n_in, out_size, ws_size); grid = -1; return; }
        int dev = 0, cus = 0, per_cu = 0;
        if (hipGetDevice(&dev) != hipSuccess || hipDeviceGetAttribute(&cus, hipDeviceAttributeMultiprocessorCount, dev) != hipSuccess) { grid = -1; return; }
        if (hipFuncSetAttribute((const void*)hymba_fwd, hipFuncAttributeMaxDynamicSharedMemorySize, LDS_BYTES) != hipSuccess) { fprintf(stderr, "kernel_launch: hipFuncSetAttribute failed\n"); grid = -1; return; }
        if (hipOccupancyMaxActiveBlocksPerMultiprocessor(&per_cu, (const void*)hymba_fwd, 512, LDS_BYTES) != hipSuccess || per_cu < 1) { fprintf(stderr, "kernel_launch: occupancy query says %d\n", per_cu); (void)hipGetLastError(); per_cu = 1; }
        grid = cus;
    }
    if (grid < 0) return;
    (void)hipMemsetAsync((char*)d_ws + WS_CTL, 0, CTL_BYTES, stream);
    Params p{};
    const float** pp = (const float**)&p;
    for (int i = 0; i < 31; ++i) pp[i] = (const float*)d_in[i];
    p.out = (float*)d_out; p.ws = (unsigned char*)d_ws;
    hipLaunchKernelGGL(hymba_fwd, dim3(grid), dim3(512), LDS_BYTES, stream, p);
}
```
